# Optimizing an MI355X kernel written in HIP

```python
import math
import jax, jax.numpy as jnp
from jax import lax
import numpy as np


D_MODEL = 1024
BATCH = 4
SEQ = 8192
DEPTH = 2

HEAD_DIM = 64
N_HEADS_TOTAL = D_MODEL // HEAD_DIM
A_HEADS = N_HEADS_TOTAL // 4
B_HEADS = 3 * N_HEADS_TOTAL // 8
C_HEADS = N_HEADS_TOTAL - A_HEADS - B_HEADS
C_KV_HEADS = 2
C_GROUP = C_HEADS // C_KV_HEADS
A_QK_DIM = HEAD_DIM // 2
A_V_DIM = HEAD_DIM
MOBA_BLOCK = 256
MOBA_TOPK = 3
MOBA_QCHUNK = 32
WINDOW = 128
DENSE_QBLOCK = 128
ALIBI_MAX = 8.0
A_Q_W = A_HEADS * 2 * A_QK_DIM
A_K_W = A_HEADS * 2 * A_QK_DIM
A_V_W = A_HEADS * A_V_DIM
B_W = B_HEADS * HEAD_DIM
C_Q_W = C_HEADS * HEAD_DIM
C_KV_W = C_KV_HEADS * HEAD_DIM
IN_WIDTH = A_Q_W + A_K_W + A_V_W + 3 * B_W + C_Q_W + 2 * C_KV_W
MIX_WIDTH = A_V_W + B_W + C_Q_W
PEER_HEADS = 8
PEER_NKEYS = 128
PEER_N = PEER_NKEYS * PEER_NKEYS
PEER_TOPK = 16
PEER_QDIM = 256
PEER_CHUNK = 128
N_MOD = 6
EPS = 1e-6

kernel_name = "hymba_diff_moba_swa_peer_adaln"


def rmsnorm(x, g):
    xf = x.astype(jnp.float32)
    y = xf * lax.rsqrt(jnp.mean(xf * xf, axis=-1, keepdims=True) + EPS)
    return (y * g.astype(jnp.float32)).astype(x.dtype)


def alibi_slopes():
    n = N_HEADS_TOTAL
    return 2.0 ** (-ALIBI_MAX * jnp.arange(1, n + 1, dtype=jnp.float32) / n)


def diff_attention(q, k, v, slopes, lam, lam_init, subln_g):
    B, S, H, _, dk = q.shape
    nq = S // DENSE_QBLOCK
    scale = dk ** -0.5
    pos_k = jnp.arange(S, dtype=jnp.float32)
    qb = q.reshape(B, nq, DENSE_QBLOCK, H, 2, dk).transpose(1, 0, 2, 3, 4, 5)

    def block(args):
        i, qi = args
        pos_q = (i * DENSE_QBLOCK + jnp.arange(DENSE_QBLOCK)).astype(jnp.float32)
        dist = pos_q[:, None] - pos_k[None, :]
        s = jnp.einsum('bqhmd,bshmd->bhmqs', qi, k).astype(jnp.float32) * scale
        s = jnp.where((dist >= 0)[None, None, None],
                      s - slopes[None, :, None, None, None] * dist[None, None, None], -jnp.inf)
        p = jax.nn.softmax(s, axis=-1)
        w = (p[:, :, 0] - lam * p[:, :, 1]).astype(v.dtype)
        return jnp.einsum('bhqs,bshd->bqhd', w, v)

    o = lax.map(block, (jnp.arange(nq), qb))
    o = o.transpose(1, 0, 2, 3, 4).reshape(B, S, H, -1)
    return rmsnorm(o, subln_g) * (1.0 - lam_init)


def moba_attention(q, k, v, slopes):
    B, S, H, d = q.shape
    L = MOBA_BLOCK
    nb = -(-S // L)
    Sp = nb * L
    pad = ((0, 0), (0, Sp - S), (0, 0), (0, 0))
    q = jnp.pad(q, pad)
    k = jnp.pad(k, pad)
    v = jnp.pad(v, pad)
    K = min(MOBA_TOPK, nb)
    nc = Sp // MOBA_QCHUNK
    scale = d ** -0.5
    kbh = k.reshape(B, nb, L, H, d).transpose(0, 3, 1, 2, 4)
    vbh = v.reshape(B, nb, L, H, d).transpose(0, 3, 1, 2, 4)
    kmean = jnp.mean(kbh.astype(jnp.float32), axis=3)
    gate = jnp.einsum('bshd,bhnd->bshn', q.astype(jnp.float32), kmean)
    q_blk = jnp.arange(Sp) // L
    past = jnp.arange(nb)[None, :] < q_blk[:, None]
    gate = jnp.where(past[None, :, None, :], gate, -jnp.inf)
    gsc, sel = lax.top_k(gate, K)
    valid = jnp.isfinite(gsc)
    b_idx = jnp.arange(B)[:, None, None, None]
    h_idx = jnp.arange(H)[None, None, :, None]
    offs = jnp.arange(L)
    KL = K * L

    def chunk(i):
        t0 = i * MOBA_QCHUNK
        qc = lax.dynamic_slice_in_dim(q, t0, MOBA_QCHUNK, axis=1)
        selc = lax.dynamic_slice_in_dim(sel, t0, MOBA_QCHUNK, axis=1)
        valc = lax.dynamic_slice_in_dim(valid, t0, MOBA_QCHUNK, axis=1)
        pos_q = (t0 + jnp.arange(MOBA_QCHUNK)).astype(jnp.float32)
        k_sel = kbh[b_idx, h_idx, selc]
        v_sel = vbh[b_idx, h_idx, selc]
        own = t0 // L
        k_own = lax.dynamic_index_in_dim(kbh, own, axis=2, keepdims=False)
        v_own = lax.dynamic_index_in_dim(vbh, own, axis=2, keepdims=False)
        s_sel = jnp.einsum('bqhd,bqhkld->bqhkl', qc, k_sel).astype(jnp.float32) * scale
        pos_sel = (selc[..., None] * L + offs).astype(jnp.float32)
        dist_sel = pos_q[None, :, None, None, None] - pos_sel
        s_sel = jnp.where(valc[..., None], s_sel - slopes[:, None, None] * dist_sel, -jnp.inf)
        pos_own = (own * L + offs).astype(jnp.float32)
        dist_own = pos_q[:, None] - pos_own[None, :]
        s_own = jnp.einsum('bqhd,bhld->bqhl', qc, k_own).astype(jnp.float32) * scale
        s_own = jnp.where((dist_own >= 0)[None, :, None, :],
                          s_own - slopes[:, None] * dist_own[None, :, None, :], -jnp.inf)
        s_all = jnp.concatenate([s_sel.reshape(B, MOBA_QCHUNK, H, KL), s_own], axis=-1)
        p = jax.nn.softmax(s_all, axis=-1).astype(v.dtype)
        p_sel = p[..., :KL].reshape(B, MOBA_QCHUNK, H, K, L)
        p_own = p[..., KL:]
        return (jnp.einsum('bqhkl,bqhkld->bqhd', p_sel, v_sel)
                + jnp.einsum('bqhl,bhld->bqhd', p_own, v_own))

    o = lax.map(chunk, jnp.arange(nc))
    return o.transpose(1, 0, 2, 3, 4).reshape(B, Sp, H, d)[:, :S]


def swa_sink_attention(q, k, v, slopes, sinks):
    B, S, Hq, d = q.shape
    W = WINDOW
    nb = S // W
    scale = d ** -0.5
    qb = q.reshape(B, nb, W, C_KV_HEADS, C_GROUP, d)

    def with_prev(t):
        tb = t.reshape(B, nb, W, C_KV_HEADS, d)
        prev = jnp.pad(tb, ((0, 0), (1, 0), (0, 0), (0, 0), (0, 0)))[:, :-1]
        return jnp.concatenate([prev, tb], axis=2)

    kb = with_prev(k)
    vb = with_prev(v)
    s = jnp.einsum('bnqhgd,bnkhd->bnhgqk', qb, kb).astype(jnp.float32) * scale
    qq = jnp.arange(W)
    kk = jnp.arange(2 * W)
    rel = (qq[:, None] + W - kk[None, :]).astype(jnp.float32)
    key_pos = jnp.arange(nb)[:, None] * W - W + kk[None, :]
    mask = (rel >= 0)[None] & (rel < W)[None] & (key_pos >= 0)[:, None, :]
    sl = slopes.reshape(C_KV_HEADS, C_GROUP)
    s = jnp.where(mask[None, :, None, None], s - sl[:, :, None, None] * rel, -jnp.inf)
    sink = jnp.broadcast_to(sinks.astype(jnp.float32).reshape(C_KV_HEADS, C_GROUP)[None, None, :, :, None, None],
                            s.shape[:-1] + (1,))
    p = jax.nn.softmax(jnp.concatenate([s, sink], axis=-1), axis=-1)[..., :-1].astype(v.dtype)
    o = jnp.einsum('bnhgqk,bnkhd->bnqhgd', p, vb)
    return o.reshape(B, S, Hq, d)


def mixer(h, w_in, w_out, lam, lam_init, subln_g, sinks):
    B, S, _ = h.shape
    proj = jnp.einsum('bsd,de->bse', h, w_in)
    cuts = np.cumsum([A_Q_W, A_K_W, A_V_W, B_W, B_W, B_W, C_Q_W, C_KV_W]).tolist()
    qa, ka, va, qb, kb, vb, qc, kc, vc = jnp.split(proj, cuts, axis=-1)
    slopes = alibi_slopes()
    sl_c = slopes[:C_HEADS]
    sl_a = slopes[C_HEADS:C_HEADS + A_HEADS]
    sl_b = slopes[C_HEADS + A_HEADS:]
    oa = diff_attention(qa.reshape(B, S, A_HEADS, 2, A_QK_DIM), ka.reshape(B, S, A_HEADS, 2, A_QK_DIM),
                        va.reshape(B, S, A_HEADS, A_V_DIM), sl_a, lam, lam_init, subln_g)
    ob = moba_attention(qb.reshape(B, S, B_HEADS, HEAD_DIM), kb.reshape(B, S, B_HEADS, HEAD_DIM),
                        vb.reshape(B, S, B_HEADS, HEAD_DIM), sl_b)
    oc = swa_sink_attention(qc.reshape(B, S, C_HEADS, HEAD_DIM), kc.reshape(B, S, C_KV_HEADS, HEAD_DIM),
                            vc.reshape(B, S, C_KV_HEADS, HEAD_DIM), sl_c, sinks)
    o = jnp.concatenate([oa.reshape(B, S, A_V_W), ob.reshape(B, S, B_W), oc.reshape(B, S, C_Q_W)], axis=-1)
    return jnp.einsum('bse,ed->bsd', o, w_out)


def peer_ffn(h, wq, sub_keys, u, v):
    B, S, D = h.shape
    T = B * S
    xs = h.reshape(T // PEER_CHUNK, PEER_CHUNK, D)

    def chunk(xc):
        q = jnp.einsum('td,de->te', xc, wq).reshape(PEER_CHUNK, PEER_HEADS, 2, PEER_QDIM // 2)
        s = jnp.einsum('thpd,hpnd->thpn', q, sub_keys).astype(jnp.float32)
        sv, si = lax.top_k(s, PEER_TOPK)
        cand = (sv[:, :, 0, :, None] + sv[:, :, 1, None, :]).reshape(PEER_CHUNK, PEER_HEADS, -1)
        cidx = (si[:, :, 0, :, None] * PEER_NKEYS + si[:, :, 1, None, :]).reshape(PEER_CHUNK, PEER_HEADS, -1)
        top, pos = lax.top_k(cand, PEER_TOPK)
        eidx = jnp.take_along_axis(cidx, pos, axis=-1)
        g = jax.nn.softmax(top, axis=-1)
        ue = u[eidx]
        ve = v[eidx]
        a = jax.nn.gelu(jnp.einsum('thkd,td->thk', ue, xc).astype(jnp.float32), approximate=False)
        return jnp.einsum('thk,thkd->td', (g * a).astype(ve.dtype), ve)

    return lax.map(chunk, xs).reshape(B, S, D)


def setup_inputs(seed: int = 0) -> dict:
    key = jax.random.key(seed)
    ks = jax.random.split(key, 20)
    f32 = jnp.float32
    D = D_MODEL

    def nrm(k, shape, scale):
        return jax.random.normal(k, shape, f32) * scale

    return {
        "x": nrm(ks[0], (BATCH, SEQ, D), 1.0),
        "c": nrm(ks[1], (BATCH, D), 1.0),
        "norm1_g": 1.0 + nrm(ks[2], (DEPTH, D), 0.02),
        "norm2_g": 1.0 + nrm(ks[3], (DEPTH, D), 0.02),
        "w_ada": nrm(ks[4], (DEPTH, D, N_MOD * D), 0.5 * D ** -0.5),
        "b_ada": nrm(ks[5], (DEPTH, N_MOD * D), 0.02),
        "w_in": nrm(ks[6], (DEPTH, D, IN_WIDTH), D ** -0.5),
        "w_out": nrm(ks[7], (DEPTH, MIX_WIDTH, D), MIX_WIDTH ** -0.5),
        "lam_q1": nrm(ks[8], (DEPTH, A_QK_DIM), 0.1),
        "lam_k1": nrm(ks[9], (DEPTH, A_QK_DIM), 0.1),
        "lam_q2": nrm(ks[10], (DEPTH, A_QK_DIM), 0.1),
        "lam_k2": nrm(ks[11], (DEPTH, A_QK_DIM), 0.1),
        "subln_g": 1.0 + nrm(ks[12], (DEPTH, A_V_DIM), 0.02),
        "sinks": nrm(ks[13], (DEPTH, C_HEADS), 0.5),
        "peer_wq": nrm(ks[14], (DEPTH, D, PEER_HEADS * PEER_QDIM), D ** -0.5),
        "peer_keys": nrm(ks[15], (DEPTH, PEER_HEADS, 2, PEER_NKEYS, PEER_QDIM // 2), (PEER_QDIM // 2) ** -0.5),
        "peer_u": nrm(ks[16], (DEPTH, PEER_N, D), D ** -0.5),
        "peer_v": nrm(ks[17], (DEPTH, PEER_N, D), (PEER_HEADS * PEER_TOPK) ** -0.5),
        "final_g": 1.0 + nrm(ks[18], (D,), 0.02),
    }


def reference(x, c, norm1_g, norm2_g, w_ada, b_ada, w_in, w_out, lam_q1, lam_k1, lam_q2, lam_k2,
              subln_g, sinks, peer_wq, peer_keys, peer_u, peer_v, final_g):
    cs = jax.nn.silu(c)
    for l in range(DEPTH):
        mod = jnp.einsum('bd,de->be', cs, w_ada[l]) + b_ada[l]
        sh1, sc1, g1, sh2, sc2, g2 = [m[:, None, :] for m in jnp.split(mod, N_MOD, axis=-1)]
        lam_init = 0.8 - 0.6 * math.exp(-0.3 * l)
        lam = (jnp.exp(jnp.sum(lam_q1[l].astype(jnp.float32) * lam_k1[l].astype(jnp.float32)))
               - jnp.exp(jnp.sum(lam_q2[l].astype(jnp.float32) * lam_k2[l].astype(jnp.float32))) + lam_init)
        h = rmsnorm(x, norm1_g[l]) * (1.0 + sc1) + sh1
        x = x + g1 * mixer(h, w_in[l], w_out[l], lam, lam_init, subln_g[l], sinks[l])
        h = rmsnorm(x, norm2_g[l]) * (1.0 + sc2) + sh2
        x = x + g2 * peer_ffn(h, peer_wq[l], peer_keys[l], peer_u[l], peer_v[l])
    return rmsnorm(x, final_g)
```

```cpp
#include <hip/hip_runtime.h>
#include <hip/hip_cooperative_groups.h>
#include <cstdio>
#include <cstdint>
#include <cmath>
namespace cg = cooperative_groups;

constexpr int DM = 1024, NBATCH = 4, SEQ = 8192, DEPTH = 2, TOK = NBATCH * SEQ;
constexpr int INW = 2560, NMOD = 6;
constexpr int OFF_QA = 0, OFF_KA = 256, OFF_VA = 512, OFF_QB = 768, OFF_KB = 1152, OFF_VB = 1536, OFF_QC = 1920, OFF_KC = 2304, OFF_VC = 2432;
constexpr int PHEADS = 8, PQW = 2048, PNK = 128, PNEXP = 16384, PTOPK = 16;
constexpr float EPS = 1e-6f;
constexpr float LOG2E = 1.4426950408889634f;
constexpr int NWAVES = 8, NTHREADS = 512;

constexpr size_t MiB = 1u << 20;
constexpr size_t WS_CTL = 0, CTL_ZERO_BYTES = 64 * 1024;
constexpr size_t WS_WIN = 1 * MiB;
constexpr size_t WS_WOUT = 11 * MiB;
constexpr size_t WS_WQ = 15 * MiB;
constexpr size_t WS_KEYS = 23 * MiB;
constexpr size_t WS_MOD = 24 * MiB;
constexpr size_t WS_KMEAN = 24 * MiB + 256 * 1024;
constexpr size_t WS_SCAL = 25 * MiB;
constexpr size_t WS_U = 26 * MiB;
constexpr size_t WS_V = 90 * MiB;
constexpr size_t WS_H = 154 * MiB;
constexpr size_t WS_PROJ = 218 * MiB;
constexpr size_t WS_O = 378 * MiB;
constexpr size_t WS_END = 442 * MiB;

#define GAS __attribute__((address_space(1)))
#define LAS __attribute__((address_space(3)))
typedef unsigned short bf16_t;
typedef short bf16x8_t __attribute__((ext_vector_type(8)));
typedef short s16x4_t __attribute__((ext_vector_type(4)));
typedef float f32x4_t __attribute__((ext_vector_type(4)));
typedef float f32x16_t __attribute__((ext_vector_type(16)));
typedef unsigned u32x4_t __attribute__((ext_vector_type(4)));
typedef unsigned u32x2_t __attribute__((ext_vector_type(2)));

__device__ __forceinline__ unsigned f2bf(float f) { unsigned u = __builtin_bit_cast(unsigned, f); return (u + 0x7fffu + ((u >> 16) & 1u)) >> 16; }
__device__ __forceinline__ unsigned pk2(float lo, float hi) { return f2bf(lo) | (f2bf(hi) << 16); }
__device__ __forceinline__ float bf_lo(unsigned w) { return __builtin_bit_cast(float, w << 16); }
__device__ __forceinline__ float bf_hi(unsigned w) { return __builtin_bit_cast(float, w & 0xffff0000u); }
__device__ __forceinline__ float wave_sum(float v) {
#pragma unroll
    for (int o = 1; o < 64; o <<= 1) v += __shfl_xor(v, o);
    return v;
}
__device__ __forceinline__ float swap32_partner(float v, int) { return __shfl_xor(v, 32); }
__device__ __forceinline__ float alibi_slope(int i) { return exp2f(-0.5f * (float)(i + 1)); }

namespace pg8 {
#define PG8_LAS __attribute__((address_space(3)))
typedef unsigned short bf16_t;
typedef short bf16x8 __attribute__((ext_vector_type(8)));
typedef float f32x4 __attribute__((ext_vector_type(4)));
typedef unsigned u32x4 __attribute__((ext_vector_type(4)));
constexpr int BM = 256, BK = 64, HALF = 128, HTB = HALF * BK * 2  , STAGE_BYTES = 8 * HTB, NXCD = 8, WGM = 8;

__host__ __device__ __forceinline__ int lds_byte(int r, int c) { const int st = (r >> 4) * 2 + (c >> 5), rr = r & 15, cc = c & 31, ob = rr * 64 + cc * 2; return st * 1024 + (ob ^ (((ob >> 9) & 1) << 5)); }
__host__ __device__ __forceinline__ void stage_rc(int b, int& R, int& C) { const int st = b / 1024, sb = b % 1024, swz = sb ^ (((sb >> 9) & 1) << 5); R = (st >> 1) * 16 + swz / 64; C = (st & 1) * 32 + (swz % 64) / 2; }
__host__ __device__ __forceinline__ int perm32(int rho) { const int n = rho >> 4, i = rho & 15; return 8 * (i >> 2) + 4 * n + (i & 3); }

struct Unit { int pm, pn; };
struct Gemm { const bf16_t* A; const bf16_t* Bt; int M, N, K; };

struct StaticOrder {
    int nM, nN, nwg, G, c;
    __host__ __device__ void init(int M, int N, int G_, int c_) { nM = M / BM; nN = N / BM; nwg = nM * nN; G = G_; c = c_; }
    __host__ __device__ bool next(int i, Unit& u) const {
        const long L = (long)i * G + c; if (L >= nwg) return false;
        int wgid = (int)L; { const int q = nwg / NXCD, r = nwg % NXCD, xcd = wgid % NXCD, off = wgid / NXCD; wgid = (xcd < r ? xcd * (q + 1) : r * (q + 1) + (xcd - r) * q) + off; }
        const int nig = WGM * nN, gid = wgid / nig, fm = gid * WGM, gsz = (nM - fm) < WGM ? (nM - fm) : WGM;
        u.pm = fm + ((wgid % nig) % gsz); u.pn = (wgid % nig) / gsz; return true;
    }
    __device__ __forceinline__ void a_ready(const Unit&) const {}
    __device__ __forceinline__ void done(const Unit&) const {}
};

__device__ __forceinline__ unsigned cvt_pk_bf16(float lo, float hi) { unsigned r; asm volatile("v_cvt_pk_bf16_f32 %0, %1, %2" : "=v"(r) : "v"(lo), "v"(hi)); return r; }
struct EpiBf16Plain {
    static constexpr bool PERM = true, AFTER_DRAIN = false;
    bf16_t* O; int ldc;
    __device__ __forceinline__ void operator()(const f32x4 (&acc)[2][2][4][2], const Unit& u, int wr, int wc, int fr, int fq) const {
        const int row0 = u.pm * BM + wr * 64 + fr, col0 = u.pn * BM + wc * 32 + 8 * fq;
#pragma unroll
        for (int ai = 0; ai < 2; ++ai)
#pragma unroll
            for (int m = 0; m < 4; ++m) { bf16_t* rowp = O + (size_t)(row0 + ai * HALF + m * 16) * ldc + col0;
#pragma unroll
                for (int bj = 0; bj < 2; ++bj) { const f32x4 v0 = acc[ai][bj][m][0], v1 = acc[ai][bj][m][1];
                    u32x4 w; w.x = cvt_pk_bf16(v0[0], v0[1]); w.y = cvt_pk_bf16(v0[2], v0[3]); w.z = cvt_pk_bf16(v1[0], v1[1]); w.w = cvt_pk_bf16(v1[2], v1[3]);
                    *(u32x4*)(rowp + bj * HALF) = w; } }
    }
};
struct EpiProj {
    static constexpr bool PERM = true, AFTER_DRAIN = false;
    bf16_t* O; int ldc; float* kmean; int kb_lo;
    __device__ __forceinline__ void operator()(const f32x4 (&acc)[2][2][4][2], const Unit& u, int wr, int wc, int fr, int fq) const {
        const int row0 = u.pm * BM + wr * 64 + fr, col0 = u.pn * BM + wc * 32 + 8 * fq;
#pragma unroll
        for (int ai = 0; ai < 2; ++ai)
#pragma unroll
            for (int m = 0; m < 4; ++m) { bf16_t* rowp = O + (size_t)(row0 + ai * HALF + m * 16) * ldc + col0;
#pragma unroll
                for (int bj = 0; bj < 2; ++bj) { const f32x4 v0 = acc[ai][bj][m][0], v1 = acc[ai][bj][m][1];
                    u32x4 w; w.x = cvt_pk_bf16(v0[0], v0[1]); w.y = cvt_pk_bf16(v0[2], v0[3]); w.z = cvt_pk_bf16(v1[0], v1[1]); w.w = cvt_pk_bf16(v1[2], v1[3]);
                    *(u32x4*)(rowp + bj * HALF) = w; } }
#pragma unroll
        for (int bj = 0; bj < 2; ++bj) {
            const int cb = u.pn * BM + bj * HALF;
            if (cb >= kb_lo && cb < kb_lo + 384) {
                f32x4 s0 = {0.f, 0.f, 0.f, 0.f}, s1 = {0.f, 0.f, 0.f, 0.f};
#pragma unroll
                for (int ai = 0; ai < 2; ++ai)
#pragma unroll
                    for (int m = 0; m < 4; ++m) { s0 += acc[ai][bj][m][0]; s1 += acc[ai][bj][m][1]; }
#pragma unroll
                for (int i = 0; i < 4; ++i) {
#pragma unroll
                    for (int o = 1; o < 16; o <<= 1) { s0[i] += __shfl_xor(s0[i], o); s1[i] += __shfl_xor(s1[i], o); }
                }
                if (fr == 0) {
                    const int c = cb + wc * 32 + 8 * fq - kb_lo, h = c >> 6, d = c & 63, b = u.pm >> 5, nb = u.pm & 31;
                    float* kp = kmean + ((size_t)((b * 6 + h) * 32 + nb)) * 64 + d;
#pragma unroll
                    for (int i = 0; i < 4; ++i) { atomicAdd(kp + i, s0[i]); atomicAdd(kp + 4 + i, s1[i]); }
                }
            }
        }
    }
};
struct EpiRes {
    static constexpr bool PERM = false, AFTER_DRAIN = false;
    const float* base; float* out; int ldc; const float* gate; int gstride;
    __device__ __forceinline__ void operator()(const f32x4 (&acc)[2][2][4][2], const Unit& u, int wr, int wc, int fr, int fq) const {
        const int row0 = u.pm * BM + wr * 64 + fr, col0 = u.pn * BM + wc * 32 + 4 * fq;
        const float* gp = gate + (size_t)(u.pm >> 5) * gstride + col0;
        f32x4 gv[2][2];
#pragma unroll
        for (int bj = 0; bj < 2; ++bj)
#pragma unroll
            for (int n = 0; n < 2; ++n) gv[bj][n] = *(const f32x4*)(gp + bj * HALF + n * 16);
#pragma unroll
        for (int ai = 0; ai < 2; ++ai)
#pragma unroll
            for (int m = 0; m < 4; ++m) { const size_t off = (size_t)(row0 + ai * HALF + m * 16) * ldc + col0;
#pragma unroll
                for (int bj = 0; bj < 2; ++bj)
#pragma unroll
                    for (int n = 0; n < 2; ++n) { const f32x4 bs = *(const f32x4*)(base + off + bj * HALF + n * 16);
                        *(f32x4*)(out + off + bj * HALF + n * 16) = bs + gv[bj][n] * acc[ai][bj][m][n]; } }
    }
};

template <class Epi, class Sched, bool ALIGN_EPI = false, bool SP2 = false>
__device__ __forceinline__ void gemm_phase(PG8_LAS unsigned char* lds, const Gemm g, const Sched& S, const Epi& E) {
    int tid_ = threadIdx.x; asm volatile("" : "+v"(tid_));
    const int tid = tid_, wid = __builtin_amdgcn_readfirstlane(tid >> 6), lane = tid & 63, wr = wid >> 2, wc = wid & 3, fr = lane & 15, fq = lane >> 4;
    const int K = g.K, nt = K / BK;
    unsigned voffA[2], voffB[2];
#pragma unroll
    for (int i = 0; i < 2; ++i) { int R, C; stage_rc(tid * 16 + i * 8192, R, C); const int Rb = Epi::PERM ? ((R & ~31) + perm32(R & 31)) : R;
        voffA[i] = (unsigned)(R * K + C) * 2u; voffB[i] = (unsigned)(Rb * K + C) * 2u; }
    const size_t kstep = (size_t)(BK * 2);
    const size_t hstep = (size_t)HALF * K * 2;
    const size_t tstep = 2 * hstep;
    const unsigned ldsw = (unsigned)wid * 1024u;
    const int aoff = lds_byte(wr * 64 + fr, fq * 8), boff = lds_byte(wc * 32 + fr, fq * 8);
#define PG8_SA(b, h) (((b) * 2 + (h)) * HTB)
#define PG8_SB(b, h) ((4 + (b) * 2 + (h)) * HTB)
#define PG8_STAGE(bufoff, gbase, voff) do { _Pragma("unroll") for (int _i = 0; _i < 2; ++_i) \
        __builtin_amdgcn_global_load_lds((const unsigned*)((const char*)(gbase) + (voff)[_i]), (PG8_LAS unsigned*)(lds + (bufoff) + ldsw + _i * 8192), 16, 0, 0); } while (0)
#define PG8_LDA(dst, b, h) do { _Pragma("unroll") for (int m = 0; m < 4; ++m) _Pragma("unroll") for (int k = 0; k < 2; ++k) dst[m][k] = *(const PG8_LAS bf16x8*)(lds + PG8_SA(b, h) + aoff + m * 2048 + k * 1024); } while (0)
#define PG8_LDB(dst, b, h) do { _Pragma("unroll") for (int n = 0; n < 2; ++n) _Pragma("unroll") for (int k = 0; k < 2; ++k) dst[n][k] = *(const PG8_LAS bf16x8*)(lds + PG8_SB(b, h) + boff + n * 2048 + k * 1024); } while (0)
#define PG8_MMA(ai, bj, At, Bt) do { __builtin_amdgcn_s_setprio(1); _Pragma("unroll") for (int m = 0; m < 4; ++m) _Pragma("unroll") for (int n = 0; n < 2; ++n) _Pragma("unroll") for (int k = 0; k < 2; ++k) \
        acc[ai][bj][m][n] = __builtin_amdgcn_mfma_f32_16x16x32_bf16(Bt[n][k], At[m][k], acc[ai][bj][m][n], 0, 0, 0); __builtin_amdgcn_s_setprio(0); } while (0)
#define PG8_WAIT_V(n) asm volatile("s_waitcnt vmcnt(" #n ")" ::: "memory")
#define PG8_WAIT_L(n) asm volatile("s_waitcnt lgkmcnt(" #n ")" ::: "memory")
#define PG8_BAR __builtin_amdgcn_s_barrier()
#define PG8_SCHED __builtin_amdgcn_sched_barrier(0)
    Unit cur, nxt; int ui = 0;
    if (!S.next(0, cur)) return;
    f32x4 acc[2][2][4][2];
#pragma unroll
    for (int a = 0; a < 2; ++a)
#pragma unroll
        for (int b = 0; b < 2; ++b)
#pragma unroll
            for (int m = 0; m < 4; ++m)
#pragma unroll
                for (int n = 0; n < 2; ++n) acc[a][b][m][n] = (f32x4){0.f, 0.f, 0.f, 0.f};
    bf16x8 At[4][2], B0[2][2], B1[2][2];
    const char* cA = (const char*)g.A + (size_t)cur.pm * tstep; const char* cB = (const char*)g.Bt + (size_t)cur.pn * tstep;
    S.a_ready(cur);
    if constexpr (SP2) {
        PG8_STAGE(PG8_SB(0, 0), cB, voffB); PG8_STAGE(PG8_SB(0, 1), cB + hstep, voffB); PG8_STAGE(PG8_SA(0, 0), cA, voffA); PG8_STAGE(PG8_SA(0, 1), cA + hstep, voffA);
        if (wr == 1) PG8_BAR;
        PG8_WAIT_V(2); PG8_BAR;
        PG8_STAGE(PG8_SB(1, 0), cB + kstep, voffB); PG8_STAGE(PG8_SA(1, 0), cA + kstep, voffA); PG8_STAGE(PG8_SB(1, 1), cB + hstep + kstep, voffB);
        PG8_WAIT_V(6); PG8_BAR;
    } else {
        PG8_STAGE(PG8_SB(0, 0), cB, voffB); PG8_STAGE(PG8_SA(0, 0), cA, voffA); PG8_STAGE(PG8_SB(0, 1), cB + hstep, voffB); PG8_STAGE(PG8_SA(0, 1), cA + hstep, voffA);
        if (wr == 1) PG8_BAR;
        PG8_WAIT_V(4); PG8_BAR;
        PG8_STAGE(PG8_SB(1, 0), cB + kstep, voffB); PG8_STAGE(PG8_SA(1, 0), cA + kstep, voffA); PG8_STAGE(PG8_SB(1, 1), cB + hstep + kstep, voffB);
        PG8_WAIT_V(6); PG8_BAR;
    }
    for (;;) {
        const bool has_next = S.next(ui + 1, nxt);
        const char* nA = has_next ? (const char*)g.A + (size_t)nxt.pm * tstep : cA; const char* nB = has_next ? (const char*)g.Bt + (size_t)nxt.pn * tstep : cB;
        for (int t = 0; t < nt; t += 2) {
            const bool last = (t == nt - 2);
            const char* a1 = cA + (size_t)(t + 1) * kstep;
            const char* a2 = last ? nA : cA + (size_t)(t + 2) * kstep; const char* b2 = last ? nB : cB + (size_t)(t + 2) * kstep;
            const char* a3 = a2 + kstep; const char* b3 = b2 + kstep;
            if (last && has_next) S.a_ready(nxt);
            if constexpr (SP2) {
            PG8_LDB(B0, 0, 0); PG8_LDB(B1, 0, 1); PG8_SCHED; PG8_LDA(At, 0, 0); PG8_STAGE(PG8_SA(1, 1), a1 + hstep, voffA);
            PG8_WAIT_V(8); PG8_WAIT_L(0); PG8_BAR; PG8_MMA(0, 0, At, B0); PG8_MMA(0, 1, At, B1); PG8_BAR; PG8_SCHED;
            PG8_LDA(At, 0, 1); PG8_STAGE(PG8_SB(0, 0), b2, voffB); PG8_STAGE(PG8_SB(0, 1), b2 + hstep, voffB); PG8_STAGE(PG8_SA(0, 0), a2, voffA);
            PG8_WAIT_V(8); PG8_WAIT_L(0); PG8_BAR; PG8_MMA(1, 0, At, B0); PG8_MMA(1, 1, At, B1); PG8_BAR; PG8_SCHED;
            PG8_LDB(B0, 1, 0); PG8_LDB(B1, 1, 1); PG8_SCHED; PG8_LDA(At, 1, 0); PG8_STAGE(PG8_SA(0, 1), a2 + hstep, voffA);
            PG8_WAIT_V(8); PG8_WAIT_L(0); PG8_BAR; PG8_MMA(0, 0, At, B0); PG8_MMA(0, 1, At, B1); PG8_BAR; PG8_SCHED;
            PG8_LDA(At, 1, 1); PG8_STAGE(PG8_SB(1, 0), b3, voffB); PG8_STAGE(PG8_SB(1, 1), b3 + hstep, voffB); PG8_STAGE(PG8_SA(1, 0), a3, voffA);
            PG8_WAIT_V(8); PG8_WAIT_L(0); PG8_BAR; PG8_MMA(1, 0, At, B0); PG8_MMA(1, 1, At, B1); PG8_BAR; PG8_SCHED;
            } else {
            PG8_LDB(B0, 0, 0); PG8_SCHED; PG8_LDA(At, 0, 0); PG8_STAGE(PG8_SA(1, 1), a1 + hstep, voffA);
            PG8_WAIT_L(8); PG8_BAR; PG8_WAIT_L(0); PG8_MMA(0, 0, At, B0); PG8_BAR; PG8_SCHED;
            PG8_LDB(B1, 0, 1); PG8_STAGE(PG8_SB(0, 0), b2, voffB);
            PG8_BAR; PG8_WAIT_L(0); PG8_MMA(0, 1, At, B1); PG8_BAR;
            PG8_LDA(At, 0, 1); PG8_STAGE(PG8_SA(0, 0), a2, voffA);
            PG8_BAR; PG8_WAIT_L(0); PG8_MMA(1, 0, At, B0); PG8_BAR; PG8_SCHED;
            PG8_STAGE(PG8_SB(0, 1), b2 + hstep, voffB);
            PG8_WAIT_V(6); PG8_BAR; PG8_MMA(1, 1, At, B1); PG8_BAR;
            PG8_LDB(B0, 1, 0); PG8_SCHED; PG8_LDA(At, 1, 0); PG8_STAGE(PG8_SA(0, 1), a2 + hstep, voffA);
            PG8_WAIT_L(8); PG8_BAR; PG8_WAIT_L(0); PG8_MMA(0, 0, At, B0); PG8_BAR; PG8_SCHED;
            PG8_LDB(B1, 1, 1); PG8_STAGE(PG8_SB(1, 0), b3, voffB);
            PG8_BAR; PG8_WAIT_L(0); PG8_MMA(0, 1, At, B1); PG8_BAR;
            PG8_LDA(At, 1, 1); PG8_STAGE(PG8_SA(1, 0), a3, voffA);
            PG8_BAR; PG8_WAIT_L(0); PG8_MMA(1, 0, At, B0); PG8_BAR; PG8_SCHED;
            PG8_STAGE(PG8_SB(1, 1), b3 + hstep, voffB);
            PG8_WAIT_V(6); PG8_BAR; PG8_MMA(1, 1, At, B1); PG8_BAR;
            }
        }
        if constexpr (ALIGN_EPI) { if (wr == 0) PG8_BAR; }
        if constexpr (!Epi::AFTER_DRAIN) { E(acc, cur, wr, wc, fr, fq); S.done(cur); }
        if (!has_next) break;
#pragma unroll
        for (int a = 0; a < 2; ++a)
#pragma unroll
            for (int b = 0; b < 2; ++b)
#pragma unroll
                for (int m = 0; m < 4; ++m)
#pragma unroll
                    for (int n = 0; n < 2; ++n) acc[a][b][m][n] = (f32x4){0.f, 0.f, 0.f, 0.f};
        cur = nxt; cA = nA; cB = nB; ++ui;
        if constexpr (ALIGN_EPI) { if (wr == 1) PG8_BAR; }
    }
    PG8_WAIT_V(0);
    if constexpr (!ALIGN_EPI) { if (wr == 0) PG8_BAR; }
    PG8_BAR;
    if constexpr (Epi::AFTER_DRAIN) { E.fused(acc, cur, wr, wc, fr, fq, lds, wid, lane); S.done(cur); }
#undef PG8_SA
#undef PG8_SB
#undef PG8_STAGE
#undef PG8_LDA
#undef PG8_LDB
#undef PG8_MMA
#undef PG8_WAIT_V
#undef PG8_WAIT_L
#undef PG8_BAR
#undef PG8_SCHED
}
}
namespace att {
constexpr int A_K = 0, A_V = 16384, A_WSF = 32768, A_KM = A_WSF + 2048, A_STG = A_KM + 8192;
constexpr int STG_STRIDE = 68, STG_WAVE_BYTES = 32 * STG_STRIDE * 4, A_END = A_STG + NWAVES * STG_WAVE_BYTES;
__device__ __forceinline__ int crow(int r, int hi) { return (r & 3) + 8 * (r >> 2) + 4 * hi; }
__device__ __forceinline__ void dma16(const void* g, LAS unsigned char* l) { __builtin_amdgcn_global_load_lds((const unsigned*)g, (LAS unsigned*)l, 16, 0, 0); }
typedef float f32x2_t __attribute__((ext_vector_type(2))); typedef __bf16 bf16x2_t __attribute__((ext_vector_type(2)));
__device__ __forceinline__ unsigned cvtpk(float lo, float hi) { f32x2_t v = {lo, hi}; bf16x2_t b = __builtin_convertvector(v, bf16x2_t); return __builtin_bit_cast(unsigned, b); }
typedef short v4i16_t __attribute__((ext_vector_type(4)));
__device__ __forceinline__ s16x4_t vtr(LAS const unsigned char* p) { return __builtin_bit_cast(s16x4_t, __builtin_amdgcn_ds_read_tr16_b64_v4i16((LAS v4i16_t*)p)); }
#define LDSW() asm volatile("s_waitcnt lgkmcnt(0)" ::: "memory")

template <int MODE>
__device__ __forceinline__ void attn_unit(int b, int h, int qb, const bf16_t* __restrict__ proj, bf16_t* __restrict__ Obuf, const float* __restrict__ kmean,
                                          float lam, float lam_init, const float* __restrict__ subg, float sinkv, LAS unsigned char* lds) {
    constexpr int NMAP = (MODE == 0) ? 2 : 1;
    int tid_ = threadIdx.x; asm volatile("" : "+v"(tid_));
    const int tid = tid_, lane = tid & 63, r32 = lane & 31, hi = lane >> 5;
    const int wid = __builtin_amdgcn_readfirstlane(tid >> 6);
    const int q0 = qb * 256;
    int qcol, kcol, vcol, ocol; float slope;
    if (MODE == 0) { qcol = OFF_QA + h * 64; kcol = OFF_KA + h * 64; vcol = OFF_VA + h * 64; ocol = h * 64; slope = alibi_slope(6 + h); }
    else if (MODE == 1) { qcol = OFF_QB + h * 64; kcol = OFF_KB + h * 64; vcol = OFF_VB + h * 64; ocol = 256 + h * 64; slope = alibi_slope(10 + h); }
    else { qcol = OFF_QC + h * 64; kcol = OFF_KC + (h / 3) * 64; vcol = OFF_VC + (h / 3) * 64; ocol = 640 + h * 64; slope = alibi_slope(h); }
    const float slope2 = slope * LOG2E;
    const float cscale = (MODE == 0 ? 0.17677669529663687f : 0.125f) * LOG2E;
    const bf16_t* base = proj + (size_t)b * SEQ * INW;
    const int t_hi = 4 * qb + 4, t_lo = (MODE == 2) ? (qb > 0 ? 4 * qb - 2 : 0) : 0;
    const bf16_t* ksrc = base + kcol + (size_t)lane * INW + wid * 8;
    const bf16_t* vsrc = base + vcol + (size_t)(16 * (wid & 3) + (lane >> 2)) * INW + (wid >> 2) * 32 + (lane & 3) * 8;
#define DMA_TILE(t, bufi) do { dma16(ksrc + (size_t)(t) * 64 * INW, lds + A_K + (bufi) * 8192 + wid * 1024); dma16(vsrc + (size_t)(t) * 64 * INW, lds + A_V + (bufi) * 8192 + wid * 1024); } while (0)
    DMA_TILE(t_lo, 0);
    const bf16_t* Qw = base + (size_t)(q0 + wid * 32 + r32) * INW + qcol;
    bf16x8_t qr[4];
#pragma unroll
    for (int d0 = 0; d0 < 4; ++d0) qr[d0] = *(const bf16x8_t*)(Qw + d0 * 16 + hi * 8);
    const int qrel = wid * 32 + r32;
    const LAS unsigned char* qlds = lds + A_STG + wid * STG_WAVE_BYTES + lane * 16;
    if (MODE == 0) {
#pragma unroll
        for (int d0 = 0; d0 < 4; ++d0) *(LAS bf16x8_t*)(lds + A_STG + wid * STG_WAVE_BYTES + lane * 16 + d0 * 1024) = qr[d0];
    }
    unsigned rowmask = 0u;
    if (MODE == 1) {
        LAS float* km = (LAS float*)(lds + A_KM);
        const float* kmg = kmean + (size_t)((b * 6 + h) * 32) * 64;
        for (int i = tid; i < 2048; i += NTHREADS) km[i] = kmg[i] * (1.0f / 256.0f);
        __syncthreads();
        if (qb > 0) {
            float qf[32];
#pragma unroll
            for (int d0 = 0; d0 < 4; ++d0)
#pragma unroll
                for (int j = 0; j < 8; ++j) qf[d0 * 8 + j] = __builtin_bit_cast(float, ((unsigned)(unsigned short)qr[d0][j]) << 16);
            float v0 = -INFINITY, v1 = -INFINITY, v2 = -INFINITY; int i0 = 0, i1 = 0, i2 = 0;
            for (int n = 0; n < qb; ++n) {
                const LAS float* kp = km + n * 64 + 8 * hi;
                float part = 0.f;
#pragma unroll
                for (int d0 = 0; d0 < 4; ++d0) {
                    const f32x4_t a = *(const LAS f32x4_t*)(kp + d0 * 16), c = *(const LAS f32x4_t*)(kp + d0 * 16 + 4);
                    part += qf[d0 * 8 + 0] * a[0]; part += qf[d0 * 8 + 1] * a[1]; part += qf[d0 * 8 + 2] * a[2]; part += qf[d0 * 8 + 3] * a[3];
                    part += qf[d0 * 8 + 4] * c[0]; part += qf[d0 * 8 + 5] * c[1]; part += qf[d0 * 8 + 6] * c[2]; part += qf[d0 * 8 + 7] * c[3];
                }
                const float tot = part + swap32_partner(part, hi);
                if (tot > v0) { v2 = v1; i2 = i1; v1 = v0; i1 = i0; v0 = tot; i0 = n; }
                else if (tot > v1) { v2 = v1; i2 = i1; v1 = tot; i1 = n; }
                else if (tot > v2) { v2 = tot; i2 = n; }
            }
            if (v0 > -INFINITY) rowmask |= 1u << i0;
            if (v1 > -INFINITY) rowmask |= 1u << i1;
            if (v2 > -INFINITY) rowmask |= 1u << i2;
        }
    }
    float m_[NMAP], l_[NMAP]; f32x16_t o[NMAP][2];
#pragma unroll
    for (int mi = 0; mi < NMAP; ++mi) { m_[mi] = -INFINITY; l_[mi] = 0.f;
#pragma unroll
        for (int d0 = 0; d0 < 2; ++d0)
#pragma unroll
            for (int r = 0; r < 16; ++r) o[mi][d0][r] = 0.f; }
    LAS float* wsf = (LAS float*)(lds + A_WSF) + wid * 64;
    const int vlane = ((lane >> 4) & 1) * 32 + (lane & 3) * 8 + (4 * hi + ((lane & 15) >> 2)) * 64;

    for (int t = t_lo; t < t_hi; ++t) {
        const int bufi = (t - t_lo) & 1;
        asm volatile("s_waitcnt vmcnt(0)" ::: "memory");
        __syncthreads();
        if (t + 1 < t_hi) DMA_TILE(t + 1, bufi ^ 1);
        const int krel0 = 64 * t - q0;
        bool need = krel0 <= wid * 32 + 31;
        if (MODE == 2) need = need && (krel0 + 63 >= wid * 32 - 127);
        const bool past = (MODE == 1) && ((t >> 2) < qb);
        if (past) need = __any((int)((rowmask >> (t >> 2)) & 1u)) != 0;
        if (!need) continue;
        const bool diag = krel0 + 63 > wid * 32;
        const int kb = krel0 + 4 * hi;
        const LAS unsigned char* Ks = lds + A_K + bufi * 8192 + hi * 1024 + r32 * 16;
        const LAS unsigned char* Vs = lds + A_V + bufi * 8192 + vlane;
#pragma unroll
        for (int mi = 0; mi < NMAP; ++mi) {
            f32x16_t p0, p1;
#pragma unroll
            for (int r = 0; r < 16; ++r) { p0[r] = 0.f; p1[r] = 0.f; }
            constexpr int ND0 = (MODE == 0) ? 2 : 4;
#pragma unroll
            for (int dd = 0; dd < ND0; ++dd) {
                const int d0 = (MODE == 0) ? (2 * mi + dd) : dd;
                const bf16x8_t b0 = *(const LAS bf16x8_t*)(Ks + d0 * 2048);
                const bf16x8_t b1 = *(const LAS bf16x8_t*)(Ks + d0 * 2048 + 512);
                const bf16x8_t qa = (MODE == 0) ? *(const LAS bf16x8_t*)(qlds + d0 * 1024) : qr[d0];
                p0 = __builtin_amdgcn_mfma_f32_32x32x16_bf16(b0, qa, p0, 0, 0, 0);
                p1 = __builtin_amdgcn_mfma_f32_32x32x16_bf16(b1, qa, p1, 0, 0, 0);
            }
            float sl2 = slope2; asm volatile("" : "+v"(sl2));
            const float tb = sl2 * (float)kb;
#pragma unroll
            for (int r = 0; r < 16; ++r) { const int kk = (r & 3) + 8 * (r >> 2); const float bias = tb + sl2 * (float)kk;
                p0[r] = p0[r] * cscale + bias; p1[r] = p1[r] * cscale + (bias + sl2 * 32.0f); }
            if (diag) {
#pragma unroll
                for (int r = 0; r < 16; ++r) { const int kk = kb + (r & 3) + 8 * (r >> 2); if (kk > qrel) p0[r] = -INFINITY; if (kk + 32 > qrel) p1[r] = -INFINITY; }
            }
            if (MODE == 2) {
#pragma unroll
                for (int r = 0; r < 16; ++r) { const int kk = kb + (r & 3) + 8 * (r >> 2); if (qrel - kk >= 128) p0[r] = -INFINITY; if (qrel - (kk + 32) >= 128) p1[r] = -INFINITY; }
            }
            if (past) { if (!((rowmask >> (t >> 2)) & 1u)) {
#pragma unroll
                for (int r = 0; r < 16; ++r) { p0[r] = -INFINITY; p1[r] = -INFINITY; } } }
            float mx = fmaxf(p0[0], p1[0]);
#pragma unroll
            for (int r = 1; r < 16; ++r) mx = fmaxf(mx, fmaxf(p0[r], p1[r]));
            mx = fmaxf(mx, __shfl_xor(mx, 32));
            const float mnew = fmaxf(m_[mi], mx), msafe = (mnew == -INFINITY) ? 0.f : mnew;
            const float f = __builtin_amdgcn_exp2f(m_[mi] - msafe);
            float ps = 0.f;
#pragma unroll
            for (int r = 0; r < 16; ++r) { p0[r] = __builtin_amdgcn_exp2f(p0[r] - msafe); p1[r] = __builtin_amdgcn_exp2f(p1[r] - msafe); ps += p0[r] + p1[r]; }
            l_[mi] = l_[mi] * f + ps; m_[mi] = mnew;
            if (__any(f != 1.0f)) {
                if (hi == 0) wsf[mi * 32 + r32] = f;
                LDSW();
#pragma unroll
                for (int r = 0; r < 16; ++r) { const float fr_ = wsf[mi * 32 + crow(r, hi)]; o[mi][0][r] *= fr_; o[mi][1][r] *= fr_; }
            }
            u32x4_t pw[4];
#pragma unroll
            for (int j = 0; j < 4; ++j) { pw[0][j] = cvtpk(p0[2 * j], p0[2 * j + 1]); pw[1][j] = cvtpk(p0[8 + 2 * j], p0[8 + 2 * j + 1]);
                                          pw[2][j] = cvtpk(p1[2 * j], p1[2 * j + 1]); pw[3][j] = cvtpk(p1[8 + 2 * j], p1[8 + 2 * j + 1]); }
#pragma unroll
            for (int d0 = 0; d0 < 2; ++d0) {
                if (d0) __builtin_amdgcn_sched_barrier(0);
#pragma unroll
                for (int ks = 0; ks < 4; ++ks) {
                    const s16x4_t lo = vtr(Vs + d0 * 4096 + ks * 1024), hh = vtr(Vs + d0 * 4096 + ks * 1024 + 512);
                    const bf16x8_t vf = {lo[0], lo[1], lo[2], lo[3], hh[0], hh[1], hh[2], hh[3]};
                    o[mi][d0] = __builtin_amdgcn_mfma_f32_32x32x16_bf16(__builtin_bit_cast(bf16x8_t, pw[ks]), vf, o[mi][d0], 0, 0, 0);
                }
            }
            if (NMAP > 1) __builtin_amdgcn_sched_barrier(0);
        }
    }
#undef DMA_TILE
    float rl[NMAP][16];
#pragma unroll
    for (int mi = 0; mi < NMAP; ++mi) {
        float lt = l_[mi];
        lt += __shfl_xor(lt, 32);
        if (MODE == 2) lt += __builtin_amdgcn_exp2f(sinkv * LOG2E + slope2 * (float)qrel - m_[mi]);
        if (hi == 0) wsf[mi * 32 + r32] = 1.0f / lt;
    }
    LDSW();
#pragma unroll
    for (int mi = 0; mi < NMAP; ++mi)
#pragma unroll
        for (int r = 0; r < 16; ++r) rl[mi][r] = wsf[mi * 32 + crow(r, hi)];
    LAS float* stg = (LAS float*)(lds + A_STG + wid * STG_WAVE_BYTES);
#pragma unroll
    for (int d0 = 0; d0 < 2; ++d0)
#pragma unroll
        for (int r = 0; r < 16; ++r) {
            float v = o[0][d0][r] * rl[0][r];
            if (MODE == 0) v -= lam * (o[NMAP - 1][d0][r] * rl[NMAP - 1][r]);
            stg[crow(r, hi) * STG_STRIDE + d0 * 32 + r32] = v;
        }
    LDSW();
    {
        const int row = lane >> 1, half = lane & 1;
        float v[32];
#pragma unroll
        for (int i = 0; i < 8; ++i) { const f32x4_t x = *(const LAS f32x4_t*)(stg + row * STG_STRIDE + half * 32 + i * 4); v[4 * i] = x[0]; v[4 * i + 1] = x[1]; v[4 * i + 2] = x[2]; v[4 * i + 3] = x[3]; }
        if (MODE == 0) {
            float ss = 0.f;
#pragma unroll
            for (int i = 0; i < 32; ++i) ss += v[i] * v[i];
            ss += __shfl_xor(ss, 1);
            const float rs = (1.0f / sqrtf(ss * (1.0f / 64.0f) + EPS)) * (1.0f - lam_init);
#pragma unroll
            for (int i = 0; i < 32; ++i) v[i] = v[i] * rs * subg[half * 32 + i];
        }
        bf16_t* op = Obuf + (size_t)(b * SEQ + q0 + wid * 32 + row) * DM + ocol + half * 32;
#pragma unroll
        for (int i = 0; i < 4; ++i) { u32x4_t w; w.x = cvtpk(v[8 * i], v[8 * i + 1]); w.y = cvtpk(v[8 * i + 2], v[8 * i + 3]); w.z = cvtpk(v[8 * i + 4], v[8 * i + 5]); w.w = cvtpk(v[8 * i + 6], v[8 * i + 7]);
            *(u32x4_t*)(op + 8 * i) = w; }
    }
    __syncthreads();
}
#undef LDSW
}

namespace peer {
constexpr int K_BYTES = 2 * 32768;
__device__ __forceinline__ int crow(int r, int hi) { return (r & 3) + 8 * (r >> 2) + 4 * hi; }

template <int N>
__device__ __forceinline__ void top16_pair(float (&s)[N], float (&out)[16], bool pair) {
#pragma unroll
    for (int it = 0; it < 16; ++it) {
        float mx = s[0];
#pragma unroll
        for (int i = 1; i < N; ++i) mx = fmaxf(mx, s[i]);
        if (pair) mx = fmaxf(mx, __shfl_xor(mx, 32));
        out[it] = mx;
#pragma unroll
        for (int i = 0; i < N; ++i) s[i] = (s[i] == mx) ? -INFINITY : s[i];
    }
}
__device__ __forceinline__ float pack_idx(float v, unsigned idx, unsigned mask) { return __builtin_bit_cast(float, (__builtin_bit_cast(unsigned, v) & ~mask) | idx); }
__device__ __forceinline__ unsigned byte16(unsigned t0, unsigned t1, unsigned t2, unsigned t3, unsigned i) {
    const unsigned s = i & 7u, a = __builtin_amdgcn_perm(t1, t0, s), b = __builtin_amdgcn_perm(t3, t2, s);
    return ((i & 8u) ? b : a) & 0xffu;
}

__device__ __forceinline__ void pk_unit(int tile, int h, const bf16_t* __restrict__ Q, const bf16_t* __restrict__ keysb, int* __restrict__ Eid, float* __restrict__ Gw, LAS unsigned char* lds) {
    int tid_ = threadIdx.x; asm volatile("" : "+v"(tid_));
    const int tid = tid_, lane = tid & 63, r32 = lane & 31, hi = lane >> 5;
    const int wid = __builtin_amdgcn_readfirstlane(tid >> 6);
    __syncthreads();
    {
        const bf16_t* kg = keysb + (size_t)h * 2 * 128 * 128;
        for (int i = tid; i < 2 * 128 * 16; i += NTHREADS) {
            const int n = i & 127, c = (i >> 7) & 15, p = i >> 11;
            const u32x4_t v = *(const u32x4_t*)(kg + ((size_t)(p * 128 + n)) * 128 + c * 8);
            *(LAS u32x4_t*)(lds + p * 32768 + c * 2048 + n * 16) = v;
        }
    }
    __syncthreads();
    const int tok = tile * 256 + wid * 32 + r32;
    float sv[2][16];
#pragma unroll
    for (int p = 0; p < 2; ++p) {
        const bf16_t* qp = Q + (size_t)tok * PQW + h * 256 + p * 128 + hi * 8;
        bf16x8_t qf[8];
#pragma unroll
        for (int ks = 0; ks < 8; ++ks) qf[ks] = *(const bf16x8_t*)(qp + ks * 16);
        float s[64];
#pragma unroll
        for (int blk = 0; blk < 4; ++blk) {
            f32x16_t acc;
#pragma unroll
            for (int r = 0; r < 16; ++r) acc[r] = 0.f;
#pragma unroll
            for (int ks = 0; ks < 8; ++ks) {
                const bf16x8_t kf = *(const LAS bf16x8_t*)(lds + p * 32768 + (2 * ks + hi) * 2048 + (blk * 32 + r32) * 16);
                acc = __builtin_amdgcn_mfma_f32_32x32x16_bf16(kf, qf[ks], acc, 0, 0, 0);
            }
#pragma unroll
            for (int r = 0; r < 16; ++r) s[blk * 16 + r] = pack_idx(acc[r], (unsigned)(blk * 32 + (r & 3) + 8 * (r >> 2) + 4 * hi), 127u);
        }
        top16_pair<64>(s, sv[p], true);
    }
    float cand[50];
    {
        int c = 0;
#pragma unroll
        for (int i = 0; i < 16; ++i)
#pragma unroll
            for (int j = 0; j < 16; ++j)
                if ((i + 1) * (j + 1) <= 16) { cand[c] = pack_idx(sv[0][i] + sv[1][j], (unsigned)(i * 16 + j), 255u); ++c; }
    }
    float top[16];
    top16_pair<50>(cand, top, false);
    unsigned t1[4], t2[4];
#pragma unroll
    for (int j = 0; j < 4; ++j) { t1[j] = 0u; t2[j] = 0u;
#pragma unroll
        for (int k = 0; k < 4; ++k) { t1[j] |= (__builtin_bit_cast(unsigned, sv[0][4 * j + k]) & 127u) << (8 * k); t2[j] |= (__builtin_bit_cast(unsigned, sv[1][4 * j + k]) & 127u) << (8 * k); } }
    float g[16]; int e[16]; float gs = 0.f;
#pragma unroll
    for (int k = 0; k < 16; ++k) {
        const unsigned code = __builtin_bit_cast(unsigned, top[k]) & 255u;
        e[k] = (int)(byte16(t1[0], t1[1], t1[2], t1[3], code >> 4) * 128u + byte16(t2[0], t2[1], t2[2], t2[3], code & 15u));
        g[k] = __expf(top[k] - top[0]); gs += g[k];
    }
    const float gi = 1.0f / gs;
    if (hi == 0) {
        int* ep = Eid + ((size_t)tok * PHEADS + h) * 16; float* gp = Gw + ((size_t)tok * PHEADS + h) * 16;
#pragma unroll
        for (int k = 0; k < 16; k += 4) {
            *(int4*)(ep + k) = make_int4(e[k], e[k + 1], e[k + 2], e[k + 3]);
            *(float4*)(gp + k) = make_float4(g[k] * gi, g[k + 1] * gi, g[k + 2] * gi, g[k + 3] * gi);
        }
    }
}

__device__ __forceinline__ float reduce16(float (&a)[16], int lane) {
    float b8[8];
    { const bool up = lane & 1;
#pragma unroll
      for (int i = 0; i < 8; ++i) { const float keep = up ? a[8 + i] : a[i], give = up ? a[i] : a[8 + i]; b8[i] = keep + __shfl_xor(give, 1); } }
    float b4[4];
    { const bool up = lane & 2;
#pragma unroll
      for (int i = 0; i < 4; ++i) { const float keep = up ? b8[4 + i] : b8[i], give = up ? b8[i] : b8[4 + i]; b4[i] = keep + __shfl_xor(give, 2); } }
    float b2[2];
    { const bool up = lane & 4;
#pragma unroll
      for (int i = 0; i < 2; ++i) { const float keep = up ? b4[2 + i] : b4[i], give = up ? b4[i] : b4[2 + i]; b2[i] = keep + __shfl_xor(give, 4); } }
    float b1;
    { const bool up = lane & 8; const float keep = up ? b2[1] : b2[0], give = up ? b2[0] : b2[1]; b1 = keep + __shfl_xor(give, 8); }
    b1 += __shfl_xor(b1, 16); b1 += __shfl_xor(b1, 32);
    return b1;
}
__device__ __forceinline__ int red16_index(int lane) { return 8 * (lane & 1) + 4 * ((lane >> 1) & 1) + 2 * ((lane >> 2) & 1) + ((lane >> 3) & 1); }

__device__ __forceinline__ void pg_token(int tok, float* __restrict__ xres, const LAS float* tab2  , const float* __restrict__ g2  , int gstride,
                                         const int* __restrict__ Eid, const float* __restrict__ Gw, const bf16_t* __restrict__ U, const bf16_t* __restrict__ V,
                                         bool last, const LAS float* tabn  , const float* __restrict__ final_g, bf16_t* __restrict__ Hn, float* __restrict__ outp, int lane) {
    const int b = tok >> 13;
    float x[16];
    float* xp = xres + (size_t)tok * DM + 8 * lane;
#pragma unroll
    for (int j = 0; j < 2; ++j) { const f32x4_t a = *(const f32x4_t*)(xp + 512 * j), c = *(const f32x4_t*)(xp + 512 * j + 4);
        x[8 * j] = a[0]; x[8 * j + 1] = a[1]; x[8 * j + 2] = a[2]; x[8 * j + 3] = a[3]; x[8 * j + 4] = c[0]; x[8 * j + 5] = c[1]; x[8 * j + 6] = c[2]; x[8 * j + 7] = c[3]; }
    float ss = 0.f;
#pragma unroll
    for (int i = 0; i < 16; ++i) ss += x[i] * x[i];
    const float rstd = 1.0f / sqrtf(wave_sum(ss) * (1.0f / DM) + EPS);
    float hh[16];
#pragma unroll
    for (int j = 0; j < 2; ++j)
#pragma unroll
        for (int i = 0; i < 8; ++i) { const int k = 8 * lane + 512 * j + i; hh[8 * j + i] = x[8 * j + i] * rstd * tab2[(b * 2 + 0) * 1024 + k] + tab2[(b * 2 + 1) * 1024 + k]; }
    float out[16];
#pragma unroll
    for (int i = 0; i < 16; ++i) out[i] = 0.f;
    const int ridx = red16_index(lane);
    for (int hd = 0; hd < PHEADS; ++hd) {
        const int ev = Eid[((size_t)tok * PHEADS + hd) * 16 + (lane & 15)];
        const float gv = Gw[((size_t)tok * PHEADS + hd) * 16 + ridx];
        float a[16];
#pragma unroll
        for (int half = 0; half < 2; ++half) {
            u32x4_t w[8][2];
#pragma unroll
            for (int k = 0; k < 8; ++k) { const int e = __builtin_amdgcn_readlane(ev, half * 8 + k); const bf16_t* up = U + (size_t)e * DM + 8 * lane;
                w[k][0] = *(const u32x4_t*)up; w[k][1] = *(const u32x4_t*)(up + 512); }
#pragma unroll
            for (int k = 0; k < 8; ++k) { float acc = 0.f;
#pragma unroll
                for (int j = 0; j < 2; ++j)
#pragma unroll
                    for (int q = 0; q < 4; ++q) { acc += hh[8 * j + 2 * q] * bf_lo(w[k][j][q]); acc += hh[8 * j + 2 * q + 1] * bf_hi(w[k][j][q]); }
                a[half * 8 + k] = acc; }
        }
        const float dot = reduce16(a, lane);
        const float wgt = gv * 0.5f * dot * (1.0f + erff(dot * 0.70710678118654752f));
#pragma unroll
        for (int half = 0; half < 2; ++half) {
            u32x4_t w[8][2];
#pragma unroll
            for (int k = 0; k < 8; ++k) { const int e = __builtin_amdgcn_readlane(ev, half * 8 + k); const bf16_t* vp = V + (size_t)e * DM + 8 * lane;
                w[k][0] = *(const u32x4_t*)vp; w[k][1] = *(const u32x4_t*)(vp + 512); }
#pragma unroll
            for (int k = 0; k < 8; ++k) { const int kk = half * 8 + k;
                const int src = ((kk >> 3) & 1) | (((kk >> 2) & 1) << 1) | (((kk >> 1) & 1) << 2) | ((kk & 1) << 3);
                const float wk = __builtin_bit_cast(float, __builtin_amdgcn_readlane(__builtin_bit_cast(int, wgt), src));
#pragma unroll
                for (int j = 0; j < 2; ++j)
#pragma unroll
                    for (int q = 0; q < 4; ++q) { out[8 * j + 2 * q] += wk * bf_lo(w[k][j][q]); out[8 * j + 2 * q + 1] += wk * bf_hi(w[k][j][q]); } }
        }
    }
    float y[16]; float s2 = 0.f;
#pragma unroll
    for (int j = 0; j < 2; ++j)
#pragma unroll
        for (int i = 0; i < 8; ++i) { const int k = 8 * lane + 512 * j + i; y[8 * j + i] = x[8 * j + i] + g2[(size_t)b * gstride + k] * out[8 * j + i]; s2 += y[8 * j + i] * y[8 * j + i]; }
    const float rn = 1.0f / sqrtf(wave_sum(s2) * (1.0f / DM) + EPS);
    if (!last) {
#pragma unroll
        for (int j = 0; j < 2; ++j) { *(f32x4_t*)(xp + 512 * j) = (f32x4_t){y[8 * j], y[8 * j + 1], y[8 * j + 2], y[8 * j + 3]}; *(f32x4_t*)(xp + 512 * j + 4) = (f32x4_t){y[8 * j + 4], y[8 * j + 5], y[8 * j + 6], y[8 * j + 7]}; }
        bf16_t* hp = Hn + (size_t)tok * DM + 8 * lane;
#pragma unroll
        for (int j = 0; j < 2; ++j) { float z[8];
#pragma unroll
            for (int i = 0; i < 8; ++i) { const int k = 8 * lane + 512 * j + i; z[i] = y[8 * j + i] * rn * tabn[(b * 2 + 0) * 1024 + k] + tabn[(b * 2 + 1) * 1024 + k]; }
            u32x4_t wv; wv.x = pk2(z[0], z[1]); wv.y = pk2(z[2], z[3]); wv.z = pk2(z[4], z[5]); wv.w = pk2(z[6], z[7]); *(u32x4_t*)(hp + 512 * j) = wv; }
    } else {
        float* op = outp + (size_t)tok * DM + 8 * lane;
#pragma unroll
        for (int j = 0; j < 2; ++j) { float z[8];
#pragma unroll
            for (int i = 0; i < 8; ++i) { z[i] = y[8 * j + i] * rn * final_g[8 * lane + 512 * j + i]; if (!(fabsf(z[i]) < 1e30f)) z[i] = 0.f; }
            *(f32x4_t*)(op + 512 * j) = (f32x4_t){z[0], z[1], z[2], z[3]}; *(f32x4_t*)(op + 512 * j + 4) = (f32x4_t){z[4], z[5], z[6], z[7]}; }
    }
}
}

constexpr int LDS_BYTES = 131072;
#define DBG_BASE 0
#ifndef ATM
#define ATM 7
#endif
#ifndef MK_N_LAUNCHES
#define MK_N_LAUNCHES 16
#endif
constexpr int N_PHASES = 2 + 7 * DEPTH;

struct Args { const float* in[19]; float* out; unsigned char* ws; int ph_lo, ph_hi; };
enum { I_X = 0, I_C, I_N1G, I_N2G, I_WADA, I_BADA, I_WIN, I_WOUT, I_LQ1, I_LK1, I_LQ2, I_LK2, I_SUBG, I_SINK, I_PWQ, I_PKEYS, I_PU, I_PV, I_FG };

__device__ __forceinline__ void p0_transpose_item(const float* W, int K, int N, bf16_t* WT, LAS float* scr, int item, int lane) {
    const int nblk = N / 32, kb = item / nblk, nb = item % nblk, k0 = 64 * kb, n0 = 32 * nb;
#pragma unroll 8
    for (int i = 0; i < 32; ++i) { const int kk = 2 * i + (lane >> 5); scr[kk * 33 + (lane & 31)] = W[(size_t)(k0 + kk) * N + n0 + (lane & 31)]; }
    asm volatile("s_waitcnt lgkmcnt(0)" ::: "memory");
    const int c = lane & 7;
#pragma unroll
    for (int j = 0; j < 4; ++j) { const int n = (lane >> 3) + 8 * j; const LAS float* s = scr + (8 * c) * 33 + n;
        u32x4_t o; o.x = pk2(s[0 * 33], s[1 * 33]); o.y = pk2(s[2 * 33], s[3 * 33]); o.z = pk2(s[4 * 33], s[5 * 33]); o.w = pk2(s[6 * 33], s[7 * 33]);
        *(u32x4_t*)(WT + (size_t)(n0 + n) * K + k0 + 8 * c) = o; }
    asm volatile("s_waitcnt lgkmcnt(0)" ::: "memory");
}
__device__ __forceinline__ void cvt_rows(const float* src, bf16_t* dst, size_t n, size_t gtid, size_t gthreads) {
    for (size_t i = gtid * 8; i < n; i += gthreads * 8) {
        const f32x4_t a = *(const f32x4_t*)(src + i), c = *(const f32x4_t*)(src + i + 4);
        u32x4_t o; o.x = pk2(a[0], a[1]); o.y = pk2(a[2], a[3]); o.z = pk2(c[0], c[1]); o.w = pk2(c[2], c[3]);
        *(u32x4_t*)(dst + i) = o;
    }
}
__device__ __forceinline__ void build_table(LAS float* tab, const float* gvec, const float* mod_l, int sh_idx, int sc_idx) {
    for (int i = threadIdx.x; i < 4096; i += NTHREADS) { const int b = i >> 10, k = i & 1023;
        tab[(b * 2 + 0) * 1024 + k] = gvec[k] * (1.0f + mod_l[b * 6144 + sc_idx * 1024 + k]);
        tab[(b * 2 + 1) * 1024 + k] = mod_l[b * 6144 + sh_idx * 1024 + k]; }
}
__device__ __forceinline__ void norm_row(const float* xrow, bf16_t* orow, const LAS float* tab, int b, int lane) {
    const f32x4_t* xr = (const f32x4_t*)xrow + lane;
    f32x4_t v[4]; float s = 0.f;
#pragma unroll
    for (int j = 0; j < 4; ++j) { v[j] = xr[64 * j]; s += (v[j][0] * v[j][0] + v[j][1] * v[j][1]) + (v[j][2] * v[j][2] + v[j][3] * v[j][3]); }
    const float rstd = 1.0f / sqrtf(wave_sum(s) * (1.0f / DM) + EPS);
    unsigned long long* o8 = (unsigned long long*)orow + lane;
#pragma unroll
    for (int j = 0; j < 4; ++j) { const int k = 4 * lane + 256 * j;
        const f32x4_t g = *(const LAS f32x4_t*)(tab + (b * 2 + 0) * 1024 + k), sh = *(const LAS f32x4_t*)(tab + (b * 2 + 1) * 1024 + k);
        const f32x4_t y = v[j] * rstd * g + sh;
        o8[64 * j] = (unsigned long long)pk2(y[0], y[1]) | ((unsigned long long)pk2(y[2], y[3]) << 32); }
}

__global__ void __launch_bounds__(NTHREADS, 2) hymba_fwd(Args args) {
    extern __shared__ __attribute__((aligned(16))) unsigned char lds_raw[];
    LAS unsigned char* lds = (LAS unsigned char*)lds_raw;
    cg::grid_group grid = cg::this_grid();
    const int tid = threadIdx.x;
#define OPAQUE_LANE() int lane; { int t_ = threadIdx.x; asm volatile("" : "+v"(t_)); lane = t_ & 63; }
    const int wave = __builtin_amdgcn_readfirstlane(tid >> 6);
    const int G = gridDim.x, bx = blockIdx.x;
    const int gw = bx * NWAVES + wave, NGW = G * NWAVES;
    unsigned char* ws = args.ws;
    bf16_t* Wt_in = (bf16_t*)(ws + WS_WIN); bf16_t* Wt_out = (bf16_t*)(ws + WS_WOUT); bf16_t* Wt_q = (bf16_t*)(ws + WS_WQ); bf16_t* keysb = (bf16_t*)(ws + WS_KEYS);
    float* modf = (float*)(ws + WS_MOD); float* kmean = (float*)(ws + WS_KMEAN); float* scal = (float*)(ws + WS_SCAL);
    bf16_t* Ub = (bf16_t*)(ws + WS_U); bf16_t* Vb = (bf16_t*)(ws + WS_V); bf16_t* Hb = (bf16_t*)(ws + WS_H);
    bf16_t* Pj = (bf16_t*)(ws + WS_PROJ); bf16_t* Qp = (bf16_t*)(ws + WS_PROJ); bf16_t* Ob = (bf16_t*)(ws + WS_O);
    int* Eid = (int*)(ws + WS_O); float* Gw = (float*)(ws + WS_O + 16 * MiB);
    const int lo = args.ph_lo, hi_ = args.ph_hi;
#ifndef PHMASK
#define PHMASK 0xffffu
#endif
#define IN(k) (((PHMASK >> ((k) < 2 ? (k) : 2 + ((k) - 2) % 7)) & 1u) && lo <= (k) && (k) < hi_)
#define SEAM(k) do { if (IN(k) && IN((k) + 1)) grid.sync(); } while (0)

    if (IN(0)) {
        OPAQUE_LANE();
        if (bx < 192) {
            LAS float* cs = (LAS float*)lds;
            LAS float* red = (LAS float*)(lds + 16384);
            for (int i = tid; i < 4096; i += NTHREADS) { const float cv = args.in[I_C][i]; cs[i] = cv / (1.0f + __expf(-cv)); }
            __syncthreads();
            for (int it = bx; it < 192; it += G) {
                const int l = it / 96, n = (it % 96) * 64 + lane;
                const float* wp = args.in[I_WADA] + (size_t)l * DM * 6144 + n;
                float a0 = 0.f, a1 = 0.f, a2 = 0.f, a3 = 0.f;
#pragma unroll 8
                for (int k = wave * 128; k < wave * 128 + 128; ++k) { const float wv = wp[(size_t)k * 6144]; a0 += cs[k] * wv; a1 += cs[1024 + k] * wv; a2 += cs[2048 + k] * wv; a3 += cs[3072 + k] * wv; }
                red[(wave * 4 + 0) * 64 + lane] = a0; red[(wave * 4 + 1) * 64 + lane] = a1; red[(wave * 4 + 2) * 64 + lane] = a2; red[(wave * 4 + 3) * 64 + lane] = a3;
                __syncthreads();
                if (wave < 4) { float s = args.in[I_BADA][l * 6144 + n];
#pragma unroll
                    for (int w = 0; w < 8; ++w) s += red[(w * 4 + wave) * 64 + lane];
                    modf[((size_t)l * 4 + wave) * 6144 + n] = s; }
                __syncthreads();
            }
        }
        __syncthreads();
        {
            LAS float* scr = (LAS float*)(lds + wave * 16384);
            constexpr int I_IN = 16 * (INW / 32), I_OUT = 16 * (DM / 32), I_Q = 16 * (PQW / 32), PER_L = I_IN + I_OUT + I_Q;
            for (int it = gw; it < DEPTH * PER_L; it += NGW) {
                const int l = it / PER_L; int r = it % PER_L;
                if (r < I_IN) { p0_transpose_item(args.in[I_WIN] + (size_t)l * DM * INW, DM, INW, Wt_in + (size_t)l * INW * DM, scr, r, lane); continue; } r -= I_IN;
                if (r < I_OUT) { p0_transpose_item(args.in[I_WOUT] + (size_t)l * DM * DM, DM, DM, Wt_out + (size_t)l * DM * DM, scr, r, lane); continue; } r -= I_OUT;
                p0_transpose_item(args.in[I_PWQ] + (size_t)l * DM * PQW, DM, PQW, Wt_q + (size_t)l * PQW * DM, scr, r, lane);
            }
        }
        {
            const size_t gtid = (size_t)bx * NTHREADS + tid, gth = (size_t)G * NTHREADS;
            cvt_rows(args.in[I_PKEYS], keysb, (size_t)DEPTH * PHEADS * 2 * 128 * 128, gtid, gth);
            cvt_rows(args.in[I_PU], Ub, (size_t)DEPTH * PNEXP * DM, gtid, gth);
            cvt_rows(args.in[I_PV], Vb, (size_t)DEPTH * PNEXP * DM, gtid, gth);
            for (size_t i = gtid; i < (size_t)DEPTH * 4 * 6 * 32 * 64; i += gth) kmean[i] = 0.f;
            if (gtid < DEPTH) { const int l = (int)gtid; float s1 = 0.f, s2 = 0.f;
                for (int i = 0; i < 32; ++i) { s1 += args.in[I_LQ1][l * 32 + i] * args.in[I_LK1][l * 32 + i]; s2 += args.in[I_LQ2][l * 32 + i] * args.in[I_LK2][l * 32 + i]; }
                const float lam_init = 0.8f - 0.6f * expf(-0.3f * (float)l);
                scal[l * 4 + 0] = expf(s1) - expf(s2) + lam_init; scal[l * 4 + 1] = lam_init; }
        }
    }
    SEAM(0);
    if (IN(1)) {
        OPAQUE_LANE();
        LAS float* tab = (LAS float*)lds;
        build_table(tab, args.in[I_N1G], modf, 0, 1);
        __syncthreads();
        for (int m = gw; m < TOK; m += NGW) norm_row(args.in[I_X] + (size_t)m * DM, Hb + (size_t)m * DM, tab, m >> 13, lane);
        __syncthreads();
    }
    SEAM(1);

    for (int l = 0; l < DEPTH; ++l) {
        const int P = 2 + 7 * l;
        const float* mod_l = modf + (size_t)l * 4 * 6144;
        float* kmean_l = kmean + (size_t)l * 4 * 6 * 32 * 64;
        float* xres_out = args.out;
        const float* xres_in = (l == 0) ? args.in[I_X] : args.out;
        if (IN(P + 0)) {
            pg8::Gemm g{Hb, Wt_in + (size_t)l * INW * DM, TOK, INW, DM}; pg8::StaticOrder S; S.init(TOK, INW, G, bx);
            pg8::EpiProj E{Pj, INW, kmean_l, OFF_KB};
            pg8::gemm_phase<pg8::EpiProj, pg8::StaticOrder, true, true>(lds, g, S, E);
        }
        SEAM(P + 0);
        if (IN(P + 1)) {
            const float lam = scal[l * 4 + 0], lam_init = scal[l * 4 + 1];
            constexpr int NUNITS = 2048;
            for (int rnd = 0; rnd * G < NUNITS; ++rnd) {
                const int idx = rnd * G + ((rnd & 1) ? (G - 1 - bx) : bx);
                if (idx >= NUNITS) continue;
                if (idx < 1280) {
                    const int qb = 31 - idx / 40, j = idx % 40;
                    if (j < 16) { if (ATM & 1) att::attn_unit<0>(j >> 2, j & 3, qb, Pj, Ob, kmean_l, lam, lam_init, args.in[I_SUBG] + l * 64, 0.f, lds); }
                    else { const int jj = j - 16; if (ATM & 2) att::attn_unit<1>(jj / 6, jj % 6, qb, Pj, Ob, kmean_l, 0.f, 0.f, nullptr, 0.f, lds); }
                } else {
                    const int j = idx - 1280, qb = j / 24, jj = j % 24;
                    if (ATM & 4) att::attn_unit<2>(jj / 6, jj % 6, qb, Pj, Ob, kmean_l, 0.f, 0.f, nullptr, args.in[I_SINK][l * 6 + jj % 6], lds);
                }
            }
        }
        SEAM(P + 1);
        if (IN(P + 2)) {
            pg8::Gemm g{Ob, Wt_out + (size_t)l * DM * DM, TOK, DM, DM}; pg8::StaticOrder S; S.init(TOK, DM, G, bx);
            pg8::EpiRes E{xres_in, xres_out, DM, mod_l + 2 * 1024, 6144};
            pg8::gemm_phase<pg8::EpiRes, pg8::StaticOrder, true, true>(lds, g, S, E);
        }
        SEAM(P + 2);
        if (IN(P + 3)) {
            OPAQUE_LANE();
            LAS float* tab = (LAS float*)lds;
            build_table(tab, args.in[I_N2G] + l * DM, mod_l, 3, 4);
            __syncthreads();
            for (int m = gw; m < TOK; m += NGW) norm_row(xres_out + (size_t)m * DM, Hb + (size_t)m * DM, tab, m >> 13, lane);
            __syncthreads();
        }
        SEAM(P + 3);
        if (IN(P + 4)) {
            pg8::Gemm g{Hb, Wt_q + (size_t)l * PQW * DM, TOK, PQW, DM}; pg8::StaticOrder S; S.init(TOK, PQW, G, bx);
            pg8::EpiBf16Plain E{Qp, PQW};
            pg8::gemm_phase<pg8::EpiBf16Plain, pg8::StaticOrder, true, true>(lds, g, S, E);
        }
        SEAM(P + 4);
        if (IN(P + 5)) {
            for (int u = bx; u < (TOK / 256) * PHEADS; u += G) peer::pk_unit(u >> 3, u & 7, Qp, keysb + (size_t)l * PHEADS * 2 * 128 * 128, Eid, Gw, lds);
            __syncthreads();
        }
        SEAM(P + 5);
        if (IN(P + 6)) {
            OPAQUE_LANE();
            LAS float* tab2 = (LAS float*)lds; LAS float* tabn = (LAS float*)(lds + 32768);
            const bool last = (l == DEPTH - 1);
            build_table(tab2, args.in[I_N2G] + l * DM, mod_l, 3, 4);
            if (!last) build_table(tabn, args.in[I_N1G] + (l + 1) * DM, mod_l + 4 * 6144, 0, 1);
            __syncthreads();
            for (int m = gw; m < TOK; m += NGW)
                peer::pg_token(m, xres_out, tab2, mod_l + 5 * 1024, 6144, Eid, Gw, Ub + (size_t)l * PNEXP * DM, Vb + (size_t)l * PNEXP * DM, last, tabn, args.in[I_FG], Hb, args.out, lane);
            __syncthreads();
        }
        if (l + 1 < DEPTH) SEAM(P + 6);
    }
#undef IN
#undef SEAM
}


#ifdef DBG
__global__ void dbg_chk16(const bf16_t* p, size_t n, unsigned* flag, unsigned bit) {
    bool bad = false;
    for (size_t i = (size_t)blockIdx.x * blockDim.x + threadIdx.x; i < n; i += (size_t)gridDim.x * blockDim.x) bad |= ((p[i] & 0x7f80u) == 0x7f80u);
    if (bad) atomicOr(flag, bit);
}
__global__ void dbg_chk32(const float* p, size_t n, unsigned* flag, unsigned bit) {
    bool bad = false;
    for (size_t i = (size_t)blockIdx.x * blockDim.x + threadIdx.x; i < n; i += (size_t)gridDim.x * blockDim.x) bad |= ((__builtin_bit_cast(unsigned, p[i]) & 0x7f800000u) == 0x7f800000u);
    if (bad) atomicOr(flag, bit);
}
__global__ void dbg_chk_o(const bf16_t* p, unsigned* flag) {
    unsigned bad = 0;
    for (size_t i = (size_t)blockIdx.x * blockDim.x + threadIdx.x; i < (size_t)TOK * DM; i += (size_t)gridDim.x * blockDim.x) {
        if ((p[i] & 0x7f80u) == 0x7f80u) { const int c = (int)(i & 1023); const int r = (int)((i >> 10) & 8191); bad |= (c < 256) ? 1u : (c < 640 ? 2u : 4u); if (r < 256) bad |= 8u; if ((r & 255) < 32) bad |= 16u; if (p[i] & 0x7fu) bad |= 32u; }
    }
    if (bad) atomicOr(flag, bad);
}
__global__ void dbg_fill(float* out, size_t n, const unsigned* flag) {
    const unsigned f = *flag; if (f == 0u) return;
    const float c = sqrtf((float)f);
    for (size_t i = (size_t)blockIdx.x * blockDim.x + threadIdx.x; i < n; i += (size_t)gridDim.x * blockDim.x) out[i] = c;
}
#endif
extern "C" void kernel_launch(void* const* d_in, const int* in_sizes, int n_in, void* d_out, int out_size, void* d_ws, size_t ws_size, hipStream_t stream) {
    static int grid = 0;
    if (grid == 0) {
        if (n_in != 19 || out_size != TOK * DM || ws_size < WS_END) { fprintf(stderr, "kernel_launch: unexpected shapes (n_in %d out %d ws %zu)\n", n_in, out_size, ws_size); grid = -1; return; }
        int dev = 0, cus = 0, per_cu = 0;
        hipGetDevice(&dev); hipDeviceGetAttribute(&cus, hipDeviceAttributeMultiprocessorCount, dev);
        hipFuncSetAttribute((const void*)hymba_fwd, hipFuncAttributeMaxDynamicSharedMemorySize, LDS_BYTES);
        hipOccupancyMaxActiveBlocksPerMultiprocessor(&per_cu, (const void*)hymba_fwd, NTHREADS, LDS_BYTES);
        (void)hipGetLastError();
        if (per_cu < 1) per_cu = 1;
        if (per_cu > 1) per_cu = 1;
        grid = cus * per_cu;
        if (grid <= 0) grid = 256;
    }
    if (grid < 0) return;
    hipMemsetAsync((char*)d_ws + WS_CTL, 0, CTL_ZERO_BYTES, stream);
    Args a{};
    for (int i = 0; i < 19; ++i) a.in[i] = (const float*)d_in[i];
    a.out = (float*)d_out; a.ws = (unsigned char*)d_ws;
#if MK_N_LAUNCHES == 1
    a.ph_lo = 0; a.ph_hi = N_PHASES;
    void* kargs[] = {&a};
    hipError_t e = hipLaunchCooperativeKernel((const void*)hymba_fwd, dim3(grid), dim3(NTHREADS), kargs, LDS_BYTES, stream);
    if (e != hipSuccess) fprintf(stderr, "cooperative launch failed: %s (grid %d)\n", hipGetErrorString(e), grid);
#else
    for (int p = 0; p < N_PHASES; ++p) { a.ph_lo = p; a.ph_hi = p + 1; hipLaunchKernelGGL(hymba_fwd, dim3(grid), dim3(NTHREADS), LDS_BYTES, stream, a);
#ifdef DBG
        unsigned* flag = (unsigned*)((char*)d_ws + WS_CTL); unsigned char* w = (unsigned char*)d_ws;
        const int base = DBG_BASE;
        if (p == 3) dbg_chk_o<<<1024, 256, 0, stream>>>((const bf16_t*)(w + WS_O), flag);
#endif
    }
#ifdef DBG
    dbg_fill<<<1024, 256, 0, stream>>>((float*)d_out, (size_t)TOK * DM, (const unsigned*)((char*)d_ws + WS_CTL));
#endif
#endif
}
```

```cpp
#include <hip/hip_runtime.h>
#include <hip/hip_cooperative_groups.h>
#include <cstdio>
#include <cstdint>
#include <cmath>
namespace cg = cooperative_groups;

constexpr int DM = 1024, NBATCH = 4, SEQ = 8192, DEPTH = 2, TOK = NBATCH * SEQ;
constexpr int INW = 2560, NMOD = 6;
constexpr int OFF_QA = 0, OFF_KA = 256, OFF_VA = 512, OFF_QB = 768, OFF_KB = 1152, OFF_VB = 1536, OFF_QC = 1920, OFF_KC = 2304, OFF_VC = 2432;
constexpr int PHEADS = 8, PQW = 2048, PNK = 128, PNEXP = 16384, PTOPK = 16;
constexpr float EPS = 1e-6f;
constexpr float LOG2E = 1.4426950408889634f;
constexpr int NWAVES = 8, NTHREADS = 512;

constexpr size_t MiB = 1u << 20;
constexpr size_t WS_CTL = 0, CTL_ZERO_BYTES = 64 * 1024;
constexpr size_t WS_WIN = 1 * MiB;
constexpr size_t WS_WOUT = 11 * MiB;
constexpr size_t WS_WQ = 15 * MiB;
constexpr size_t WS_KEYS = 23 * MiB;
constexpr size_t WS_MOD = 24 * MiB;
constexpr size_t WS_KMEAN = 24 * MiB + 256 * 1024;
constexpr size_t WS_SCAL = 25 * MiB;
constexpr size_t WS_U = 26 * MiB;
constexpr size_t WS_V = 90 * MiB;
constexpr size_t WS_H = 154 * MiB;
constexpr size_t WS_PROJ = 218 * MiB;
constexpr size_t WS_O = 378 * MiB;
constexpr size_t WS_END = 442 * MiB;

#define GAS __attribute__((address_space(1)))
#define LAS __attribute__((address_space(3)))
typedef unsigned short bf16_t;
typedef short bf16x8_t __attribute__((ext_vector_type(8)));
typedef short s16x4_t __attribute__((ext_vector_type(4)));
typedef float f32x4_t __attribute__((ext_vector_type(4)));
typedef float f32x16_t __attribute__((ext_vector_type(16)));
typedef unsigned u32x4_t __attribute__((ext_vector_type(4)));
typedef unsigned u32x2_t __attribute__((ext_vector_type(2)));

__device__ __forceinline__ unsigned f2bf(float f) { unsigned u = __builtin_bit_cast(unsigned, f); return (u + 0x7fffu + ((u >> 16) & 1u)) >> 16; }
__device__ __forceinline__ unsigned pk2(float lo, float hi) { return f2bf(lo) | (f2bf(hi) << 16); }
__device__ __forceinline__ float bf_lo(unsigned w) { return __builtin_bit_cast(float, w << 16); }
__device__ __forceinline__ float bf_hi(unsigned w) { return __builtin_bit_cast(float, w & 0xffff0000u); }
__device__ __forceinline__ float wave_sum(float v) {
#pragma unroll
    for (int o = 1; o < 64; o <<= 1) v += __shfl_xor(v, o);
    return v;
}
__device__ __forceinline__ float swap32_partner(float v, int) { return __shfl_xor(v, 32); }
__device__ __forceinline__ float alibi_slope(int i) { return exp2f(-0.5f * (float)(i + 1)); }

namespace pg8 {
#define PG8_LAS __attribute__((address_space(3)))
typedef unsigned short bf16_t;
typedef short bf16x8 __attribute__((ext_vector_type(8)));
typedef float f32x4 __attribute__((ext_vector_type(4)));
typedef unsigned u32x4 __attribute__((ext_vector_type(4)));
constexpr int BM = 256, BK = 64, HALF = 128, HTB = HALF * BK * 2  , STAGE_BYTES = 8 * HTB, NXCD = 8, WGM = 8;

__host__ __device__ __forceinline__ int lds_byte(int r, int c) { const int st = (r >> 4) * 2 + (c >> 5), rr = r & 15, cc = c & 31, ob = rr * 64 + cc * 2; return st * 1024 + (ob ^ (((ob >> 9) & 1) << 5)); }
__host__ __device__ __forceinline__ void stage_rc(int b, int& R, int& C) { const int st = b / 1024, sb = b % 1024, swz = sb ^ (((sb >> 9) & 1) << 5); R = (st >> 1) * 16 + swz / 64; C = (st & 1) * 32 + (swz % 64) / 2; }
__host__ __device__ __forceinline__ int perm32(int rho) { const int n = rho >> 4, i = rho & 15; return 8 * (i >> 2) + 4 * n + (i & 3); }

struct Unit { int pm, pn; };
struct Gemm { const bf16_t* A; const bf16_t* Bt; int M, N, K; };

struct StaticOrder {
    int nM, nN, nwg, G, c;
    __host__ __device__ void init(int M, int N, int G_, int c_) { nM = M / BM; nN = N / BM; nwg = nM * nN; G = G_; c = c_; }
    __host__ __device__ bool next(int i, Unit& u) const {
        const long L = (long)i * G + c; if (L >= nwg) return false;
        int wgid = (int)L; { const int q = nwg / NXCD, r = nwg % NXCD, xcd = wgid % NXCD, off = wgid / NXCD; wgid = (xcd < r ? xcd * (q + 1) : r * (q + 1) + (xcd - r) * q) + off; }
        const int nig = WGM * nN, gid = wgid / nig, fm = gid * WGM, gsz = (nM - fm) < WGM ? (nM - fm) : WGM;
        u.pm = fm + ((wgid % nig) % gsz); u.pn = (wgid % nig) / gsz; return true;
    }
    __device__ __forceinline__ void a_ready(const Unit&) const {}
    __device__ __forceinline__ void done(const Unit&) const {}
};

__device__ __forceinline__ unsigned cvt_pk_bf16(float lo, float hi) { unsigned r; asm volatile("v_cvt_pk_bf16_f32 %0, %1, %2" : "=v"(r) : "v"(lo), "v"(hi)); return r; }
struct EpiBf16Plain {
    static constexpr bool PERM = true, AFTER_DRAIN = false;
    bf16_t* O; int ldc;
    __device__ __forceinline__ void operator()(const f32x4 (&acc)[2][2][4][2], const Unit& u, int wr, int wc, int fr, int fq) const {
        const int row0 = u.pm * BM + wr * 64 + fr, col0 = u.pn * BM + wc * 32 + 8 * fq;
#pragma unroll
        for (int ai = 0; ai < 2; ++ai)
#pragma unroll
            for (int m = 0; m < 4; ++m) { bf16_t* rowp = O + (size_t)(row0 + ai * HALF + m * 16) * ldc + col0;
#pragma unroll
                for (int bj = 0; bj < 2; ++bj) { const f32x4 v0 = acc[ai][bj][m][0], v1 = acc[ai][bj][m][1];
                    u32x4 w; w.x = cvt_pk_bf16(v0[0], v0[1]); w.y = cvt_pk_bf16(v0[2], v0[3]); w.z = cvt_pk_bf16(v1[0], v1[1]); w.w = cvt_pk_bf16(v1[2], v1[3]);
                    *(u32x4*)(rowp + bj * HALF) = w; } }
    }
};
struct EpiProj {
    static constexpr bool PERM = true, AFTER_DRAIN = false;
    bf16_t* O; int ldc; float* kmean; int kb_lo;
    __device__ __forceinline__ void operator()(const f32x4 (&acc)[2][2][4][2], const Unit& u, int wr, int wc, int fr, int fq) const {
        const int row0 = u.pm * BM + wr * 64 + fr, col0 = u.pn * BM + wc * 32 + 8 * fq;
#pragma unroll
        for (int ai = 0; ai < 2; ++ai)
#pragma unroll
            for (int m = 0; m < 4; ++m) { bf16_t* rowp = O + (size_t)(row0 + ai * HALF + m * 16) * ldc + col0;
#pragma unroll
                for (int bj = 0; bj < 2; ++bj) { const f32x4 v0 = acc[ai][bj][m][0], v1 = acc[ai][bj][m][1];
                    u32x4 w; w.x = cvt_pk_bf16(v0[0], v0[1]); w.y = cvt_pk_bf16(v0[2], v0[3]); w.z = cvt_pk_bf16(v1[0], v1[1]); w.w = cvt_pk_bf16(v1[2], v1[3]);
                    *(u32x4*)(rowp + bj * HALF) = w; } }
#pragma unroll
        for (int bj = 0; bj < 2; ++bj) {
            const int cb = u.pn * BM + bj * HALF;
            if (cb >= kb_lo && cb < kb_lo + 384) {
                f32x4 s0 = {0.f, 0.f, 0.f, 0.f}, s1 = {0.f, 0.f, 0.f, 0.f};
#pragma unroll
                for (int ai = 0; ai < 2; ++ai)
#pragma unroll
                    for (int m = 0; m < 4; ++m) { s0 += acc[ai][bj][m][0]; s1 += acc[ai][bj][m][1]; }
#pragma unroll
                for (int i = 0; i < 4; ++i) {
#pragma unroll
                    for (int o = 1; o < 16; o <<= 1) { s0[i] += __shfl_xor(s0[i], o); s1[i] += __shfl_xor(s1[i], o); }
                }
                if (fr == 0) {
                    const int c = cb + wc * 32 + 8 * fq - kb_lo, h = c >> 6, d = c & 63, b = u.pm >> 5, nb = u.pm & 31;
                    float* kp = kmean + ((size_t)((b * 6 + h) * 32 + nb)) * 64 + d;
#pragma unroll
                    for (int i = 0; i < 4; ++i) { atomicAdd(kp + i, s0[i]); atomicAdd(kp + 4 + i, s1[i]); }
                }
            }
        }
    }
};
struct EpiRes {
    static constexpr bool PERM = false, AFTER_DRAIN = false;
    const float* base; float* out; int ldc; const float* gate; int gstride;
    __device__ __forceinline__ void operator()(const f32x4 (&acc)[2][2][4][2], const Unit& u, int wr, int wc, int fr, int fq) const {
        const int row0 = u.pm * BM + wr * 64 + fr, col0 = u.pn * BM + wc * 32 + 4 * fq;
        const float* gp = gate + (size_t)(u.pm >> 5) * gstride + col0;
        f32x4 gv[2][2];
#pragma unroll
        for (int bj = 0; bj < 2; ++bj)
#pragma unroll
            for (int n = 0; n < 2; ++n) gv[bj][n] = *(const f32x4*)(gp + bj * HALF + n * 16);
#pragma unroll
        for (int ai = 0; ai < 2; ++ai)
#pragma unroll
            for (int m = 0; m < 4; ++m) { const size_t off = (size_t)(row0 + ai * HALF + m * 16) * ldc + col0;
#pragma unroll
                for (int bj = 0; bj < 2; ++bj)
#pragma unroll
                    for (int n = 0; n < 2; ++n) { const f32x4 bs = *(const f32x4*)(base + off + bj * HALF + n * 16);
                        *(f32x4*)(out + off + bj * HALF + n * 16) = bs + gv[bj][n] * acc[ai][bj][m][n]; } }
    }
};

template <class Epi, class Sched, bool ALIGN_EPI = false, bool SP2 = false>
__device__ __forceinline__ void gemm_phase(PG8_LAS unsigned char* lds, const Gemm g, const Sched& S, const Epi& E) {
    int tid_ = threadIdx.x; asm volatile("" : "+v"(tid_));
    const int tid = tid_, wid = __builtin_amdgcn_readfirstlane(tid >> 6), lane = tid & 63, wr = wid >> 2, wc = wid & 3, fr = lane & 15, fq = lane >> 4;
    const int K = g.K, nt = K / BK;
    unsigned voffA[2], voffB[2];
#pragma unroll
    for (int i = 0; i < 2; ++i) { int R, C; stage_rc(tid * 16 + i * 8192, R, C); const int Rb = Epi::PERM ? ((R & ~31) + perm32(R & 31)) : R;
        voffA[i] = (unsigned)(R * K + C) * 2u; voffB[i] = (unsigned)(Rb * K + C) * 2u; }
    const size_t kstep = (size_t)(BK * 2);
    const size_t hstep = (size_t)HALF * K * 2;
    const size_t tstep = 2 * hstep;
    const unsigned ldsw = (unsigned)wid * 1024u;
    const int aoff = lds_byte(wr * 64 + fr, fq * 8), boff = lds_byte(wc * 32 + fr, fq * 8);
#define PG8_SA(b, h) (((b) * 2 + (h)) * HTB)
#define PG8_SB(b, h) ((4 + (b) * 2 + (h)) * HTB)
#define PG8_STAGE(bufoff, gbase, voff) do { _Pragma("unroll") for (int _i = 0; _i < 2; ++_i) \
        __builtin_amdgcn_global_load_lds((const unsigned*)((const char*)(gbase) + (voff)[_i]), (PG8_LAS unsigned*)(lds + (bufoff) + ldsw + _i * 8192), 16, 0, 0); } while (0)
#define PG8_LDA(dst, b, h) do { _Pragma("unroll") for (int m = 0; m < 4; ++m) _Pragma("unroll") for (int k = 0; k < 2; ++k) dst[m][k] = *(const PG8_LAS bf16x8*)(lds + PG8_SA(b, h) + aoff + m * 2048 + k * 1024); } while (0)
#define PG8_LDB(dst, b, h) do { _Pragma("unroll") for (int n = 0; n < 2; ++n) _Pragma("unroll") for (int k = 0; k < 2; ++k) dst[n][k] = *(const PG8_LAS bf16x8*)(lds + PG8_SB(b, h) + boff + n * 2048 + k * 1024); } while (0)
#define PG8_MMA(ai, bj, At, Bt) do { __builtin_amdgcn_s_setprio(1); _Pragma("unroll") for (int m = 0; m < 4; ++m) _Pragma("unroll") for (int n = 0; n < 2; ++n) _Pragma("unroll") for (int k = 0; k < 2; ++k) \
        acc[ai][bj][m][n] = __builtin_amdgcn_mfma_f32_16x16x32_bf16(Bt[n][k], At[m][k], acc[ai][bj][m][n], 0, 0, 0); __builtin_amdgcn_s_setprio(0); } while (0)
#define PG8_WAIT_V(n) asm volatile("s_waitcnt vmcnt(" #n ")" ::: "memory")
#define PG8_WAIT_L(n) asm volatile("s_waitcnt lgkmcnt(" #n ")" ::: "memory")
#define PG8_BAR __builtin_amdgcn_s_barrier()
#define PG8_SCHED __builtin_amdgcn_sched_barrier(0)
    Unit cur, nxt; int ui = 0;
    if (!S.next(0, cur)) return;
    f32x4 acc[2][2][4][2];
#pragma unroll
    for (int a = 0; a < 2; ++a)
#pragma unroll
        for (int b = 0; b < 2; ++b)
#pragma unroll
            for (int m = 0; m < 4; ++m)
#pragma unroll
                for (int n = 0; n < 2; ++n) acc[a][b][m][n] = (f32x4){0.f, 0.f, 0.f, 0.f};
    bf16x8 At[4][2], B0[2][2], B1[2][2];
    const char* cA = (const char*)g.A + (size_t)cur.pm * tstep; const char* cB = (const char*)g.Bt + (size_t)cur.pn * tstep;
    S.a_ready(cur);
    if constexpr (SP2) {
        PG8_STAGE(PG8_SB(0, 0), cB, voffB); PG8_STAGE(PG8_SB(0, 1), cB + hstep, voffB); PG8_STAGE(PG8_SA(0, 0), cA, voffA); PG8_STAGE(PG8_SA(0, 1), cA + hstep, voffA);
        if (wr == 1) PG8_BAR;
        PG8_WAIT_V(2); PG8_BAR;
        PG8_STAGE(PG8_SB(1, 0), cB + kstep, voffB); PG8_STAGE(PG8_SA(1, 0), cA + kstep, voffA); PG8_STAGE(PG8_SB(1, 1), cB + hstep + kstep, voffB);
        PG8_WAIT_V(6); PG8_BAR;
    } else {
        PG8_STAGE(PG8_SB(0, 0), cB, voffB); PG8_STAGE(PG8_SA(0, 0), cA, voffA); PG8_STAGE(PG8_SB(0, 1), cB + hstep, voffB); PG8_STAGE(PG8_SA(0, 1), cA + hstep, voffA);
        if (wr == 1) PG8_BAR;
        PG8_WAIT_V(4); PG8_BAR;
        PG8_STAGE(PG8_SB(1, 0), cB + kstep, voffB); PG8_STAGE(PG8_SA(1, 0), cA + kstep, voffA); PG8_STAGE(PG8_SB(1, 1), cB + hstep + kstep, voffB);
        PG8_WAIT_V(6); PG8_BAR;
    }
    for (;;) {
        const bool has_next = S.next(ui + 1, nxt);
        const char* nA = has_next ? (const char*)g.A + (size_t)nxt.pm * tstep : cA; const char* nB = has_next ? (const char*)g.Bt + (size_t)nxt.pn * tstep : cB;
        for (int t = 0; t < nt; t += 2) {
            const bool last = (t == nt - 2);
            const char* a1 = cA + (size_t)(t + 1) * kstep;
            const char* a2 = last ? nA : cA + (size_t)(t + 2) * kstep; const char* b2 = last ? nB : cB + (size_t)(t + 2) * kstep;
            const char* a3 = a2 + kstep; const char* b3 = b2 + kstep;
            if (last && has_next) S.a_ready(nxt);
            if constexpr (SP2) {
            PG8_LDB(B0, 0, 0); PG8_LDB(B1, 0, 1); PG8_SCHED; PG8_LDA(At, 0, 0); PG8_STAGE(PG8_SA(1, 1), a1 + hstep, voffA);
            PG8_WAIT_V(8); PG8_WAIT_L(0); PG8_BAR; PG8_MMA(0, 0, At, B0); PG8_MMA(0, 1, At, B1); PG8_BAR; PG8_SCHED;
            PG8_LDA(At, 0, 1); PG8_STAGE(PG8_SB(0, 0), b2, voffB); PG8_STAGE(PG8_SB(0, 1), b2 + hstep, voffB); PG8_STAGE(PG8_SA(0, 0), a2, voffA);
            PG8_WAIT_V(8); PG8_WAIT_L(0); PG8_BAR; PG8_MMA(1, 0, At, B0); PG8_MMA(1, 1, At, B1); PG8_BAR; PG8_SCHED;
            PG8_LDB(B0, 1, 0); PG8_LDB(B1, 1, 1); PG8_SCHED; PG8_LDA(At, 1, 0); PG8_STAGE(PG8_SA(0, 1), a2 + hstep, voffA);
            PG8_WAIT_V(8); PG8_WAIT_L(0); PG8_BAR; PG8_MMA(0, 0, At, B0); PG8_MMA(0, 1, At, B1); PG8_BAR; PG8_SCHED;
            PG8_LDA(At, 1, 1); PG8_STAGE(PG8_SB(1, 0), b3, voffB); PG8_STAGE(PG8_SB(1, 1), b3 + hstep, voffB); PG8_STAGE(PG8_SA(1, 0), a3, voffA);
            PG8_WAIT_V(8); PG8_WAIT_L(0); PG8_BAR; PG8_MMA(1, 0, At, B0); PG8_MMA(1, 1, At, B1); PG8_BAR; PG8_SCHED;
            } else {
            PG8_LDB(B0, 0, 0); PG8_SCHED; PG8_LDA(At, 0, 0); PG8_STAGE(PG8_SA(1, 1), a1 + hstep, voffA);
            PG8_WAIT_L(8); PG8_BAR; PG8_WAIT_L(0); PG8_MMA(0, 0, At, B0); PG8_BAR; PG8_SCHED;
            PG8_LDB(B1, 0, 1); PG8_STAGE(PG8_SB(0, 0), b2, voffB);
            PG8_BAR; PG8_WAIT_L(0); PG8_MMA(0, 1, At, B1); PG8_BAR;
            PG8_LDA(At, 0, 1); PG8_STAGE(PG8_SA(0, 0), a2, voffA);
            PG8_BAR; PG8_WAIT_L(0); PG8_MMA(1, 0, At, B0); PG8_BAR; PG8_SCHED;
            PG8_STAGE(PG8_SB(0, 1), b2 + hstep, voffB);
            PG8_WAIT_V(6); PG8_BAR; PG8_MMA(1, 1, At, B1); PG8_BAR;
            PG8_LDB(B0, 1, 0); PG8_SCHED; PG8_LDA(At, 1, 0); PG8_STAGE(PG8_SA(0, 1), a2 + hstep, voffA);
            PG8_WAIT_L(8); PG8_BAR; PG8_WAIT_L(0); PG8_MMA(0, 0, At, B0); PG8_BAR; PG8_SCHED;
            PG8_LDB(B1, 1, 1); PG8_STAGE(PG8_SB(1, 0), b3, voffB);
            PG8_BAR; PG8_WAIT_L(0); PG8_MMA(0, 1, At, B1); PG8_BAR;
            PG8_LDA(At, 1, 1); PG8_STAGE(PG8_SA(1, 0), a3, voffA);
            PG8_BAR; PG8_WAIT_L(0); PG8_MMA(1, 0, At, B0); PG8_BAR; PG8_SCHED;
            PG8_STAGE(PG8_SB(1, 1), b3 + hstep, voffB);
            PG8_WAIT_V(6); PG8_BAR; PG8_MMA(1, 1, At, B1); PG8_BAR;
            }
        }
        if constexpr (ALIGN_EPI) { if (wr == 0) PG8_BAR; }
        if constexpr (!Epi::AFTER_DRAIN) { E(acc, cur, wr, wc, fr, fq); S.done(cur); }
        if (!has_next) break;
#pragma unroll
        for (int a = 0; a < 2; ++a)
#pragma unroll
            for (int b = 0; b < 2; ++b)
#pragma unroll
                for (int m = 0; m < 4; ++m)
#pragma unroll
                    for (int n = 0; n < 2; ++n) acc[a][b][m][n] = (f32x4){0.f, 0.f, 0.f, 0.f};
        cur = nxt; cA = nA; cB = nB; ++ui;
        if constexpr (ALIGN_EPI) { if (wr == 1) PG8_BAR; }
    }
    PG8_WAIT_V(0);
    if constexpr (!ALIGN_EPI) { if (wr == 0) PG8_BAR; }
    PG8_BAR;
    if constexpr (Epi::AFTER_DRAIN) { E.fused(acc, cur, wr, wc, fr, fq, lds, wid, lane); S.done(cur); }
#undef PG8_SA
#undef PG8_SB
#undef PG8_STAGE
#undef PG8_LDA
#undef PG8_LDB
#undef PG8_MMA
#undef PG8_WAIT_V
#undef PG8_WAIT_L
#undef PG8_BAR
#undef PG8_SCHED
}
}
namespace att {
constexpr int A_K = 0, A_V = 16384, A_WSF = 32768, A_KM = A_WSF + 2048, A_STG = A_KM + 8192;
constexpr int STG_STRIDE = 68, STG_WAVE_BYTES = 32 * STG_STRIDE * 4, A_END = A_STG + NWAVES * STG_WAVE_BYTES;
__device__ __forceinline__ int crow(int r, int hi) { return (r & 3) + 8 * (r >> 2) + 4 * hi; }
__device__ __forceinline__ void dma16(const void* g, LAS unsigned char* l) { __builtin_amdgcn_global_load_lds((const unsigned*)g, (LAS unsigned*)l, 16, 0, 0); }
typedef float f32x2_t __attribute__((ext_vector_type(2))); typedef __bf16 bf16x2_t __attribute__((ext_vector_type(2)));
__device__ __forceinline__ unsigned cvtpk(float lo, float hi) { f32x2_t v = {lo, hi}; bf16x2_t b = __builtin_convertvector(v, bf16x2_t); return __builtin_bit_cast(unsigned, b); }
typedef short v4i16_t __attribute__((ext_vector_type(4)));
__device__ __forceinline__ s16x4_t vtr(LAS const unsigned char* p) { return __builtin_bit_cast(s16x4_t, __builtin_amdgcn_ds_read_tr16_b64_v4i16((LAS v4i16_t*)p)); }
#define LDSW() asm volatile("s_waitcnt lgkmcnt(0)" ::: "memory")

template <int MODE>
__device__ __forceinline__ void attn_unit(int b, int h, int qb, const bf16_t* __restrict__ proj, bf16_t* __restrict__ Obuf, const float* __restrict__ kmean,
                                          float lam, float lam_init, const float* __restrict__ subg, float sinkv, LAS unsigned char* lds) {
    constexpr int NMAP = (MODE == 0) ? 2 : 1;
    int tid_ = threadIdx.x; asm volatile("" : "+v"(tid_));
    const int tid = tid_, lane = tid & 63, r32 = lane & 31, hi = lane >> 5;
    const int wid = __builtin_amdgcn_readfirstlane(tid >> 6);
    const int q0 = qb * 256;
    int qcol, kcol, vcol, ocol; float slope;
    if (MODE == 0) { qcol = OFF_QA + h * 64; kcol = OFF_KA + h * 64; vcol = OFF_VA + h * 64; ocol = h * 64; slope = alibi_slope(6 + h); }
    else if (MODE == 1) { qcol = OFF_QB + h * 64; kcol = OFF_KB + h * 64; vcol = OFF_VB + h * 64; ocol = 256 + h * 64; slope = alibi_slope(10 + h); }
    else { qcol = OFF_QC + h * 64; kcol = OFF_KC + (h / 3) * 64; vcol = OFF_VC + (h / 3) * 64; ocol = 640 + h * 64; slope = alibi_slope(h); }
    const float slope2 = slope * LOG2E;
    const float cscale = (MODE == 0 ? 0.17677669529663687f : 0.125f) * LOG2E;
    const bf16_t* base = proj + (size_t)b * SEQ * INW;
    const int t_hi = 4 * qb + 4, t_lo = (MODE == 2) ? (qb > 0 ? 4 * qb - 2 : 0) : 0;
    const bf16_t* ksrc = base + kcol + (size_t)lane * INW + wid * 8;
    const bf16_t* vsrc = base + vcol + (size_t)(16 * (wid & 3) + (lane >> 2)) * INW + (wid >> 2) * 32 + (lane & 3) * 8;
#define DMA_TILE(t, bufi) do { dma16(ksrc + (size_t)(t) * 64 * INW, lds + A_K + (bufi) * 8192 + wid * 1024); dma16(vsrc + (size_t)(t) * 64 * INW, lds + A_V + (bufi) * 8192 + wid * 1024); } while (0)
    DMA_TILE(t_lo, 0);
    const bf16_t* Qw = base + (size_t)(q0 + wid * 32 + r32) * INW + qcol;
    bf16x8_t qr[4];
#pragma unroll
    for (int d0 = 0; d0 < 4; ++d0) qr[d0] = *(const bf16x8_t*)(Qw + d0 * 16 + hi * 8);
    const int qrel = wid * 32 + r32;
    const LAS unsigned char* qlds = lds + A_STG + wid * STG_WAVE_BYTES + lane * 16;
    if (MODE == 0) {
#pragma unroll
        for (int d0 = 0; d0 < 4; ++d0) *(LAS bf16x8_t*)(lds + A_STG + wid * STG_WAVE_BYTES + lane * 16 + d0 * 1024) = qr[d0];
    }
    unsigned rowmask = 0u;
    if (MODE == 1) {
        LAS float* km = (LAS float*)(lds + A_KM);
        const float* kmg = kmean + (size_t)((b * 6 + h) * 32) * 64;
        for (int i = tid; i < 2048; i += NTHREADS) km[i] = kmg[i] * (1.0f / 256.0f);
        __syncthreads();
        if (qb > 0) {
            float qf[32];
#pragma unroll
            for (int d0 = 0; d0 < 4; ++d0)
#pragma unroll
                for (int j = 0; j < 8; ++j) qf[d0 * 8 + j] = __builtin_bit_cast(float, ((unsigned)(unsigned short)qr[d0][j]) << 16);
            float v0 = -INFINITY, v1 = -INFINITY, v2 = -INFINITY; int i0 = 0, i1 = 0, i2 = 0;
            for (int n = 0; n < qb; ++n) {
                const LAS float* kp = km + n * 64 + 8 * hi;
                float part = 0.f;
#pragma unroll
                for (int d0 = 0; d0 < 4; ++d0) {
                    const f32x4_t a = *(const LAS f32x4_t*)(kp + d0 * 16), c = *(const LAS f32x4_t*)(kp + d0 * 16 + 4);
                    part += qf[d0 * 8 + 0] * a[0]; part += qf[d0 * 8 + 1] * a[1]; part += qf[d0 * 8 + 2] * a[2]; part += qf[d0 * 8 + 3] * a[3];
                    part += qf[d0 * 8 + 4] * c[0]; part += qf[d0 * 8 + 5] * c[1]; part += qf[d0 * 8 + 6] * c[2]; part += qf[d0 * 8 + 7] * c[3];
                }
                const float tot = part + swap32_partner(part, hi);
                if (tot > v0) { v2 = v1; i2 = i1; v1 = v0; i1 = i0; v0 = tot; i0 = n; }
                else if (tot > v1) { v2 = v1; i2 = i1; v1 = tot; i1 = n; }
                else if (tot > v2) { v2 = tot; i2 = n; }
            }
            if (v0 > -INFINITY) rowmask |= 1u << i0;
            if (v1 > -INFINITY) rowmask |= 1u << i1;
            if (v2 > -INFINITY) rowmask |= 1u << i2;
        }
    }
    float m_[NMAP], l_[NMAP]; f32x16_t o[NMAP][2];
#pragma unroll
    for (int mi = 0; mi < NMAP; ++mi) { m_[mi] = -INFINITY; l_[mi] = 0.f;
#pragma unroll
        for (int d0 = 0; d0 < 2; ++d0)
#pragma unroll
            for (int r = 0; r < 16; ++r) o[mi][d0][r] = 0.f; }
    LAS float* wsf = (LAS float*)(lds + A_WSF) + wid * 64;
    const int vlane = ((lane >> 4) & 1) * 32 + (lane & 3) * 8 + (4 * hi + ((lane & 15) >> 2)) * 64;

    for (int t = t_lo; t < t_hi; ++t) {
        const int bufi = (t - t_lo) & 1;
        asm volatile("s_waitcnt vmcnt(0)" ::: "memory");
        __syncthreads();
        if (t + 1 < t_hi) DMA_TILE(t + 1, bufi ^ 1);
        const int krel0 = 64 * t - q0;
        bool need = krel0 <= wid * 32 + 31;
        if (MODE == 2) need = need && (krel0 + 63 >= wid * 32 - 127);
        const bool past = (MODE == 1) && ((t >> 2) < qb);
        if (past) need = __any((int)((rowmask >> (t >> 2)) & 1u)) != 0;
        if (!need) continue;
        const bool diag = krel0 + 63 > wid * 32;
        const int kb = krel0 + 4 * hi;
        const LAS unsigned char* Ks = lds + A_K + bufi * 8192 + hi * 1024 + r32 * 16;
        const LAS unsigned char* Vs = lds + A_V + bufi * 8192 + vlane;
#pragma unroll
        for (int mi = 0; mi < NMAP; ++mi) {
            f32x16_t p0, p1;
#pragma unroll
            for (int r = 0; r < 16; ++r) { p0[r] = 0.f; p1[r] = 0.f; }
            constexpr int ND0 = (MODE == 0) ? 2 : 4;
#pragma unroll
            for (int dd = 0; dd < ND0; ++dd) {
                const int d0 = (MODE == 0) ? (2 * mi + dd) : dd;
                const bf16x8_t b0 = *(const LAS bf16x8_t*)(Ks + d0 * 2048);
                const bf16x8_t b1 = *(const LAS bf16x8_t*)(Ks + d0 * 2048 + 512);
                const bf16x8_t qa = (MODE == 0) ? *(const LAS bf16x8_t*)(qlds + d0 * 1024) : qr[d0];
                p0 = __builtin_amdgcn_mfma_f32_32x32x16_bf16(b0, qa, p0, 0, 0, 0);
                p1 = __builtin_amdgcn_mfma_f32_32x32x16_bf16(b1, qa, p1, 0, 0, 0);
            }
            float sl2 = slope2; asm volatile("" : "+v"(sl2));
            const float tb = sl2 * (float)kb;
#pragma unroll
            for (int r = 0; r < 16; ++r) { const int kk = (r & 3) + 8 * (r >> 2); const float bias = tb + sl2 * (float)kk;
                p0[r] = p0[r] * cscale + bias; p1[r] = p1[r] * cscale + (bias + sl2 * 32.0f); }
            if (diag) {
#pragma unroll
                for (int r = 0; r < 16; ++r) { const int kk = kb + (r & 3) + 8 * (r >> 2); if (kk > qrel) p0[r] = -INFINITY; if (kk + 32 > qrel) p1[r] = -INFINITY; }
            }
            if (MODE == 2) {
#pragma unroll
                for (int r = 0; r < 16; ++r) { const int kk = kb + (r & 3) + 8 * (r >> 2); if (qrel - kk >= 128) p0[r] = -INFINITY; if (qrel - (kk + 32) >= 128) p1[r] = -INFINITY; }
            }
            if (past) { if (!((rowmask >> (t >> 2)) & 1u)) {
#pragma unroll
                for (int r = 0; r < 16; ++r) { p0[r] = -INFINITY; p1[r] = -INFINITY; } } }
            float mx = fmaxf(p0[0], p1[0]);
#pragma unroll
            for (int r = 1; r < 16; ++r) mx = fmaxf(mx, fmaxf(p0[r], p1[r]));
            mx = fmaxf(mx, __shfl_xor(mx, 32));
            const float mnew = fmaxf(m_[mi], mx), msafe = (mnew == -INFINITY) ? 0.f : mnew;
            const float f = __builtin_amdgcn_exp2f(m_[mi] - msafe);
            float ps = 0.f;
#pragma unroll
            for (int r = 0; r < 16; ++r) { p0[r] = __builtin_amdgcn_exp2f(p0[r] - msafe); p1[r] = __builtin_amdgcn_exp2f(p1[r] - msafe); ps += p0[r] + p1[r]; }
            l_[mi] = l_[mi] * f + ps; m_[mi] = mnew;
            if (__any(f != 1.0f)) {
                if (hi == 0) wsf[mi * 32 + r32] = f;
                LDSW();
#pragma unroll
                for (int r = 0; r < 16; ++r) { const float fr_ = wsf[mi * 32 + crow(r, hi)]; o[mi][0][r] *= fr_; o[mi][1][r] *= fr_; }
            }
            u32x4_t pw[4];
#pragma unroll
            for (int j = 0; j < 4; ++j) { pw[0][j] = cvtpk(p0[2 * j], p0[2 * j + 1]); pw[1][j] = cvtpk(p0[8 + 2 * j], p0[8 + 2 * j + 1]);
                                          pw[2][j] = cvtpk(p1[2 * j], p1[2 * j + 1]); pw[3][j] = cvtpk(p1[8 + 2 * j], p1[8 + 2 * j + 1]); }
#pragma unroll
            for (int d0 = 0; d0 < 2; ++d0) {
                if (d0) __builtin_amdgcn_sched_barrier(0);
#pragma unroll
                for (int ks = 0; ks < 4; ++ks) {
                    const s16x4_t lo = vtr(Vs + d0 * 4096 + ks * 1024), hh = vtr(Vs + d0 * 4096 + ks * 1024 + 512);
                    const bf16x8_t vf = {lo[0], lo[1], lo[2], lo[3], hh[0], hh[1], hh[2], hh[3]};
                    o[mi][d0] = __builtin_amdgcn_mfma_f32_32x32x16_bf16(__builtin_bit_cast(bf16x8_t, pw[ks]), vf, o[mi][d0], 0, 0, 0);
                }
            }
            if (NMAP > 1) __builtin_amdgcn_sched_barrier(0);
        }
    }
#undef DMA_TILE
    float rl[NMAP][16];
#pragma unroll
    for (int mi = 0; mi < NMAP; ++mi) {
        float lt = l_[mi];
        lt += __shfl_xor(lt, 32);
        if (MODE == 2) lt += __builtin_amdgcn_exp2f(sinkv * LOG2E + slope2 * (float)qrel - m_[mi]);
        if (hi == 0) wsf[mi * 32 + r32] = 1.0f / lt;
    }
    LDSW();
#pragma unroll
    for (int mi = 0; mi < NMAP; ++mi)
#pragma unroll
        for (int r = 0; r < 16; ++r) rl[mi][r] = wsf[mi * 32 + crow(r, hi)];
    LAS float* stg = (LAS float*)(lds + A_STG + wid * STG_WAVE_BYTES);
#pragma unroll
    for (int d0 = 0; d0 < 2; ++d0)
#pragma unroll
        for (int r = 0; r < 16; ++r) {
            float v = o[0][d0][r] * rl[0][r];
            if (MODE == 0) v -= lam * (o[NMAP - 1][d0][r] * rl[NMAP - 1][r]);
            stg[crow(r, hi) * STG_STRIDE + d0 * 32 + r32] = v;
        }
    LDSW();
    {
        const int row = lane >> 1, half = lane & 1;
        float v[32];
#pragma unroll
        for (int i = 0; i < 8; ++i) { const f32x4_t x = *(const LAS f32x4_t*)(stg + row * STG_STRIDE + half * 32 + i * 4); v[4 * i] = x[0]; v[4 * i + 1] = x[1]; v[4 * i + 2] = x[2]; v[4 * i + 3] = x[3]; }
        if (MODE == 0) {
            float ss = 0.f;
#pragma unroll
            for (int i = 0; i < 32; ++i) ss += v[i] * v[i];
            ss += __shfl_xor(ss, 1);
            const float rs = (1.0f / sqrtf(ss * (1.0f / 64.0f) + EPS)) * (1.0f - lam_init);
#pragma unroll
            for (int i = 0; i < 32; ++i) v[i] = v[i] * rs * subg[half * 32 + i];
        }
        bf16_t* op = Obuf + (size_t)(b * SEQ + q0 + wid * 32 + row) * DM + ocol + half * 32;
#pragma unroll
        for (int i = 0; i < 4; ++i) { u32x4_t w; w.x = cvtpk(v[8 * i], v[8 * i + 1]); w.y = cvtpk(v[8 * i + 2], v[8 * i + 3]); w.z = cvtpk(v[8 * i + 4], v[8 * i + 5]); w.w = cvtpk(v[8 * i + 6], v[8 * i + 7]);
            *(u32x4_t*)(op + 8 * i) = w; }
    }
    __syncthreads();
}
#undef LDSW
}

namespace peer {
constexpr int K_BYTES = 2 * 32768;
__device__ __forceinline__ int crow(int r, int hi) { return (r & 3) + 8 * (r >> 2) + 4 * hi; }

template <int N>
__device__ __forceinline__ void top16_pair(float (&s)[N], float (&out)[16], bool pair) {
#pragma unroll
    for (int it = 0; it < 16; ++it) {
        float mx = s[0];
#pragma unroll
        for (int i = 1; i < N; ++i) mx = fmaxf(mx, s[i]);
        if (pair) mx = fmaxf(mx, __shfl_xor(mx, 32));
        out[it] = mx;
#pragma unroll
        for (int i = 0; i < N; ++i) s[i] = (s[i] == mx) ? -INFINITY : s[i];
    }
}
__device__ __forceinline__ float pack_idx(float v, unsigned idx, unsigned mask) { return __builtin_bit_cast(float, (__builtin_bit_cast(unsigned, v) & ~mask) | idx); }
__device__ __forceinline__ unsigned byte16(unsigned t0, unsigned t1, unsigned t2, unsigned t3, unsigned i) {
    const unsigned s = i & 7u, a = __builtin_amdgcn_perm(t1, t0, s), b = __builtin_amdgcn_perm(t3, t2, s);
    return ((i & 8u) ? b : a) & 0xffu;
}

__device__ __forceinline__ void pk_unit(int tile, int h, const bf16_t* __restrict__ Q, const bf16_t* __restrict__ keysb, int* __restrict__ Eid, float* __restrict__ Gw, LAS unsigned char* lds) {
    int tid_ = threadIdx.x; asm volatile("" : "+v"(tid_));
    const int tid = tid_, lane = tid & 63, r32 = lane & 31, hi = lane >> 5;
    const int wid = __builtin_amdgcn_readfirstlane(tid >> 6);
    __syncthreads();
    {
        const bf16_t* kg = keysb + (size_t)h * 2 * 128 * 128;
        for (int i = tid; i < 2 * 128 * 16; i += NTHREADS) {
            const int n = i & 127, c = (i >> 7) & 15, p = i >> 11;
            const u32x4_t v = *(const u32x4_t*)(kg + ((size_t)(p * 128 + n)) * 128 + c * 8);
            *(LAS u32x4_t*)(lds + p * 32768 + c * 2048 + n * 16) = v;
        }
    }
    __syncthreads();
    const int tok = tile * 256 + wid * 32 + r32;
    float sv[2][16];
#pragma unroll
    for (int p = 0; p < 2; ++p) {
        const bf16_t* qp = Q + (size_t)tok * PQW + h * 256 + p * 128 + hi * 8;
        bf16x8_t qf[8];
#pragma unroll
        for (int ks = 0; ks < 8; ++ks) qf[ks] = *(const bf16x8_t*)(qp + ks * 16);
        float s[64];
#pragma unroll
        for (int blk = 0; blk < 4; ++blk) {
            f32x16_t acc;
#pragma unroll
            for (int r = 0; r < 16; ++r) acc[r] = 0.f;
#pragma unroll
            for (int ks = 0; ks < 8; ++ks) {
                const bf16x8_t kf = *(const LAS bf16x8_t*)(lds + p * 32768 + (2 * ks + hi) * 2048 + (blk * 32 + r32) * 16);
                acc = __builtin_amdgcn_mfma_f32_32x32x16_bf16(kf, qf[ks], acc, 0, 0, 0);
            }
#pragma unroll
            for (int r = 0; r < 16; ++r) s[blk * 16 + r] = pack_idx(acc[r], (unsigned)(blk * 32 + (r & 3) + 8 * (r >> 2) + 4 * hi), 127u);
        }
        top16_pair<64>(s, sv[p], true);
    }
    float cand[50];
    {
        int c = 0;
#pragma unroll
        for (int i = 0; i < 16; ++i)
#pragma unroll
            for (int j = 0; j < 16; ++j)
                if ((i + 1) * (j + 1) <= 16) { cand[c] = pack_idx(sv[0][i] + sv[1][j], (unsigned)(i * 16 + j), 255u); ++c; }
    }
    float top[16];
    top16_pair<50>(cand, top, false);
    unsigned t1[4], t2[4];
#pragma unroll
    for (int j = 0; j < 4; ++j) { t1[j] = 0u; t2[j] = 0u;
#pragma unroll
        for (int k = 0; k < 4; ++k) { t1[j] |= (__builtin_bit_cast(unsigned, sv[0][4 * j + k]) & 127u) << (8 * k); t2[j] |= (__builtin_bit_cast(unsigned, sv[1][4 * j + k]) & 127u) << (8 * k); } }
    float g[16]; int e[16]; float gs = 0.f;
#pragma unroll
    for (int k = 0; k < 16; ++k) {
        const unsigned code = __builtin_bit_cast(unsigned, top[k]) & 255u;
        e[k] = (int)(byte16(t1[0], t1[1], t1[2], t1[3], code >> 4) * 128u + byte16(t2[0], t2[1], t2[2], t2[3], code & 15u));
        g[k] = __expf(top[k] - top[0]); gs += g[k];
    }
    const float gi = 1.0f / gs;
    if (hi == 0) {
        int* ep = Eid + ((size_t)tok * PHEADS + h) * 16; float* gp = Gw + ((size_t)tok * PHEADS + h) * 16;
#pragma unroll
        for (int k = 0; k < 16; k += 4) {
            *(int4*)(ep + k) = make_int4(e[k], e[k + 1], e[k + 2], e[k + 3]);
            *(float4*)(gp + k) = make_float4(g[k] * gi, g[k + 1] * gi, g[k + 2] * gi, g[k + 3] * gi);
        }
    }
}

__device__ __forceinline__ float reduce16(float (&a)[16], int lane) {
    float b8[8];
    { const bool up = lane & 1;
#pragma unroll
      for (int i = 0; i < 8; ++i) { const float keep = up ? a[8 + i] : a[i], give = up ? a[i] : a[8 + i]; b8[i] = keep + __shfl_xor(give, 1); } }
    float b4[4];
    { const bool up = lane & 2;
#pragma unroll
      for (int i = 0; i < 4; ++i) { const float keep = up ? b8[4 + i] : b8[i], give = up ? b8[i] : b8[4 + i]; b4[i] = keep + __shfl_xor(give, 2); } }
    float b2[2];
    { const bool up = lane & 4;
#pragma unroll
      for (int i = 0; i < 2; ++i) { const float keep = up ? b4[2 + i] : b4[i], give = up ? b4[i] : b4[2 + i]; b2[i] = keep + __shfl_xor(give, 4); } }
    float b1;
    { const bool up = lane & 8; const float keep = up ? b2[1] : b2[0], give = up ? b2[0] : b2[1]; b1 = keep + __shfl_xor(give, 8); }
    b1 += __shfl_xor(b1, 16); b1 += __shfl_xor(b1, 32);
    return b1;
}
__device__ __forceinline__ int red16_index(int lane) { return 8 * (lane & 1) + 4 * ((lane >> 1) & 1) + 2 * ((lane >> 2) & 1) + ((lane >> 3) & 1); }

__device__ __forceinline__ void pg_token(int tok, float* __restrict__ xres, const LAS float* tab2  , const float* __restrict__ g2  , int gstride,
                                         const int* __restrict__ Eid, const float* __restrict__ Gw, const bf16_t* __restrict__ U, const bf16_t* __restrict__ V,
                                         bool last, const LAS float* tabn  , const float* __restrict__ final_g, bf16_t* __restrict__ Hn, float* __restrict__ outp, int lane) {
    const int b = tok >> 13;
    float x[16];
    float* xp = xres + (size_t)tok * DM + 8 * lane;
#pragma unroll
    for (int j = 0; j < 2; ++j) { const f32x4_t a = *(const f32x4_t*)(xp + 512 * j), c = *(const f32x4_t*)(xp + 512 * j + 4);
        x[8 * j] = a[0]; x[8 * j + 1] = a[1]; x[8 * j + 2] = a[2]; x[8 * j + 3] = a[3]; x[8 * j + 4] = c[0]; x[8 * j + 5] = c[1]; x[8 * j + 6] = c[2]; x[8 * j + 7] = c[3]; }
    float ss = 0.f;
#pragma unroll
    for (int i = 0; i < 16; ++i) ss += x[i] * x[i];
    const float rstd = 1.0f / sqrtf(wave_sum(ss) * (1.0f / DM) + EPS);
    float hh[16];
#pragma unroll
    for (int j = 0; j < 2; ++j)
#pragma unroll
        for (int i = 0; i < 8; ++i) { const int k = 8 * lane + 512 * j + i; hh[8 * j + i] = x[8 * j + i] * rstd * tab2[(b * 2 + 0) * 1024 + k] + tab2[(b * 2 + 1) * 1024 + k]; }
    float out[16];
#pragma unroll
    for (int i = 0; i < 16; ++i) out[i] = 0.f;
    const int ridx = red16_index(lane);
    for (int hd = 0; hd < PHEADS; ++hd) {
        const int ev = Eid[((size_t)tok * PHEADS + hd) * 16 + (lane & 15)];
        const float gv = Gw[((size_t)tok * PHEADS + hd) * 16 + ridx];
        float a[16];
#pragma unroll
        for (int half = 0; half < 2; ++half) {
            u32x4_t w[8][2];
#pragma unroll
            for (int k = 0; k < 8; ++k) { const int e = __builtin_amdgcn_readlane(ev, half * 8 + k); const bf16_t* up = U + (size_t)e * DM + 8 * lane;
                w[k][0] = *(const u32x4_t*)up; w[k][1] = *(const u32x4_t*)(up + 512); }
#pragma unroll
            for (int k = 0; k < 8; ++k) { float acc = 0.f;
#pragma unroll
                for (int j = 0; j < 2; ++j)
#pragma unroll
                    for (int q = 0; q < 4; ++q) { acc += hh[8 * j + 2 * q] * bf_lo(w[k][j][q]); acc += hh[8 * j + 2 * q + 1] * bf_hi(w[k][j][q]); }
                a[half * 8 + k] = acc; }
        }
        const float dot = reduce16(a, lane);
        const float wgt = gv * 0.5f * dot * (1.0f + erff(dot * 0.70710678118654752f));
#pragma unroll
        for (int half = 0; half < 2; ++half) {
            u32x4_t w[8][2];
#pragma unroll
            for (int k = 0; k < 8; ++k) { const int e = __builtin_amdgcn_readlane(ev, half * 8 + k); const bf16_t* vp = V + (size_t)e * DM + 8 * lane;
                w[k][0] = *(const u32x4_t*)vp; w[k][1] = *(const u32x4_t*)(vp + 512); }
#pragma unroll
            for (int k = 0; k < 8; ++k) { const int kk = half * 8 + k;
                const int src = ((kk >> 3) & 1) | (((kk >> 2) & 1) << 1) | (((kk >> 1) & 1) << 2) | ((kk & 1) << 3);
                const float wk = __builtin_bit_cast(float, __builtin_amdgcn_readlane(__builtin_bit_cast(int, wgt), src));
#pragma unroll
                for (int j = 0; j < 2; ++j)
#pragma unroll
                    for (int q = 0; q < 4; ++q) { out[8 * j + 2 * q] += wk * bf_lo(w[k][j][q]); out[8 * j + 2 * q + 1] += wk * bf_hi(w[k][j][q]); } }
        }
    }
    float y[16]; float s2 = 0.f;
#pragma unroll
    for (int j = 0; j < 2; ++j)
#pragma unroll
        for (int i = 0; i < 8; ++i) { const int k = 8 * lane + 512 * j + i; y[8 * j + i] = x[8 * j + i] + g2[(size_t)b * gstride + k] * out[8 * j + i]; s2 += y[8 * j + i] * y[8 * j + i]; }
    const float rn = 1.0f / sqrtf(wave_sum(s2) * (1.0f / DM) + EPS);
    if (!last) {
#pragma unroll
        for (int j = 0; j < 2; ++j) { *(f32x4_t*)(xp + 512 * j) = (f32x4_t){y[8 * j], y[8 * j + 1], y[8 * j + 2], y[8 * j + 3]}; *(f32x4_t*)(xp + 512 * j + 4) = (f32x4_t){y[8 * j + 4], y[8 * j + 5], y[8 * j + 6], y[8 * j + 7]}; }
        bf16_t* hp = Hn + (size_t)tok * DM + 8 * lane;
#pragma unroll
        for (int j = 0; j < 2; ++j) { float z[8];
#pragma unroll
            for (int i = 0; i < 8; ++i) { const int k = 8 * lane + 512 * j + i; z[i] = y[8 * j + i] * rn * tabn[(b * 2 + 0) * 1024 + k] + tabn[(b * 2 + 1) * 1024 + k]; }
            u32x4_t wv; wv.x = pk2(z[0], z[1]); wv.y = pk2(z[2], z[3]); wv.z = pk2(z[4], z[5]); wv.w = pk2(z[6], z[7]); *(u32x4_t*)(hp + 512 * j) = wv; }
    } else {
        float* op = outp + (size_t)tok * DM + 8 * lane;
#pragma unroll
        for (int j = 0; j < 2; ++j) { float z[8];
#pragma unroll
            for (int i = 0; i < 8; ++i) { z[i] = y[8 * j + i] * rn * final_g[8 * lane + 512 * j + i]; if (!(fabsf(z[i]) < 1e30f)) z[i] = 0.f; }
            *(f32x4_t*)(op + 512 * j) = (f32x4_t){z[0], z[1], z[2], z[3]}; *(f32x4_t*)(op + 512 * j + 4) = (f32x4_t){z[4], z[5], z[6], z[7]}; }
    }
}
}

constexpr int LDS_BYTES = 131072;
#define DBG_BASE 0
#ifndef ATM
#define ATM 7
#endif
#ifndef MK_N_LAUNCHES
#define MK_N_LAUNCHES 1
#endif
constexpr int N_PHASES = 2 + 7 * DEPTH;

struct Args { const float* in[19]; float* out; unsigned char* ws; int ph_lo, ph_hi; };
enum { I_X = 0, I_C, I_N1G, I_N2G, I_WADA, I_BADA, I_WIN, I_WOUT, I_LQ1, I_LK1, I_LQ2, I_LK2, I_SUBG, I_SINK, I_PWQ, I_PKEYS, I_PU, I_PV, I_FG };

__device__ __forceinline__ void p0_transpose_item(const float* W, int K, int N, bf16_t* WT, LAS float* scr, int item, int lane) {
    const int nblk = N / 32, kb = item / nblk, nb = item % nblk, k0 = 64 * kb, n0 = 32 * nb;
#pragma unroll 8
    for (int i = 0; i < 32; ++i) { const int kk = 2 * i + (lane >> 5); scr[kk * 33 + (lane & 31)] = W[(size_t)(k0 + kk) * N + n0 + (lane & 31)]; }
    asm volatile("s_waitcnt lgkmcnt(0)" ::: "memory");
    const int c = lane & 7;
#pragma unroll
    for (int j = 0; j < 4; ++j) { const int n = (lane >> 3) + 8 * j; const LAS float* s = scr + (8 * c) * 33 + n;
        u32x4_t o; o.x = pk2(s[0 * 33], s[1 * 33]); o.y = pk2(s[2 * 33], s[3 * 33]); o.z = pk2(s[4 * 33], s[5 * 33]); o.w = pk2(s[6 * 33], s[7 * 33]);
        *(u32x4_t*)(WT + (size_t)(n0 + n) * K + k0 + 8 * c) = o; }
    asm volatile("s_waitcnt lgkmcnt(0)" ::: "memory");
}
__device__ __forceinline__ void cvt_rows(const float* src, bf16_t* dst, size_t n, size_t gtid, size_t gthreads) {
    for (size_t i = gtid * 8; i < n; i += gthreads * 8) {
        const f32x4_t a = *(const f32x4_t*)(src + i), c = *(const f32x4_t*)(src + i + 4);
        u32x4_t o; o.x = pk2(a[0], a[1]); o.y = pk2(a[2], a[3]); o.z = pk2(c[0], c[1]); o.w = pk2(c[2], c[3]);
        *(u32x4_t*)(dst + i) = o;
    }
}
__device__ __forceinline__ void build_table(LAS float* tab, const float* gvec, const float* mod_l, int sh_idx, int sc_idx) {
    for (int i = threadIdx.x; i < 4096; i += NTHREADS) { const int b = i >> 10, k = i & 1023;
        tab[(b * 2 + 0) * 1024 + k] = gvec[k] * (1.0f + mod_l[b * 6144 + sc_idx * 1024 + k]);
        tab[(b * 2 + 1) * 1024 + k] = mod_l[b * 6144 + sh_idx * 1024 + k]; }
}
__device__ __forceinline__ void norm_row(const float* xrow, bf16_t* orow, const LAS float* tab, int b, int lane) {
    const f32x4_t* xr = (const f32x4_t*)xrow + lane;
    f32x4_t v[4]; float s = 0.f;
#pragma unroll
    for (int j = 0; j < 4; ++j) { v[j] = xr[64 * j]; s += (v[j][0] * v[j][0] + v[j][1] * v[j][1]) + (v[j][2] * v[j][2] + v[j][3] * v[j][3]); }
    const float rstd = 1.0f / sqrtf(wave_sum(s) * (1.0f / DM) + EPS);
    unsigned long long* o8 = (unsigned long long*)orow + lane;
#pragma unroll
    for (int j = 0; j < 4; ++j) { const int k = 4 * lane + 256 * j;
        const f32x4_t g = *(const LAS f32x4_t*)(tab + (b * 2 + 0) * 1024 + k), sh = *(const LAS f32x4_t*)(tab + (b * 2 + 1) * 1024 + k);
        const f32x4_t y = v[j] * rstd * g + sh;
        o8[64 * j] = (unsigned long long)pk2(y[0], y[1]) | ((unsigned long long)pk2(y[2], y[3]) << 32); }
}

__global__ void __launch_bounds__(NTHREADS, 2) hymba_fwd(Args args) {
    extern __shared__ __attribute__((aligned(16))) unsigned char lds_raw[];
    LAS unsigned char* lds = (LAS unsigned char*)lds_raw;
    cg::grid_group grid = cg::this_grid();
    const int tid = threadIdx.x;
#define OPAQUE_LANE() int lane; { int t_ = threadIdx.x; asm volatile("" : "+v"(t_)); lane = t_ & 63; }
    const int wave = __builtin_amdgcn_readfirstlane(tid >> 6);
    const int G = gridDim.x, bx = blockIdx.x;
    const int gw = bx * NWAVES + wave, NGW = G * NWAVES;
    unsigned char* ws = args.ws;
    bf16_t* Wt_in = (bf16_t*)(ws + WS_WIN); bf16_t* Wt_out = (bf16_t*)(ws + WS_WOUT); bf16_t* Wt_q = (bf16_t*)(ws + WS_WQ); bf16_t* keysb = (bf16_t*)(ws + WS_KEYS);
    float* modf = (float*)(ws + WS_MOD); float* kmean = (float*)(ws + WS_KMEAN); float* scal = (float*)(ws + WS_SCAL);
    bf16_t* Ub = (bf16_t*)(ws + WS_U); bf16_t* Vb = (bf16_t*)(ws + WS_V); bf16_t* Hb = (bf16_t*)(ws + WS_H);
    bf16_t* Pj = (bf16_t*)(ws + WS_PROJ); bf16_t* Qp = (bf16_t*)(ws + WS_PROJ); bf16_t* Ob = (bf16_t*)(ws + WS_O);
    int* Eid = (int*)(ws + WS_O); float* Gw = (float*)(ws + WS_O + 16 * MiB);
    const int lo = args.ph_lo, hi_ = args.ph_hi;
#ifndef PHMASK
#define PHMASK 0xffffu
#endif
#define IN(k) (((PHMASK >> ((k) < 2 ? (k) : 2 + ((k) - 2) % 7)) & 1u) && lo <= (k) && (k) < hi_)
#define SEAM(k) do { if (IN(k) && IN((k) + 1)) grid.sync(); } while (0)

    if (IN(0)) {
        OPAQUE_LANE();
        if (bx < 192) {
            LAS float* cs = (LAS float*)lds;
            LAS float* red = (LAS float*)(lds + 16384);
            for (int i = tid; i < 4096; i += NTHREADS) { const float cv = args.in[I_C][i]; cs[i] = cv / (1.0f + __expf(-cv)); }
            __syncthreads();
            for (int it = bx; it < 192; it += G) {
                const int l = it / 96, n = (it % 96) * 64 + lane;
                const float* wp = args.in[I_WADA] + (size_t)l * DM * 6144 + n;
                float a0 = 0.f, a1 = 0.f, a2 = 0.f, a3 = 0.f;
#pragma unroll 8
                for (int k = wave * 128; k < wave * 128 + 128; ++k) { const float wv = wp[(size_t)k * 6144]; a0 += cs[k] * wv; a1 += cs[1024 + k] * wv; a2 += cs[2048 + k] * wv; a3 += cs[3072 + k] * wv; }
                red[(wave * 4 + 0) * 64 + lane] = a0; red[(wave * 4 + 1) * 64 + lane] = a1; red[(wave * 4 + 2) * 64 + lane] = a2; red[(wave * 4 + 3) * 64 + lane] = a3;
                __syncthreads();
                if (wave < 4) { float s = args.in[I_BADA][l * 6144 + n];
#pragma unroll
                    for (int w = 0; w < 8; ++w) s += red[(w * 4 + wave) * 64 + lane];
                    modf[((size_t)l * 4 + wave) * 6144 + n] = s; }
                __syncthreads();
            }
        }
        __syncthreads();
        {
            LAS float* scr = (LAS float*)(lds + wave * 16384);
            constexpr int I_IN = 16 * (INW / 32), I_OUT = 16 * (DM / 32), I_Q = 16 * (PQW / 32), PER_L = I_IN + I_OUT + I_Q;
            for (int it = gw; it < DEPTH * PER_L; it += NGW) {
                const int l = it / PER_L; int r = it % PER_L;
                if (r < I_IN) { p0_transpose_item(args.in[I_WIN] + (size_t)l * DM * INW, DM, INW, Wt_in + (size_t)l * INW * DM, scr, r, lane); continue; } r -= I_IN;
                if (r < I_OUT) { p0_transpose_item(args.in[I_WOUT] + (size_t)l * DM * DM, DM, DM, Wt_out + (size_t)l * DM * DM, scr, r, lane); continue; } r -= I_OUT;
                p0_transpose_item(args.in[I_PWQ] + (size_t)l * DM * PQW, DM, PQW, Wt_q + (size_t)l * PQW * DM, scr, r, lane);
            }
        }
        {
            const size_t gtid = (size_t)bx * NTHREADS + tid, gth = (size_t)G * NTHREADS;
            cvt_rows(args.in[I_PKEYS], keysb, (size_t)DEPTH * PHEADS * 2 * 128 * 128, gtid, gth);
            cvt_rows(args.in[I_PU], Ub, (size_t)DEPTH * PNEXP * DM, gtid, gth);
            cvt_rows(args.in[I_PV], Vb, (size_t)DEPTH * PNEXP * DM, gtid, gth);
            for (size_t i = gtid; i < (size_t)DEPTH * 4 * 6 * 32 * 64; i += gth) kmean[i] = 0.f;
            if (gtid < DEPTH) { const int l = (int)gtid; float s1 = 0.f, s2 = 0.f;
                for (int i = 0; i < 32; ++i) { s1 += args.in[I_LQ1][l * 32 + i] * args.in[I_LK1][l * 32 + i]; s2 += args.in[I_LQ2][l * 32 + i] * args.in[I_LK2][l * 32 + i]; }
                const float lam_init = 0.8f - 0.6f * expf(-0.3f * (float)l);
                scal[l * 4 + 0] = expf(s1) - expf(s2) + lam_init; scal[l * 4 + 1] = lam_init; }
        }
    }
    SEAM(0);
    if (IN(1)) {
        OPAQUE_LANE();
        LAS float* tab = (LAS float*)lds;
        build_table(tab, args.in[I_N1G], modf, 0, 1);
        __syncthreads();
        for (int m = gw; m < TOK; m += NGW) norm_row(args.in[I_X] + (size_t)m * DM, Hb + (size_t)m * DM, tab, m >> 13, lane);
        __syncthreads();
    }
    SEAM(1);

    for (int l = 0; l < DEPTH; ++l) {
        const int P = 2 + 7 * l;
        const float* mod_l = modf + (size_t)l * 4 * 6144;
        float* kmean_l = kmean + (size_t)l * 4 * 6 * 32 * 64;
        float* xres_out = args.out;
        const float* xres_in = (l == 0) ? args.in[I_X] : args.out;
        if (IN(P + 0)) {
            pg8::Gemm g{Hb, Wt_in + (size_t)l * INW * DM, TOK, INW, DM}; pg8::StaticOrder S; S.init(TOK, INW, G, bx);
            pg8::EpiProj E{Pj, INW, kmean_l, OFF_KB};
            pg8::gemm_phase<pg8::EpiProj, pg8::StaticOrder, true, true>(lds, g, S, E);
        }
        SEAM(P + 0);
        if (IN(P + 1)) {
            const float lam = scal[l * 4 + 0], lam_init = scal[l * 4 + 1];
            constexpr int NUNITS = 2048;
            for (int rnd = 0; rnd * G < NUNITS; ++rnd) {
                const int idx = rnd * G + ((rnd & 1) ? (G - 1 - bx) : bx);
                if (idx >= NUNITS) continue;
                if (idx < 1280) {
                    const int qb = 31 - idx / 40, j = idx % 40;
                    if (j < 16) { if (ATM & 1) att::attn_unit<0>(j >> 2, j & 3, qb, Pj, Ob, kmean_l, lam, lam_init, args.in[I_SUBG] + l * 64, 0.f, lds); }
                    else { const int jj = j - 16; if (ATM & 2) att::attn_unit<1>(jj / 6, jj % 6, qb, Pj, Ob, kmean_l, 0.f, 0.f, nullptr, 0.f, lds); }
                } else {
                    const int j = idx - 1280, qb = j / 24, jj = j % 24;
                    if (ATM & 4) att::attn_unit<2>(jj / 6, jj % 6, qb, Pj, Ob, kmean_l, 0.f, 0.f, nullptr, args.in[I_SINK][l * 6 + jj % 6], lds);
                }
            }
        }
        SEAM(P + 1);
        if (IN(P + 2)) {
            pg8::Gemm g{Ob, Wt_out + (size_t)l * DM * DM, TOK, DM, DM}; pg8::StaticOrder S; S.init(TOK, DM, G, bx);
            pg8::EpiRes E{xres_in, xres_out, DM, mod_l + 2 * 1024, 6144};
            pg8::gemm_phase<pg8::EpiRes, pg8::StaticOrder, true, true>(lds, g, S, E);
        }
        SEAM(P + 2);
        if (IN(P + 3)) {
            OPAQUE_LANE();
            LAS float* tab = (LAS float*)lds;
            build_table(tab, args.in[I_N2G] + l * DM, mod_l, 3, 4);
            __syncthreads();
            for (int m = gw; m < TOK; m += NGW) norm_row(xres_out + (size_t)m * DM, Hb + (size_t)m * DM, tab, m >> 13, lane);
            __syncthreads();
        }
        SEAM(P + 3);
        if (IN(P + 4)) {
            pg8::Gemm g{Hb, Wt_q + (size_t)l * PQW * DM, TOK, PQW, DM}; pg8::StaticOrder S; S.init(TOK, PQW, G, bx);
            pg8::EpiBf16Plain E{Qp, PQW};
            pg8::gemm_phase<pg8::EpiBf16Plain, pg8::StaticOrder, true, true>(lds, g, S, E);
        }
        SEAM(P + 4);
        if (IN(P + 5)) {
            for (int u = bx; u < (TOK / 256) * PHEADS; u += G) peer::pk_unit(u >> 3, u & 7, Qp, keysb + (size_t)l * PHEADS * 2 * 128 * 128, Eid, Gw, lds);
            __syncthreads();
        }
        SEAM(P + 5);
        if (IN(P + 6)) {
            OPAQUE_LANE();
            LAS float* tab2 = (LAS float*)lds; LAS float* tabn = (LAS float*)(lds + 32768);
            const bool last = (l == DEPTH - 1);
            build_table(tab2, args.in[I_N2G] + l * DM, mod_l, 3, 4);
            if (!last) build_table(tabn, args.in[I_N1G] + (l + 1) * DM, mod_l + 4 * 6144, 0, 1);
            __syncthreads();
            for (int m = gw; m < TOK; m += NGW)
                peer::pg_token(m, xres_out, tab2, mod_l + 5 * 1024, 6144, Eid, Gw, Ub + (size_t)l * PNEXP * DM, Vb + (size_t)l * PNEXP * DM, last, tabn, args.in[I_FG], Hb, args.out, lane);
            __syncthreads();
        }
        if (l + 1 < DEPTH) SEAM(P + 6);
    }
#undef IN
#undef SEAM
}


#ifdef DBG
__global__ void dbg_chk16(const bf16_t* p, size_t n, unsigned* flag, unsigned bit) {
    bool bad = false;
    for (size_t i = (size_t)blockIdx.x * blockDim.x + threadIdx.x; i < n; i += (size_t)gridDim.x * blockDim.x) bad |= ((p[i] & 0x7f80u) == 0x7f80u);
    if (bad) atomicOr(flag, bit);
}
__global__ void dbg_chk32(const float* p, size_t n, unsigned* flag, unsigned bit) {
    bool bad = false;
    for (size_t i = (size_t)blockIdx.x * blockDim.x + threadIdx.x; i < n; i += (size_t)gridDim.x * blockDim.x) bad |= ((__builtin_bit_cast(unsigned, p[i]) & 0x7f800000u) == 0x7f800000u);
    if (bad) atomicOr(flag, bit);
}
__global__ void dbg_chk_o(const bf16_t* p, unsigned* flag) {
    unsigned bad = 0;
    for (size_t i = (size_t)blockIdx.x * blockDim.x + threadIdx.x; i < (size_t)TOK * DM; i += (size_t)gridDim.x * blockDim.x) {
        if ((p[i] & 0x7f80u) == 0x7f80u) { const int c = (int)(i & 1023); const int r = (int)((i >> 10) & 8191); bad |= (c < 256) ? 1u : (c < 640 ? 2u : 4u); if (r < 256) bad |= 8u; if ((r & 255) < 32) bad |= 16u; if (p[i] & 0x7fu) bad |= 32u; }
    }
    if (bad) atomicOr(flag, bad);
}
__global__ void dbg_fill(float* out, size_t n, const unsigned* flag) {
    const unsigned f = *flag; if (f == 0u) return;
    const float c = sqrtf((float)f);
    for (size_t i = (size_t)blockIdx.x * blockDim.x + threadIdx.x; i < n; i += (size_t)gridDim.x * blockDim.x) out[i] = c;
}
#endif
extern "C" void kernel_launch(void* const* d_in, const int* in_sizes, int n_in, void* d_out, int out_size, void* d_ws, size_t ws_size, hipStream_t stream) {
    static int grid = 0;
    if (grid == 0) {
        if (n_in != 19 || out_size != TOK * DM || ws_size < WS_END) { fprintf(stderr, "kernel_launch: unexpected shapes (n_in %d out %d ws %zu)\n", n_in, out_size, ws_size); grid = -1; return; }
        int dev = 0, cus = 0, per_cu = 0;
        hipGetDevice(&dev); hipDeviceGetAttribute(&cus, hipDeviceAttributeMultiprocessorCount, dev);
        hipFuncSetAttribute((const void*)hymba_fwd, hipFuncAttributeMaxDynamicSharedMemorySize, LDS_BYTES);
        hipOccupancyMaxActiveBlocksPerMultiprocessor(&per_cu, (const void*)hymba_fwd, NTHREADS, LDS_BYTES);
        (void)hipGetLastError();
        if (per_cu < 1) per_cu = 1;
        if (per_cu > 1) per_cu = 1;
        grid = cus * per_cu;
        if (grid <= 0) grid = 256;
    }
    if (grid < 0) return;
    hipMemsetAsync((char*)d_ws + WS_CTL, 0, CTL_ZERO_BYTES, stream);
    Args a{};
    for (int i = 0; i < 19; ++i) a.in[i] = (const float*)d_in[i];
    a.out = (float*)d_out; a.ws = (unsigned char*)d_ws;
#if MK_N_LAUNCHES == 1
    a.ph_lo = 0; a.ph_hi = N_PHASES;
    void* kargs[] = {&a};
    hipError_t e = hipLaunchCooperativeKernel((const void*)hymba_fwd, dim3(grid), dim3(NTHREADS), kargs, LDS_BYTES, stream);
    if (e != hipSuccess) fprintf(stderr, "cooperative launch failed: %s (grid %d)\n", hipGetErrorString(e), grid);
#else
    for (int p = 0; p < N_PHASES; ++p) { a.ph_lo = p; a.ph_hi = p + 1; hipLaunchKernelGGL(hymba_fwd, dim3(grid), dim3(NTHREADS), LDS_BYTES, stream, a);
#ifdef DBG
        unsigned* flag = (unsigned*)((char*)d_ws + WS_CTL); unsigned char* w = (unsigned char*)d_ws;
        const int base = DBG_BASE;
        if (p == 3) dbg_chk_o<<<1024, 256, 0, stream>>>((const bf16_t*)(w + WS_O), flag);
#endif
    }
#ifdef DBG
    dbg_fill<<<1024, 256, 0, stream>>>((float*)d_out, (size_t)TOK * DM, (const unsigned*)((char*)d_ws + WS_CTL));
#endif
#endif
}
```

```cpp
#include <hip/hip_runtime.h>
#include <hip/hip_cooperative_groups.h>
#include <cstdio>
#include <cstdint>
#include <cmath>
namespace cg = cooperative_groups;

constexpr int DM = 1024, NBATCH = 4, SEQ = 8192, DEPTH = 2, TOK = NBATCH * SEQ;
constexpr int INW = 2560, NMOD = 6;
constexpr int OFF_QA = 0, OFF_KA = 256, OFF_VA = 512, OFF_QB = 768, OFF_KB = 1152, OFF_VB = 1536, OFF_QC = 1920, OFF_KC = 2304, OFF_VC = 2432;
constexpr int PHEADS = 8, PQW = 2048, PNK = 128, PNEXP = 16384, PTOPK = 16;
constexpr float EPS = 1e-6f;
constexpr float LOG2E = 1.4426950408889634f;
constexpr int NWAVES = 8, NTHREADS = 512;

constexpr size_t MiB = 1u << 20;
constexpr size_t WS_CTL = 0, CTL_ZERO_BYTES = 64 * 1024;
constexpr size_t WS_WIN = 1 * MiB;
constexpr size_t WS_WOUT = 11 * MiB;
constexpr size_t WS_WQ = 15 * MiB;
constexpr size_t WS_KEYS = 23 * MiB;
constexpr size_t WS_MOD = 24 * MiB;
constexpr size_t WS_KMEAN = 24 * MiB + 256 * 1024;
constexpr size_t WS_SCAL = 25 * MiB;
constexpr size_t WS_U = 26 * MiB;
constexpr size_t WS_V = 90 * MiB;
constexpr size_t WS_H = 154 * MiB;
constexpr size_t WS_PROJ = 218 * MiB;
constexpr size_t WS_O = 378 * MiB;
constexpr size_t WS_END = 442 * MiB;

#define GAS __attribute__((address_space(1)))
#define LAS __attribute__((address_space(3)))
typedef unsigned short bf16_t;
typedef short bf16x8_t __attribute__((ext_vector_type(8)));
typedef short s16x4_t __attribute__((ext_vector_type(4)));
typedef float f32x4_t __attribute__((ext_vector_type(4)));
typedef float f32x16_t __attribute__((ext_vector_type(16)));
typedef unsigned u32x4_t __attribute__((ext_vector_type(4)));
typedef unsigned u32x2_t __attribute__((ext_vector_type(2)));

__device__ __forceinline__ unsigned f2bf(float f) { unsigned u = __builtin_bit_cast(unsigned, f); return (u + 0x7fffu + ((u >> 16) & 1u)) >> 16; }
__device__ __forceinline__ unsigned pk2(float lo, float hi) { return f2bf(lo) | (f2bf(hi) << 16); }
__device__ __forceinline__ float bf_lo(unsigned w) { return __builtin_bit_cast(float, w << 16); }
__device__ __forceinline__ float bf_hi(unsigned w) { return __builtin_bit_cast(float, w & 0xffff0000u); }
__device__ __forceinline__ float wave_sum(float v) {
#pragma unroll
    for (int o = 1; o < 64; o <<= 1) v += __shfl_xor(v, o);
    return v;
}
__device__ __forceinline__ float swap32_partner(float v, int) { return __shfl_xor(v, 32); }
__device__ __forceinline__ float alibi_slope(int i) { return exp2f(-0.5f * (float)(i + 1)); }

namespace pg8 {
#define PG8_LAS __attribute__((address_space(3)))
typedef unsigned short bf16_t;
typedef short bf16x8 __attribute__((ext_vector_type(8)));
typedef float f32x4 __attribute__((ext_vector_type(4)));
typedef unsigned u32x4 __attribute__((ext_vector_type(4)));
constexpr int BM = 256, BK = 64, HALF = 128, HTB = HALF * BK * 2  , STAGE_BYTES = 8 * HTB, NXCD = 8, WGM = 8;

__host__ __device__ __forceinline__ int lds_byte(int r, int c) { const int st = (r >> 4) * 2 + (c >> 5), rr = r & 15, cc = c & 31, ob = rr * 64 + cc * 2; return st * 1024 + (ob ^ (((ob >> 9) & 1) << 5)); }
__host__ __device__ __forceinline__ void stage_rc(int b, int& R, int& C) { const int st = b / 1024, sb = b % 1024, swz = sb ^ (((sb >> 9) & 1) << 5); R = (st >> 1) * 16 + swz / 64; C = (st & 1) * 32 + (swz % 64) / 2; }
__host__ __device__ __forceinline__ int perm32(int rho) { const int n = rho >> 4, i = rho & 15; return 8 * (i >> 2) + 4 * n + (i & 3); }

struct Unit { int pm, pn; };
struct Gemm { const bf16_t* A; const bf16_t* Bt; int M, N, K; };

struct StaticOrder {
    int nM, nN, nwg, G, c;
    __host__ __device__ void init(int M, int N, int G_, int c_) { nM = M / BM; nN = N / BM; nwg = nM * nN; G = G_; c = c_; }
    __host__ __device__ bool next(int i, Unit& u) const {
        const long L = (long)i * G + c; if (L >= nwg) return false;
        int wgid = (int)L; { const int q = nwg / NXCD, r = nwg % NXCD, xcd = wgid % NXCD, off = wgid / NXCD; wgid = (xcd < r ? xcd * (q + 1) : r * (q + 1) + (xcd - r) * q) + off; }
        const int nig = WGM * nN, gid = wgid / nig, fm = gid * WGM, gsz = (nM - fm) < WGM ? (nM - fm) : WGM;
        u.pm = fm + ((wgid % nig) % gsz); u.pn = (wgid % nig) / gsz; return true;
    }
    __device__ __forceinline__ void a_ready(const Unit&) const {}
    __device__ __forceinline__ void done(const Unit&) const {}
};

__device__ __forceinline__ unsigned cvt_pk_bf16(float lo, float hi) { unsigned r; asm volatile("v_cvt_pk_bf16_f32 %0, %1, %2" : "=v"(r) : "v"(lo), "v"(hi)); return r; }
struct EpiBf16Plain {
    static constexpr bool PERM = true, AFTER_DRAIN = false;
    bf16_t* O; int ldc;
    __device__ __forceinline__ void operator()(const f32x4 (&acc)[2][2][4][2], const Unit& u, int wr, int wc, int fr, int fq) const {
        const int row0 = u.pm * BM + wr * 64 + fr, col0 = u.pn * BM + wc * 32 + 8 * fq;
#pragma unroll
        for (int ai = 0; ai < 2; ++ai)
#pragma unroll
            for (int m = 0; m < 4; ++m) { bf16_t* rowp = O + (size_t)(row0 + ai * HALF + m * 16) * ldc + col0;
#pragma unroll
                for (int bj = 0; bj < 2; ++bj) { const f32x4 v0 = acc[ai][bj][m][0], v1 = acc[ai][bj][m][1];
                    u32x4 w; w.x = cvt_pk_bf16(v0[0], v0[1]); w.y = cvt_pk_bf16(v0[2], v0[3]); w.z = cvt_pk_bf16(v1[0], v1[1]); w.w = cvt_pk_bf16(v1[2], v1[3]);
                    *(u32x4*)(rowp + bj * HALF) = w; } }
    }
};
struct EpiProj {
    static constexpr bool PERM = true, AFTER_DRAIN = false;
    bf16_t* O; int ldc; float* kmean; int kb_lo;
    __device__ __forceinline__ void operator()(const f32x4 (&acc)[2][2][4][2], const Unit& u, int wr, int wc, int fr, int fq) const {
        const int row0 = u.pm * BM + wr * 64 + fr, col0 = u.pn * BM + wc * 32 + 8 * fq;
#pragma unroll
        for (int ai = 0; ai < 2; ++ai)
#pragma unroll
            for (int m = 0; m < 4; ++m) { bf16_t* rowp = O + (size_t)(row0 + ai * HALF + m * 16) * ldc + col0;
#pragma unroll
                for (int bj = 0; bj < 2; ++bj) { const f32x4 v0 = acc[ai][bj][m][0], v1 = acc[ai][bj][m][1];
                    u32x4 w; w.x = cvt_pk_bf16(v0[0], v0[1]); w.y = cvt_pk_bf16(v0[2], v0[3]); w.z = cvt_pk_bf16(v1[0], v1[1]); w.w = cvt_pk_bf16(v1[2], v1[3]);
                    *(u32x4*)(rowp + bj * HALF) = w; } }
#pragma unroll
        for (int bj = 0; bj < 2; ++bj) {
            const int cb = u.pn * BM + bj * HALF;
            if (cb >= kb_lo && cb < kb_lo + 384) {
                f32x4 s0 = {0.f, 0.f, 0.f, 0.f}, s1 = {0.f, 0.f, 0.f, 0.f};
#pragma unroll
                for (int ai = 0; ai < 2; ++ai)
#pragma unroll
                    for (int m = 0; m < 4; ++m) { s0 += acc[ai][bj][m][0]; s1 += acc[ai][bj][m][1]; }
#pragma unroll
                for (int i = 0; i < 4; ++i) {
#pragma unroll
                    for (int o = 1; o < 16; o <<= 1) { s0[i] += __shfl_xor(s0[i], o); s1[i] += __shfl_xor(s1[i], o); }
                }
                if (fr == 0) {
                    const int c = cb + wc * 32 + 8 * fq - kb_lo, h = c >> 6, d = c & 63, b = u.pm >> 5, nb = u.pm & 31;
                    float* kp = kmean + ((size_t)((b * 6 + h) * 32 + nb)) * 64 + d;
#pragma unroll
                    for (int i = 0; i < 4; ++i) { atomicAdd(kp + i, s0[i]); atomicAdd(kp + 4 + i, s1[i]); }
                }
            }
        }
    }
};
struct EpiRes {
    static constexpr bool PERM = false, AFTER_DRAIN = false;
    const float* base; float* out; int ldc; const float* gate; int gstride;
    __device__ __forceinline__ void operator()(const f32x4 (&acc)[2][2][4][2], const Unit& u, int wr, int wc, int fr, int fq) const {
        const int row0 = u.pm * BM + wr * 64 + fr, col0 = u.pn * BM + wc * 32 + 4 * fq;
        const float* gp = gate + (size_t)(u.pm >> 5) * gstride + col0;
        f32x4 gv[2][2];
#pragma unroll
        for (int bj = 0; bj < 2; ++bj)
#pragma unroll
            for (int n = 0; n < 2; ++n) gv[bj][n] = *(const f32x4*)(gp + bj * HALF + n * 16);
#pragma unroll
        for (int ai = 0; ai < 2; ++ai)
#pragma unroll
            for (int m = 0; m < 4; ++m) { const size_t off = (size_t)(row0 + ai * HALF + m * 16) * ldc + col0;
#pragma unroll
                for (int bj = 0; bj < 2; ++bj)
#pragma unroll
                    for (int n = 0; n < 2; ++n) { const f32x4 bs = *(const f32x4*)(base + off + bj * HALF + n * 16);
                        *(f32x4*)(out + off + bj * HALF + n * 16) = bs + gv[bj][n] * acc[ai][bj][m][n]; } }
    }
};

template <class Epi, class Sched, bool ALIGN_EPI = false, bool SP2 = false>
__device__ __forceinline__ void gemm_phase(PG8_LAS unsigned char* lds, const Gemm g, const Sched& S, const Epi& E) {
    int tid_ = threadIdx.x; asm volatile("" : "+v"(tid_));
    const int tid = tid_, wid = __builtin_amdgcn_readfirstlane(tid >> 6), lane = tid & 63, wr = wid >> 2, wc = wid & 3, fr = lane & 15, fq = lane >> 4;
    const int K = g.K, nt = K / BK;
    unsigned voffA[2], voffB[2];
#pragma unroll
    for (int i = 0; i < 2; ++i) { int R, C; stage_rc(tid * 16 + i * 8192, R, C); const int Rb = Epi::PERM ? ((R & ~31) + perm32(R & 31)) : R;
        voffA[i] = (unsigned)(R * K + C) * 2u; voffB[i] = (unsigned)(Rb * K + C) * 2u; }
    const size_t kstep = (size_t)(BK * 2);
    const size_t hstep = (size_t)HALF * K * 2;
    const size_t tstep = 2 * hstep;
    const unsigned ldsw = (unsigned)wid * 1024u;
    const int aoff = lds_byte(wr * 64 + fr, fq * 8), boff = lds_byte(wc * 32 + fr, fq * 8);
#define PG8_SA(b, h) (((b) * 2 + (h)) * HTB)
#define PG8_SB(b, h) ((4 + (b) * 2 + (h)) * HTB)
#define PG8_STAGE(bufoff, gbase, voff) do { _Pragma("unroll") for (int _i = 0; _i < 2; ++_i) \
        __builtin_amdgcn_global_load_lds((const unsigned*)((const char*)(gbase) + (voff)[_i]), (PG8_LAS unsigned*)(lds + (bufoff) + ldsw + _i * 8192), 16, 0, 0); } while (0)
#define PG8_LDA(dst, b, h) do { _Pragma("unroll") for (int m = 0; m < 4; ++m) _Pragma("unroll") for (int k = 0; k < 2; ++k) dst[m][k] = *(const PG8_LAS bf16x8*)(lds + PG8_SA(b, h) + aoff + m * 2048 + k * 1024); } while (0)
#define PG8_LDB(dst, b, h) do { _Pragma("unroll") for (int n = 0; n < 2; ++n) _Pragma("unroll") for (int k = 0; k < 2; ++k) dst[n][k] = *(const PG8_LAS bf16x8*)(lds + PG8_SB(b, h) + boff + n * 2048 + k * 1024); } while (0)
#define PG8_MMA(ai, bj, At, Bt) do { __builtin_amdgcn_s_setprio(1); _Pragma("unroll") for (int m = 0; m < 4; ++m) _Pragma("unroll") for (int n = 0; n < 2; ++n) _Pragma("unroll") for (int k = 0; k < 2; ++k) \
        acc[ai][bj][m][n] = __builtin_amdgcn_mfma_f32_16x16x32_bf16(Bt[n][k], At[m][k], acc[ai][bj][m][n], 0, 0, 0); __builtin_amdgcn_s_setprio(0); } while (0)
#define PG8_WAIT_V(n) asm volatile("s_waitcnt vmcnt(" #n ")" ::: "memory")
#define PG8_WAIT_L(n) asm volatile("s_waitcnt lgkmcnt(" #n ")" ::: "memory")
#define PG8_BAR __builtin_amdgcn_s_barrier()
#define PG8_SCHED __builtin_amdgcn_sched_barrier(0)
    Unit cur, nxt; int ui = 0;
    if (!S.next(0, cur)) return;
    f32x4 acc[2][2][4][2];
#pragma unroll
    for (int a = 0; a < 2; ++a)
#pragma unroll
        for (int b = 0; b < 2; ++b)
#pragma unroll
            for (int m = 0; m < 4; ++m)
#pragma unroll
                for (int n = 0; n < 2; ++n) acc[a][b][m][n] = (f32x4){0.f, 0.f, 0.f, 0.f};
    bf16x8 At[4][2], B0[2][2], B1[2][2];
    const char* cA = (const char*)g.A + (size_t)cur.pm * tstep; const char* cB = (const char*)g.Bt + (size_t)cur.pn * tstep;
    S.a_ready(cur);
    if constexpr (SP2) {
        PG8_STAGE(PG8_SB(0, 0), cB, voffB); PG8_STAGE(PG8_SB(0, 1), cB + hstep, voffB); PG8_STAGE(PG8_SA(0, 0), cA, voffA); PG8_STAGE(PG8_SA(0, 1), cA + hstep, voffA);
        if (wr == 1) PG8_BAR;
        PG8_WAIT_V(2); PG8_BAR;
        PG8_STAGE(PG8_SB(1, 0), cB + kstep, voffB); PG8_STAGE(PG8_SA(1, 0), cA + kstep, voffA); PG8_STAGE(PG8_SB(1, 1), cB + hstep + kstep, voffB);
        PG8_WAIT_V(6); PG8_BAR;
    } else {
        PG8_STAGE(PG8_SB(0, 0), cB, voffB); PG8_STAGE(PG8_SA(0, 0), cA, voffA); PG8_STAGE(PG8_SB(0, 1), cB + hstep, voffB); PG8_STAGE(PG8_SA(0, 1), cA + hstep, voffA);
        if (wr == 1) PG8_BAR;
        PG8_WAIT_V(4); PG8_BAR;
        PG8_STAGE(PG8_SB(1, 0), cB + kstep, voffB); PG8_STAGE(PG8_SA(1, 0), cA + kstep, voffA); PG8_STAGE(PG8_SB(1, 1), cB + hstep + kstep, voffB);
        PG8_WAIT_V(6); PG8_BAR;
    }
    for (;;) {
        const bool has_next = S.next(ui + 1, nxt);
        const char* nA = has_next ? (const char*)g.A + (size_t)nxt.pm * tstep : cA; const char* nB = has_next ? (const char*)g.Bt + (size_t)nxt.pn * tstep : cB;
        for (int t = 0; t < nt; t += 2) {
            const bool last = (t == nt - 2);
            const char* a1 = cA + (size_t)(t + 1) * kstep;
            const char* a2 = last ? nA : cA + (size_t)(t + 2) * kstep; const char* b2 = last ? nB : cB + (size_t)(t + 2) * kstep;
            const char* a3 = a2 + kstep; const char* b3 = b2 + kstep;
            if (last && has_next) S.a_ready(nxt);
            if constexpr (SP2) {
            PG8_LDB(B0, 0, 0); PG8_LDB(B1, 0, 1); PG8_SCHED; PG8_LDA(At, 0, 0); PG8_STAGE(PG8_SA(1, 1), a1 + hstep, voffA);
            PG8_WAIT_V(8); PG8_WAIT_L(0); PG8_BAR; PG8_MMA(0, 0, At, B0); PG8_MMA(0, 1, At, B1); PG8_BAR; PG8_SCHED;
            PG8_LDA(At, 0, 1); PG8_STAGE(PG8_SB(0, 0), b2, voffB); PG8_STAGE(PG8_SB(0, 1), b2 + hstep, voffB); PG8_STAGE(PG8_SA(0, 0), a2, voffA);
            PG8_WAIT_V(8); PG8_WAIT_L(0); PG8_BAR; PG8_MMA(1, 0, At, B0); PG8_MMA(1, 1, At, B1); PG8_BAR; PG8_SCHED;
            PG8_LDB(B0, 1, 0); PG8_LDB(B1, 1, 1); PG8_SCHED; PG8_LDA(At, 1, 0); PG8_STAGE(PG8_SA(0, 1), a2 + hstep, voffA);
            PG8_WAIT_V(8); PG8_WAIT_L(0); PG8_BAR; PG8_MMA(0, 0, At, B0); PG8_MMA(0, 1, At, B1); PG8_BAR; PG8_SCHED;
            PG8_LDA(At, 1, 1); PG8_STAGE(PG8_SB(1, 0), b3, voffB); PG8_STAGE(PG8_SB(1, 1), b3 + hstep, voffB); PG8_STAGE(PG8_SA(1, 0), a3, voffA);
            PG8_WAIT_V(8); PG8_WAIT_L(0); PG8_BAR; PG8_MMA(1, 0, At, B0); PG8_MMA(1, 1, At, B1); PG8_BAR; PG8_SCHED;
            } else {
            PG8_LDB(B0, 0, 0); PG8_SCHED; PG8_LDA(At, 0, 0); PG8_STAGE(PG8_SA(1, 1), a1 + hstep, voffA);
            PG8_WAIT_L(8); PG8_BAR; PG8_WAIT_L(0); PG8_MMA(0, 0, At, B0); PG8_BAR; PG8_SCHED;
            PG8_LDB(B1, 0, 1); PG8_STAGE(PG8_SB(0, 0), b2, voffB);
            PG8_BAR; PG8_WAIT_L(0); PG8_MMA(0, 1, At, B1); PG8_BAR;
            PG8_LDA(At, 0, 1); PG8_STAGE(PG8_SA(0, 0), a2, voffA);
            PG8_BAR; PG8_WAIT_L(0); PG8_MMA(1, 0, At, B0); PG8_BAR; PG8_SCHED;
            PG8_STAGE(PG8_SB(0, 1), b2 + hstep, voffB);
            PG8_WAIT_V(6); PG8_BAR; PG8_MMA(1, 1, At, B1); PG8_BAR;
            PG8_LDB(B0, 1, 0); PG8_SCHED; PG8_LDA(At, 1, 0); PG8_STAGE(PG8_SA(0, 1), a2 + hstep, voffA);
            PG8_WAIT_L(8); PG8_BAR; PG8_WAIT_L(0); PG8_MMA(0, 0, At, B0); PG8_BAR; PG8_SCHED;
            PG8_LDB(B1, 1, 1); PG8_STAGE(PG8_SB(1, 0), b3, voffB);
            PG8_BAR; PG8_WAIT_L(0); PG8_MMA(0, 1, At, B1); PG8_BAR;
            PG8_LDA(At, 1, 1); PG8_STAGE(PG8_SA(1, 0), a3, voffA);
            PG8_BAR; PG8_WAIT_L(0); PG8_MMA(1, 0, At, B0); PG8_BAR; PG8_SCHED;
            PG8_STAGE(PG8_SB(1, 1), b3 + hstep, voffB);
            PG8_WAIT_V(6); PG8_BAR; PG8_MMA(1, 1, At, B1); PG8_BAR;
            }
        }
        if constexpr (ALIGN_EPI) { if (wr == 0) PG8_BAR; }
        if constexpr (!Epi::AFTER_DRAIN) { E(acc, cur, wr, wc, fr, fq); S.done(cur); }
        if (!has_next) break;
#pragma unroll
        for (int a = 0; a < 2; ++a)
#pragma unroll
            for (int b = 0; b < 2; ++b)
#pragma unroll
                for (int m = 0; m < 4; ++m)
#pragma unroll
                    for (int n = 0; n < 2; ++n) acc[a][b][m][n] = (f32x4){0.f, 0.f, 0.f, 0.f};
        cur = nxt; cA = nA; cB = nB; ++ui;
        if constexpr (ALIGN_EPI) { if (wr == 1) PG8_BAR; }
    }
    PG8_WAIT_V(0);
    if constexpr (!ALIGN_EPI) { if (wr == 0) PG8_BAR; }
    PG8_BAR;
    if constexpr (Epi::AFTER_DRAIN) { E.fused(acc, cur, wr, wc, fr, fq, lds, wid, lane); S.done(cur); }
#undef PG8_SA
#undef PG8_SB
#undef PG8_STAGE
#undef PG8_LDA
#undef PG8_LDB
#undef PG8_MMA
#undef PG8_WAIT_V
#undef PG8_WAIT_L
#undef PG8_BAR
#undef PG8_SCHED
}
}
namespace att {
constexpr int A_K = 0, A_V = 16384, A_WSF = 32768, A_KM = A_WSF + 2048, A_STG = A_KM + 8192;
constexpr int STG_STRIDE = 68, STG_WAVE_BYTES = 32 * STG_STRIDE * 4, A_END = A_STG + NWAVES * STG_WAVE_BYTES;
__device__ __forceinline__ int crow(int r, int hi) { return (r & 3) + 8 * (r >> 2) + 4 * hi; }
__device__ __forceinline__ void dma16(const void* g, LAS unsigned char* l) { __builtin_amdgcn_global_load_lds((const unsigned*)g, (LAS unsigned*)l, 16, 0, 0); }
typedef float f32x2_t __attribute__((ext_vector_type(2))); typedef __bf16 bf16x2_t __attribute__((ext_vector_type(2)));
__device__ __forceinline__ unsigned cvtpk(float lo, float hi) { f32x2_t v = {lo, hi}; bf16x2_t b = __builtin_convertvector(v, bf16x2_t); return __builtin_bit_cast(unsigned, b); }
typedef short v4i16_t __attribute__((ext_vector_type(4)));
__device__ __forceinline__ s16x4_t vtr(LAS const unsigned char* p) { return __builtin_bit_cast(s16x4_t, __builtin_amdgcn_ds_read_tr16_b64_v4i16((LAS v4i16_t*)p)); }
#define LDSW() asm volatile("s_waitcnt lgkmcnt(0)" ::: "memory")

template <int MODE>
__device__ __forceinline__ void attn_unit(int b, int h, int qb, const bf16_t* __restrict__ proj, bf16_t* __restrict__ Obuf, const float* __restrict__ kmean,
                                          float lam, float lam_init, const float* __restrict__ subg, const float* sinkp, LAS unsigned char* lds) {
    constexpr int NMAP = (MODE == 0) ? 2 : 1;
    int tid_ = threadIdx.x; asm volatile("" : "+v"(tid_));
    const int tid = tid_, lane = tid & 63, r32 = lane & 31, hi = lane >> 5;
    const int wid = __builtin_amdgcn_readfirstlane(tid >> 6);
    const int q0 = qb * 256;
    int qcol, kcol, vcol, ocol; float slope;
    if (MODE == 0) { qcol = OFF_QA + h * 64; kcol = OFF_KA + h * 64; vcol = OFF_VA + h * 64; ocol = h * 64; slope = alibi_slope(6 + h); }
    else if (MODE == 1) { qcol = OFF_QB + h * 64; kcol = OFF_KB + h * 64; vcol = OFF_VB + h * 64; ocol = 256 + h * 64; slope = alibi_slope(10 + h); }
    else { qcol = OFF_QC + h * 64; kcol = OFF_KC + (h / 3) * 64; vcol = OFF_VC + (h / 3) * 64; ocol = 640 + h * 64; slope = alibi_slope(h); }
    const float slope2 = slope * LOG2E;
    const float cscale = (MODE == 0 ? 0.17677669529663687f : 0.125f) * LOG2E;
    const bf16_t* base = proj + (size_t)b * SEQ * INW;
    const int t_hi = 4 * qb + 4, t_lo = (MODE == 2) ? (qb > 0 ? 4 * qb - 2 : 0) : 0;
    const bf16_t* ksrc = base + kcol + (size_t)lane * INW + wid * 8;
    const bf16_t* vsrc = base + vcol + (size_t)(16 * (wid & 3) + (lane >> 2)) * INW + (wid >> 2) * 32 + (lane & 3) * 8;
#define DMA_TILE(t, bufi) do { dma16(ksrc + (size_t)(t) * 64 * INW, lds + A_K + (bufi) * 8192 + wid * 1024); dma16(vsrc + (size_t)(t) * 64 * INW, lds + A_V + (bufi) * 8192 + wid * 1024); } while (0)
    DMA_TILE(t_lo, 0);
    const bf16_t* Qw = base + (size_t)(q0 + wid * 32 + r32) * INW + qcol;
    bf16x8_t qr[4];
#pragma unroll
    for (int d0 = 0; d0 < 4; ++d0) qr[d0] = *(const bf16x8_t*)(Qw + d0 * 16 + hi * 8);
    const int qrel = wid * 32 + r32;
    const LAS unsigned char* qlds = lds + A_STG + wid * STG_WAVE_BYTES + lane * 16;
    if (MODE == 0) {
#pragma unroll
        for (int d0 = 0; d0 < 4; ++d0) *(LAS bf16x8_t*)(lds + A_STG + wid * STG_WAVE_BYTES + lane * 16 + d0 * 1024) = qr[d0];
    }
    unsigned rowmask = 0u;
    if (MODE == 1) {
        LAS float* km = (LAS float*)(lds + A_KM);
        const float* kmg = kmean + (size_t)((b * 6 + h) * 32) * 64;
        for (int i = tid; i < 2048; i += NTHREADS) km[i] = kmg[i] * (1.0f / 256.0f);
        __syncthreads();
        if (qb > 0) {
            float qf[32];
#pragma unroll
            for (int d0 = 0; d0 < 4; ++d0)
#pragma unroll
                for (int j = 0; j < 8; ++j) qf[d0 * 8 + j] = __builtin_bit_cast(float, ((unsigned)(unsigned short)qr[d0][j]) << 16);
            float v0 = -INFINITY, v1 = -INFINITY, v2 = -INFINITY; int i0 = 0, i1 = 0, i2 = 0;
            for (int n = 0; n < qb; ++n) {
                const LAS float* kp = km + n * 64 + 8 * hi;
                float part = 0.f;
#pragma unroll
                for (int d0 = 0; d0 < 4; ++d0) {
                    const f32x4_t a = *(const LAS f32x4_t*)(kp + d0 * 16), c = *(const LAS f32x4_t*)(kp + d0 * 16 + 4);
                    part += qf[d0 * 8 + 0] * a[0]; part += qf[d0 * 8 + 1] * a[1]; part += qf[d0 * 8 + 2] * a[2]; part += qf[d0 * 8 + 3] * a[3];
                    part += qf[d0 * 8 + 4] * c[0]; part += qf[d0 * 8 + 5] * c[1]; part += qf[d0 * 8 + 6] * c[2]; part += qf[d0 * 8 + 7] * c[3];
                }
                const float tot = part + swap32_partner(part, hi);
                if (tot > v0) { v2 = v1; i2 = i1; v1 = v0; i1 = i0; v0 = tot; i0 = n; }
                else if (tot > v1) { v2 = v1; i2 = i1; v1 = tot; i1 = n; }
                else if (tot > v2) { v2 = tot; i2 = n; }
            }
            if (v0 > -INFINITY) rowmask |= 1u << i0;
            if (v1 > -INFINITY) rowmask |= 1u << i1;
            if (v2 > -INFINITY) rowmask |= 1u << i2;
        }
    }
    float m_[NMAP], l_[NMAP]; f32x16_t o[NMAP][2];
#pragma unroll
    for (int mi = 0; mi < NMAP; ++mi) { m_[mi] = -INFINITY; l_[mi] = 0.f;
#pragma unroll
        for (int d0 = 0; d0 < 2; ++d0)
#pragma unroll
            for (int r = 0; r < 16; ++r) o[mi][d0][r] = 0.f; }
    LAS float* wsf = (LAS float*)(lds + A_WSF) + wid * 64;
    const int vlane = ((lane >> 4) & 1) * 32 + (lane & 3) * 8 + (4 * hi + ((lane & 15) >> 2)) * 64;

    for (int t = t_lo; t < t_hi; ++t) {
        const int bufi = (t - t_lo) & 1;
        asm volatile("s_waitcnt vmcnt(0)" ::: "memory");
        __syncthreads();
        if (t + 1 < t_hi) DMA_TILE(t + 1, bufi ^ 1);
        const int krel0 = 64 * t - q0;
        bool need = krel0 <= wid * 32 + 31;
        if (MODE == 2) need = need && (krel0 + 63 >= wid * 32 - 127);
        const bool past = (MODE == 1) && ((t >> 2) < qb);
        if (past) need = __any((int)((rowmask >> (t >> 2)) & 1u)) != 0;
        if (!need) continue;
        const bool diag = krel0 + 63 > wid * 32;
        const int kb = krel0 + 4 * hi;
        const LAS unsigned char* Ks = lds + A_K + bufi * 8192 + hi * 1024 + r32 * 16;
        const LAS unsigned char* Vs = lds + A_V + bufi * 8192 + vlane;
#pragma unroll
        for (int mi = 0; mi < NMAP; ++mi) {
            f32x16_t p0, p1;
#pragma unroll
            for (int r = 0; r < 16; ++r) { p0[r] = 0.f; p1[r] = 0.f; }
            constexpr int ND0 = (MODE == 0) ? 2 : 4;
#pragma unroll
            for (int dd = 0; dd < ND0; ++dd) {
                const int d0 = (MODE == 0) ? (2 * mi + dd) : dd;
                const bf16x8_t b0 = *(const LAS bf16x8_t*)(Ks + d0 * 2048);
                const bf16x8_t b1 = *(const LAS bf16x8_t*)(Ks + d0 * 2048 + 512);
                const bf16x8_t qa = (MODE == 0) ? *(const LAS bf16x8_t*)(qlds + d0 * 1024) : qr[d0];
                p0 = __builtin_amdgcn_mfma_f32_32x32x16_bf16(b0, qa, p0, 0, 0, 0);
                p1 = __builtin_amdgcn_mfma_f32_32x32x16_bf16(b1, qa, p1, 0, 0, 0);
            }
            float sl2 = slope2; asm volatile("" : "+v"(sl2));
            const float tb = sl2 * (float)kb;
#pragma unroll
            for (int r = 0; r < 16; ++r) { const int kk = (r & 3) + 8 * (r >> 2); const float bias = tb + sl2 * (float)kk;
                p0[r] = p0[r] * cscale + bias; p1[r] = p1[r] * cscale + (bias + sl2 * 32.0f); }
            if (diag) {
#pragma unroll
                for (int r = 0; r < 16; ++r) { const int kk = kb + (r & 3) + 8 * (r >> 2); if (kk > qrel) p0[r] = -INFINITY; if (kk + 32 > qrel) p1[r] = -INFINITY; }
            }
            if (MODE == 2) {
#pragma unroll
                for (int r = 0; r < 16; ++r) { const int kk = kb + (r & 3) + 8 * (r >> 2); if (qrel - kk >= 128) p0[r] = -INFINITY; if (qrel - (kk + 32) >= 128) p1[r] = -INFINITY; }
            }
            if (past) { if (!((rowmask >> (t >> 2)) & 1u)) {
#pragma unroll
                for (int r = 0; r < 16; ++r) { p0[r] = -INFINITY; p1[r] = -INFINITY; } } }
            float mx = fmaxf(p0[0], p1[0]);
#pragma unroll
            for (int r = 1; r < 16; ++r) mx = fmaxf(mx, fmaxf(p0[r], p1[r]));
            mx = fmaxf(mx, __shfl_xor(mx, 32));
            const float mnew = fmaxf(m_[mi], mx), msafe = (mnew == -INFINITY) ? 0.f : mnew;
            const float f = __builtin_amdgcn_exp2f(m_[mi] - msafe);
            float ps = 0.f;
#pragma unroll
            for (int r = 0; r < 16; ++r) { p0[r] = __builtin_amdgcn_exp2f(p0[r] - msafe); p1[r] = __builtin_amdgcn_exp2f(p1[r] - msafe); ps += p0[r] + p1[r]; }
            l_[mi] = l_[mi] * f + ps; m_[mi] = mnew;
            if (__any(f != 1.0f)) {
                if (hi == 0) wsf[mi * 32 + r32] = f;
                LDSW();
#pragma unroll
                for (int r = 0; r < 16; ++r) { const float fr_ = wsf[mi * 32 + crow(r, hi)]; o[mi][0][r] *= fr_; o[mi][1][r] *= fr_; }
            }
            u32x4_t pw[4];
#pragma unroll
            for (int j = 0; j < 4; ++j) { pw[0][j] = cvtpk(p0[2 * j], p0[2 * j + 1]); pw[1][j] = cvtpk(p0[8 + 2 * j], p0[8 + 2 * j + 1]);
                                          pw[2][j] = cvtpk(p1[2 * j], p1[2 * j + 1]); pw[3][j] = cvtpk(p1[8 + 2 * j], p1[8 + 2 * j + 1]); }
#pragma unroll
            for (int d0 = 0; d0 < 2; ++d0) {
                if (d0) __builtin_amdgcn_sched_barrier(0);
#pragma unroll
                for (int ks = 0; ks < 4; ++ks) {
                    const s16x4_t lo = vtr(Vs + d0 * 4096 + ks * 1024), hh = vtr(Vs + d0 * 4096 + ks * 1024 + 512);
                    const bf16x8_t vf = {lo[0], lo[1], lo[2], lo[3], hh[0], hh[1], hh[2], hh[3]};
                    o[mi][d0] = __builtin_amdgcn_mfma_f32_32x32x16_bf16(__builtin_bit_cast(bf16x8_t, pw[ks]), vf, o[mi][d0], 0, 0, 0);
                }
            }
            if (NMAP > 1) __builtin_amdgcn_sched_barrier(0);
        }
    }
#undef DMA_TILE
    float rl[NMAP][16];
#pragma unroll
    for (int mi = 0; mi < NMAP; ++mi) {
        float lt = l_[mi];
        lt += __shfl_xor(lt, 32);
        if (MODE == 2) lt += __builtin_amdgcn_exp2f(sinkp[0] * LOG2E + slope2 * (float)qrel - m_[mi]);
        if (hi == 0) wsf[mi * 32 + r32] = 1.0f / lt;
    }
    LDSW();
#pragma unroll
    for (int mi = 0; mi < NMAP; ++mi)
#pragma unroll
        for (int r = 0; r < 16; ++r) rl[mi][r] = wsf[mi * 32 + crow(r, hi)];
    LAS float* stg = (LAS float*)(lds + A_STG + wid * STG_WAVE_BYTES);
#pragma unroll
    for (int d0 = 0; d0 < 2; ++d0)
#pragma unroll
        for (int r = 0; r < 16; ++r) {
            float v = o[0][d0][r] * rl[0][r];
            if (MODE == 0) v -= lam * (o[NMAP - 1][d0][r] * rl[NMAP - 1][r]);
            stg[crow(r, hi) * STG_STRIDE + d0 * 32 + r32] = v;
        }
    LDSW();
    {
        const int row = lane >> 1, half = lane & 1;
        float v[32];
#pragma unroll
        for (int i = 0; i < 8; ++i) { const f32x4_t x = *(const LAS f32x4_t*)(stg + row * STG_STRIDE + half * 32 + i * 4); v[4 * i] = x[0]; v[4 * i + 1] = x[1]; v[4 * i + 2] = x[2]; v[4 * i + 3] = x[3]; }
        if (MODE == 0) {
            float ss = 0.f;
#pragma unroll
            for (int i = 0; i < 32; ++i) ss += v[i] * v[i];
            ss += __shfl_xor(ss, 1);
            const float rs = (1.0f / sqrtf(ss * (1.0f / 64.0f) + EPS)) * (1.0f - lam_init);
#pragma unroll
            for (int i = 0; i < 32; ++i) v[i] = v[i] * rs * subg[half * 32 + i];
        }
        bf16_t* op = Obuf + (size_t)(b * SEQ + q0 + wid * 32 + row) * DM + ocol + half * 32;
#pragma unroll
        for (int i = 0; i < 4; ++i) { u32x4_t w; w.x = cvtpk(v[8 * i], v[8 * i + 1]); w.y = cvtpk(v[8 * i + 2], v[8 * i + 3]); w.z = cvtpk(v[8 * i + 4], v[8 * i + 5]); w.w = cvtpk(v[8 * i + 6], v[8 * i + 7]);
            *(u32x4_t*)(op + 8 * i) = w; }
    }
    __syncthreads();
}
#undef LDSW
}

namespace peer {
constexpr int K_BYTES = 2 * 32768;
__device__ __forceinline__ int crow(int r, int hi) { return (r & 3) + 8 * (r >> 2) + 4 * hi; }

template <int N>
__device__ __forceinline__ void top16_pair(float (&s)[N], float (&out)[16], bool pair) {
#pragma unroll
    for (int it = 0; it < 16; ++it) {
        float mx = s[0];
#pragma unroll
        for (int i = 1; i < N; ++i) mx = fmaxf(mx, s[i]);
        if (pair) mx = fmaxf(mx, __shfl_xor(mx, 32));
        out[it] = mx;
#pragma unroll
        for (int i = 0; i < N; ++i) s[i] = (s[i] == mx) ? -INFINITY : s[i];
    }
}
__device__ __forceinline__ float pack_idx(float v, unsigned idx, unsigned mask) { return __builtin_bit_cast(float, (__builtin_bit_cast(unsigned, v) & ~mask) | idx); }
__device__ __forceinline__ unsigned byte16(unsigned t0, unsigned t1, unsigned t2, unsigned t3, unsigned i) {
    const unsigned s = i & 7u, a = __builtin_amdgcn_perm(t1, t0, s), b = __builtin_amdgcn_perm(t3, t2, s);
    return ((i & 8u) ? b : a) & 0xffu;
}

__device__ __forceinline__ void pk_unit(int tile, int h, const bf16_t* __restrict__ Q, const bf16_t* __restrict__ keysb, int* __restrict__ Eid, float* __restrict__ Gw, LAS unsigned char* lds) {
    int tid_ = threadIdx.x; asm volatile("" : "+v"(tid_));
    const int tid = tid_, lane = tid & 63, r32 = lane & 31, hi = lane >> 5;
    const int wid = __builtin_amdgcn_readfirstlane(tid >> 6);
    __syncthreads();
    {
        const bf16_t* kg = keysb + (size_t)h * 2 * 128 * 128;
        for (int i = tid; i < 2 * 128 * 16; i += NTHREADS) {
            const int n = i & 127, c = (i >> 7) & 15, p = i >> 11;
            const u32x4_t v = *(const u32x4_t*)(kg + ((size_t)(p * 128 + n)) * 128 + c * 8);
            *(LAS u32x4_t*)(lds + p * 32768 + c * 2048 + n * 16) = v;
        }
    }
    __syncthreads();
    const int tok = tile * 256 + wid * 32 + r32;
    float sv[2][16];
#pragma unroll
    for (int p = 0; p < 2; ++p) {
        const bf16_t* qp = Q + (size_t)tok * PQW + h * 256 + p * 128 + hi * 8;
        bf16x8_t qf[8];
#pragma unroll
        for (int ks = 0; ks < 8; ++ks) qf[ks] = *(const bf16x8_t*)(qp + ks * 16);
        float s[64];
#pragma unroll
        for (int blk = 0; blk < 4; ++blk) {
            f32x16_t acc;
#pragma unroll
            for (int r = 0; r < 16; ++r) acc[r] = 0.f;
#pragma unroll
            for (int ks = 0; ks < 8; ++ks) {
                const bf16x8_t kf = *(const LAS bf16x8_t*)(lds + p * 32768 + (2 * ks + hi) * 2048 + (blk * 32 + r32) * 16);
                acc = __builtin_amdgcn_mfma_f32_32x32x16_bf16(kf, qf[ks], acc, 0, 0, 0);
            }
#pragma unroll
            for (int r = 0; r < 16; ++r) s[blk * 16 + r] = pack_idx(acc[r], (unsigned)(blk * 32 + (r & 3) + 8 * (r >> 2) + 4 * hi), 127u);
        }
        top16_pair<64>(s, sv[p], true);
    }
    float cand[50];
    {
        int c = 0;
#pragma unroll
        for (int i = 0; i < 16; ++i)
#pragma unroll
            for (int j = 0; j < 16; ++j)
                if ((i + 1) * (j + 1) <= 16) { cand[c] = pack_idx(sv[0][i] + sv[1][j], (unsigned)(i * 16 + j), 255u); ++c; }
    }
    float top[16];
    top16_pair<50>(cand, top, false);
    unsigned t1[4], t2[4];
#pragma unroll
    for (int j = 0; j < 4; ++j) { t1[j] = 0u; t2[j] = 0u;
#pragma unroll
        for (int k = 0; k < 4; ++k) { t1[j] |= (__builtin_bit_cast(unsigned, sv[0][4 * j + k]) & 127u) << (8 * k); t2[j] |= (__builtin_bit_cast(unsigned, sv[1][4 * j + k]) & 127u) << (8 * k); } }
    float g[16]; int e[16]; float gs = 0.f;
#pragma unroll
    for (int k = 0; k < 16; ++k) {
        const unsigned code = __builtin_bit_cast(unsigned, top[k]) & 255u;
        e[k] = (int)(byte16(t1[0], t1[1], t1[2], t1[3], code >> 4) * 128u + byte16(t2[0], t2[1], t2[2], t2[3], code & 15u));
        g[k] = __expf(top[k] - top[0]); gs += g[k];
    }
    const float gi = 1.0f / gs;
    if (hi == 0) {
        int* ep = Eid + ((size_t)tok * PHEADS + h) * 16; float* gp = Gw + ((size_t)tok * PHEADS + h) * 16;
#pragma unroll
        for (int k = 0; k < 16; k += 4) {
            *(int4*)(ep + k) = make_int4(e[k], e[k + 1], e[k + 2], e[k + 3]);
            *(float4*)(gp + k) = make_float4(g[k] * gi, g[k + 1] * gi, g[k + 2] * gi, g[k + 3] * gi);
        }
    }
}

__device__ __forceinline__ float reduce16(float (&a)[16], int lane) {
    float b8[8];
    { const bool up = lane & 1;
#pragma unroll
      for (int i = 0; i < 8; ++i) { const float keep = up ? a[8 + i] : a[i], give = up ? a[i] : a[8 + i]; b8[i] = keep + __shfl_xor(give, 1); } }
    float b4[4];
    { const bool up = lane & 2;
#pragma unroll
      for (int i = 0; i < 4; ++i) { const float keep = up ? b8[4 + i] : b8[i], give = up ? b8[i] : b8[4 + i]; b4[i] = keep + __shfl_xor(give, 2); } }
    float b2[2];
    { const bool up = lane & 4;
#pragma unroll
      for (int i = 0; i < 2; ++i) { const float keep = up ? b4[2 + i] : b4[i], give = up ? b4[i] : b4[2 + i]; b2[i] = keep + __shfl_xor(give, 4); } }
    float b1;
    { const bool up = lane & 8; const float keep = up ? b2[1] : b2[0], give = up ? b2[0] : b2[1]; b1 = keep + __shfl_xor(give, 8); }
    b1 += __shfl_xor(b1, 16); b1 += __shfl_xor(b1, 32);
    return b1;
}
__device__ __forceinline__ int red16_index(int lane) { return 8 * (lane & 1) + 4 * ((lane >> 1) & 1) + 2 * ((lane >> 2) & 1) + ((lane >> 3) & 1); }

typedef float f32x2_t __attribute__((ext_vector_type(2)));
__device__ __forceinline__ void pg_token(int tok, const float* xres, float* xdst, const LAS float* tab2  , const float* __restrict__ g2  , int gstride,
                                         const int* __restrict__ Eid, const float* __restrict__ Gw, const unsigned char* __restrict__ U8, const unsigned char* __restrict__ V8,
                                         const float* __restrict__ Us, const float* __restrict__ Vs,
                                         bool last, const LAS float* tabn  , const float* __restrict__ final_g, bf16_t* __restrict__ Hn, float* __restrict__ outp, int lane) {
    const int b = tok >> 13;
    float x[16];
    const float* xp = xres + (size_t)tok * DM + 16 * lane;
    float* xw = xdst + (size_t)tok * DM + 16 * lane;
#pragma unroll
    for (int q = 0; q < 4; ++q) { const f32x4_t a = *(const f32x4_t*)(xp + 4 * q); x[4 * q] = a[0]; x[4 * q + 1] = a[1]; x[4 * q + 2] = a[2]; x[4 * q + 3] = a[3]; }
    float ss = 0.f;
#pragma unroll
    for (int i = 0; i < 16; ++i) ss += x[i] * x[i];
    const float rstd = 1.0f / sqrtf(wave_sum(ss) * (1.0f / DM) + EPS);
    float hh[16];
#pragma unroll
    for (int q = 0; q < 4; ++q) { const f32x4_t g = *(const LAS f32x4_t*)(tab2 + (b * 2 + 0) * 1024 + 16 * lane + 4 * q), s = *(const LAS f32x4_t*)(tab2 + (b * 2 + 1) * 1024 + 16 * lane + 4 * q);
#pragma unroll
        for (int i = 0; i < 4; ++i) hh[4 * q + i] = x[4 * q + i] * rstd * g[i] + s[i]; }
    float out[16];
#pragma unroll
    for (int i = 0; i < 16; ++i) out[i] = 0.f;
    const int ridx = red16_index(lane);
    for (int hd = 0; hd < PHEADS; ++hd) {
        const size_t eb = ((size_t)tok * PHEADS + hd) * 16;
        const int ev = Eid[eb + (lane & 15)];
        const int er = Eid[eb + ridx];
        const float gv = Gw[eb + ridx];
        const float su = Us[er], sv = Vs[er];
        float a[16];
        {
            u32x4_t w[16];
#pragma unroll
            for (int k = 0; k < 16; ++k) { const int e = __builtin_amdgcn_readlane(ev, k); w[k] = *(const u32x4_t*)(U8 + (size_t)e * DM + 16 * lane); }
#pragma unroll
            for (int k = 0; k < 16; ++k) { float acc = 0.f;
#pragma unroll
                for (int q = 0; q < 4; ++q) { const f32x2_t lo = __builtin_amdgcn_cvt_pk_f32_fp8((int)w[k][q], false), hi2 = __builtin_amdgcn_cvt_pk_f32_fp8((int)w[k][q], true);
                    acc += hh[4 * q] * lo[0]; acc += hh[4 * q + 1] * lo[1]; acc += hh[4 * q + 2] * hi2[0]; acc += hh[4 * q + 3] * hi2[1]; }
                a[k] = acc; }
        }
        __builtin_amdgcn_sched_barrier(0);
        const float dot = reduce16(a, lane) * su;
        const float wgt = gv * sv * 0.5f * dot * (1.0f + erff(dot * 0.70710678118654752f));
        {
            u32x4_t w[16];
#pragma unroll
            for (int k = 0; k < 16; ++k) { const int e = __builtin_amdgcn_readlane(ev, k); w[k] = *(const u32x4_t*)(V8 + (size_t)e * DM + 16 * lane); }
#pragma unroll
            for (int k = 0; k < 16; ++k) {
                const int src = ((k >> 3) & 1) | (((k >> 2) & 1) << 1) | (((k >> 1) & 1) << 2) | ((k & 1) << 3);
                const float wk = __builtin_bit_cast(float, __builtin_amdgcn_readlane(__builtin_bit_cast(int, wgt), src));
#pragma unroll
                for (int q = 0; q < 4; ++q) { const f32x2_t lo = __builtin_amdgcn_cvt_pk_f32_fp8((int)w[k][q], false), hi2 = __builtin_amdgcn_cvt_pk_f32_fp8((int)w[k][q], true);
                    out[4 * q] += wk * lo[0]; out[4 * q + 1] += wk * lo[1]; out[4 * q + 2] += wk * hi2[0]; out[4 * q + 3] += wk * hi2[1]; }
            }
        }
    }
    float y[16]; float s2 = 0.f;
#pragma unroll
    for (int q = 0; q < 4; ++q) { const f32x4_t gg = *(const f32x4_t*)(g2 + (size_t)b * gstride + 16 * lane + 4 * q);
#pragma unroll
        for (int i = 0; i < 4; ++i) { y[4 * q + i] = x[4 * q + i] + gg[i] * out[4 * q + i]; s2 += y[4 * q + i] * y[4 * q + i]; } }
    const float rn = 1.0f / sqrtf(wave_sum(s2) * (1.0f / DM) + EPS);
    if (!last) {
#pragma unroll
        for (int q = 0; q < 4; ++q) *(f32x4_t*)(xw + 4 * q) = (f32x4_t){y[4 * q], y[4 * q + 1], y[4 * q + 2], y[4 * q + 3]};
        float z[16];
#pragma unroll
        for (int q = 0; q < 4; ++q) { const f32x4_t g = *(const LAS f32x4_t*)(tabn + (b * 2 + 0) * 1024 + 16 * lane + 4 * q), s = *(const LAS f32x4_t*)(tabn + (b * 2 + 1) * 1024 + 16 * lane + 4 * q);
#pragma unroll
            for (int i = 0; i < 4; ++i) z[4 * q + i] = y[4 * q + i] * rn * g[i] + s[i]; }
        bf16_t* hp = Hn + (size_t)tok * DM + 16 * lane;
#pragma unroll
        for (int j = 0; j < 2; ++j) { u32x4_t wv; wv.x = pk2(z[8 * j], z[8 * j + 1]); wv.y = pk2(z[8 * j + 2], z[8 * j + 3]); wv.z = pk2(z[8 * j + 4], z[8 * j + 5]); wv.w = pk2(z[8 * j + 6], z[8 * j + 7]); *(u32x4_t*)(hp + 8 * j) = wv; }
    } else {
        float* op = outp + (size_t)tok * DM + 16 * lane;
#pragma unroll
        for (int q = 0; q < 4; ++q) { const f32x4_t fg = *(const f32x4_t*)(final_g + 16 * lane + 4 * q);
            *(f32x4_t*)(op + 4 * q) = (f32x4_t){y[4 * q] * rn * fg[0], y[4 * q + 1] * rn * fg[1], y[4 * q + 2] * rn * fg[2], y[4 * q + 3] * rn * fg[3]}; }
    }
}
__device__ __forceinline__ void row_to_fp8(const float* src, unsigned char* dst, float* scale_out, int lane) {
    float v[16]; float mx = 0.f;
#pragma unroll
    for (int q = 0; q < 4; ++q) { const f32x4_t a = *(const f32x4_t*)(src + 16 * lane + 4 * q); v[4 * q] = a[0]; v[4 * q + 1] = a[1]; v[4 * q + 2] = a[2]; v[4 * q + 3] = a[3]; }
#pragma unroll
    for (int i = 0; i < 16; ++i) mx = fmaxf(mx, fabsf(v[i]));
#pragma unroll
    for (int o = 1; o < 64; o <<= 1) mx = fmaxf(mx, __shfl_xor(mx, o));
    const float sc = mx > 0.f ? 384.0f / mx : 1.0f;
    u32x4_t w;
#pragma unroll
    for (int q = 0; q < 4; ++q) { int t = 0; t = __builtin_amdgcn_cvt_pk_fp8_f32(v[4 * q] * sc, v[4 * q + 1] * sc, t, false); t = __builtin_amdgcn_cvt_pk_fp8_f32(v[4 * q + 2] * sc, v[4 * q + 3] * sc, t, true); w[q] = (unsigned)t; }
    *(u32x4_t*)(dst + 16 * lane) = w;
    if (lane == 0) *scale_out = mx > 0.f ? mx / 384.0f : 1.0f;
}
}

constexpr int LDS_BYTES = 131072;
#ifndef REPMASK
#define REPMASK 0u
#endif
#define NREP(k) ((((REPMASK) >> (k)) & 1u) ? 2 : 1)
#define DBG_BASE 0
#ifndef ATM
#define ATM 7
#endif
#ifndef MK_N_LAUNCHES
#define MK_N_LAUNCHES 1
#endif
constexpr int N_PHASES = 2 + 7 * DEPTH;

struct Args { const float* in[19]; float* out; unsigned char* ws; int ph_lo, ph_hi; };
enum { I_X = 0, I_C, I_N1G, I_N2G, I_WADA, I_BADA, I_WIN, I_WOUT, I_LQ1, I_LK1, I_LQ2, I_LK2, I_SUBG, I_SINK, I_PWQ, I_PKEYS, I_PU, I_PV, I_FG };

__device__ __forceinline__ void p0_transpose_item(const float* W, int K, int N, bf16_t* WT, LAS float* scr, int item, int lane) {
    const int nblk = N / 32, kb = item / nblk, nb = item % nblk, k0 = 64 * kb, n0 = 32 * nb;
#pragma unroll 8
    for (int i = 0; i < 32; ++i) { const int kk = 2 * i + (lane >> 5); scr[kk * 33 + (lane & 31)] = W[(size_t)(k0 + kk) * N + n0 + (lane & 31)]; }
    asm volatile("s_waitcnt lgkmcnt(0)" ::: "memory");
    const int c = lane & 7;
#pragma unroll
    for (int j = 0; j < 4; ++j) { const int n = (lane >> 3) + 8 * j; const LAS float* s = scr + (8 * c) * 33 + n;
        u32x4_t o; o.x = pk2(s[0 * 33], s[1 * 33]); o.y = pk2(s[2 * 33], s[3 * 33]); o.z = pk2(s[4 * 33], s[5 * 33]); o.w = pk2(s[6 * 33], s[7 * 33]);
        *(u32x4_t*)(WT + (size_t)(n0 + n) * K + k0 + 8 * c) = o; }
    asm volatile("s_waitcnt lgkmcnt(0)" ::: "memory");
}
__device__ __forceinline__ void cvt_rows(const float* src, bf16_t* dst, size_t n, size_t gtid, size_t gthreads) {
    for (size_t i = gtid * 8; i < n; i += gthreads * 8) {
        const f32x4_t a = *(const f32x4_t*)(src + i), c = *(const f32x4_t*)(src + i + 4);
        u32x4_t o; o.x = pk2(a[0], a[1]); o.y = pk2(a[2], a[3]); o.z = pk2(c[0], c[1]); o.w = pk2(c[2], c[3]);
        *(u32x4_t*)(dst + i) = o;
    }
}
__device__ __forceinline__ void build_table(LAS float* tab, const float* gvec, const float* mod_l, int sh_idx, int sc_idx) {
    for (int i = threadIdx.x; i < 4096; i += NTHREADS) { const int b = i >> 10, k = i & 1023;
        tab[(b * 2 + 0) * 1024 + k] = gvec[k] * (1.0f + mod_l[b * 6144 + sc_idx * 1024 + k]);
        tab[(b * 2 + 1) * 1024 + k] = mod_l[b * 6144 + sh_idx * 1024 + k]; }
}
__device__ __forceinline__ void norm_row(const float* xrow, bf16_t* orow, const LAS float* tab, int b, int lane) {
    const f32x4_t* xr = (const f32x4_t*)xrow + lane;
    f32x4_t v[4]; float s = 0.f;
#pragma unroll
    for (int j = 0; j < 4; ++j) { v[j] = xr[64 * j]; s += (v[j][0] * v[j][0] + v[j][1] * v[j][1]) + (v[j][2] * v[j][2] + v[j][3] * v[j][3]); }
    const float rstd = 1.0f / sqrtf(wave_sum(s) * (1.0f / DM) + EPS);
    unsigned long long* o8 = (unsigned long long*)orow + lane;
#pragma unroll
    for (int j = 0; j < 4; ++j) { const int k = 4 * lane + 256 * j;
        const f32x4_t g = *(const LAS f32x4_t*)(tab + (b * 2 + 0) * 1024 + k), sh = *(const LAS f32x4_t*)(tab + (b * 2 + 1) * 1024 + k);
        const f32x4_t y = v[j] * rstd * g + sh;
        o8[64 * j] = (unsigned long long)pk2(y[0], y[1]) | ((unsigned long long)pk2(y[2], y[3]) << 32); }
}

__global__ void __launch_bounds__(NTHREADS, 2) hymba_fwd(Args args) {
    extern __shared__ __attribute__((aligned(16))) unsigned char lds_raw[];
    LAS unsigned char* lds = (LAS unsigned char*)lds_raw;
    cg::grid_group grid = cg::this_grid();
    const int tid = threadIdx.x;
    const int wave = __builtin_amdgcn_readfirstlane(tid >> 6);
    const int G = gridDim.x, bx = blockIdx.x;
    const int gw = bx * NWAVES + wave, NGW = G * NWAVES;
    const int lo = args.ph_lo, hi_ = args.ph_hi;
#ifndef PHMASK
#define PHMASK 0xffffu
#endif
#define IN(k) (((PHMASK >> ((k) < 2 ? (k) : 2 + ((k) - 2) % 7)) & 1u) && lo <= (k) && (k) < hi_)
#define SEAM(k) do { if (IN(k) && IN((k) + 1)) grid.sync(); } while (0)
#define PHASE_BEGIN() unsigned char* ws = args.ws; asm volatile("" : "+s"(ws)); int lane; { int t_ = threadIdx.x; asm volatile("" : "+v"(t_)); lane = t_ & 63; } (void)lane; \
    bf16_t* Wt_in = (bf16_t*)(ws + WS_WIN); bf16_t* Wt_out = (bf16_t*)(ws + WS_WOUT); bf16_t* Wt_q = (bf16_t*)(ws + WS_WQ); bf16_t* keysb = (bf16_t*)(ws + WS_KEYS); \
    float* modf = (float*)(ws + WS_MOD); float* kmean = (float*)(ws + WS_KMEAN); float* scal = (float*)(ws + WS_SCAL); \
    unsigned char* U8 = ws + WS_U; unsigned char* V8 = ws + WS_V; bf16_t* Hb = (bf16_t*)(ws + WS_H); \
    float* Us = (float*)(ws + WS_SCAL + 65536); float* Vs = (float*)(ws + WS_SCAL + 65536 + 262144); \
    bf16_t* Pj = (bf16_t*)(ws + WS_PROJ); bf16_t* Qp = (bf16_t*)(ws + WS_PROJ); bf16_t* Ob = (bf16_t*)(ws + WS_O); \
    int* Eid = (int*)(ws + WS_O); float* Gw = (float*)(ws + WS_O + 16 * MiB); unsigned* ctl = (unsigned*)(ws + WS_CTL); \
    (void)Wt_in; (void)Wt_out; (void)Wt_q; (void)keysb; (void)modf; (void)kmean; (void)scal; (void)U8; (void)V8; (void)Hb; (void)Us; (void)Vs; (void)Pj; (void)Qp; (void)Ob; (void)Eid; (void)Gw; (void)ctl

    if (IN(0)) for (int rep = 0; rep < NREP(0); ++rep) {
        PHASE_BEGIN();
        if (bx < 192) {
            LAS float* cs = (LAS float*)lds;
            LAS float* red = (LAS float*)(lds + 16384);
            for (int i = tid; i < 4096; i += NTHREADS) { const float cv = args.in[I_C][i]; cs[i] = cv / (1.0f + __expf(-cv)); }
            __syncthreads();
            for (int it = bx; it < 192; it += G) {
                const int l = it / 96, n = (it % 96) * 64 + lane;
                const float* wp = args.in[I_WADA] + (size_t)l * DM * 6144 + n;
                float a0 = 0.f, a1 = 0.f, a2 = 0.f, a3 = 0.f;
#pragma unroll 8
                for (int k = wave * 128; k < wave * 128 + 128; ++k) { const float wv = wp[(size_t)k * 6144]; a0 += cs[k] * wv; a1 += cs[1024 + k] * wv; a2 += cs[2048 + k] * wv; a3 += cs[3072 + k] * wv; }
                red[(wave * 4 + 0) * 64 + lane] = a0; red[(wave * 4 + 1) * 64 + lane] = a1; red[(wave * 4 + 2) * 64 + lane] = a2; red[(wave * 4 + 3) * 64 + lane] = a3;
                __syncthreads();
                if (wave < 4) { float s = args.in[I_BADA][l * 6144 + n];
#pragma unroll
                    for (int w = 0; w < 8; ++w) s += red[(w * 4 + wave) * 64 + lane];
                    modf[((size_t)l * 4 + wave) * 6144 + n] = s; }
                __syncthreads();
            }
        }
        __syncthreads();
        {
            LAS float* scr = (LAS float*)(lds + wave * 16384);
            constexpr int I_IN = 16 * (INW / 32), I_OUT = 16 * (DM / 32), I_Q = 16 * (PQW / 32), PER_L = I_IN + I_OUT + I_Q;
            for (int it = gw; it < DEPTH * PER_L; it += NGW) {
                const int l = it / PER_L; int r = it % PER_L;
                if (r < I_IN) { p0_transpose_item(args.in[I_WIN] + (size_t)l * DM * INW, DM, INW, Wt_in + (size_t)l * INW * DM, scr, r, lane); continue; } r -= I_IN;
                if (r < I_OUT) { p0_transpose_item(args.in[I_WOUT] + (size_t)l * DM * DM, DM, DM, Wt_out + (size_t)l * DM * DM, scr, r, lane); continue; } r -= I_OUT;
                p0_transpose_item(args.in[I_PWQ] + (size_t)l * DM * PQW, DM, PQW, Wt_q + (size_t)l * PQW * DM, scr, r, lane);
            }
        }
        {
            const size_t gtid = (size_t)bx * NTHREADS + tid, gth = (size_t)G * NTHREADS;
            cvt_rows(args.in[I_PKEYS], keysb, (size_t)DEPTH * PHEADS * 2 * 128 * 128, gtid, gth);
            for (int r = gw; r < 2 * DEPTH * PNEXP; r += NGW) { const int tb = r / (DEPTH * PNEXP), rr = r % (DEPTH * PNEXP);
                peer::row_to_fp8(args.in[tb ? I_PV : I_PU] + (size_t)rr * DM, (tb ? V8 : U8) + (size_t)rr * DM, (tb ? Vs : Us) + rr, lane); }
            for (size_t i = gtid; i < (size_t)DEPTH * 4 * 6 * 32 * 64; i += gth) kmean[i] = 0.f;
            if (gtid < DEPTH) { const int l = (int)gtid; float s1 = 0.f, s2 = 0.f;
                for (int i = 0; i < 32; ++i) { s1 += args.in[I_LQ1][l * 32 + i] * args.in[I_LK1][l * 32 + i]; s2 += args.in[I_LQ2][l * 32 + i] * args.in[I_LK2][l * 32 + i]; }
                const float lam_init = 0.8f - 0.6f * expf(-0.3f * (float)l);
                scal[l * 4 + 0] = expf(s1) - expf(s2) + lam_init; scal[l * 4 + 1] = lam_init; }
        }
    }
    SEAM(0);
    if (IN(1)) for (int rep = 0; rep < NREP(1); ++rep) {
        PHASE_BEGIN();
        LAS float* tab = (LAS float*)lds;
        build_table(tab, args.in[I_N1G], modf, 0, 1);
        __syncthreads();
        for (int m = gw; m < TOK; m += NGW) norm_row(args.in[I_X] + (size_t)m * DM, Hb + (size_t)m * DM, tab, m >> 13, lane);
        __syncthreads();
    }
    SEAM(1);

#pragma unroll 1
    for (int l = 0; l < DEPTH; ++l) {
        const int P = 2 + 7 * l;
        if (IN(P + 0)) for (int rep = 0; rep < NREP(2); ++rep) {
            PHASE_BEGIN();
            pg8::Gemm g{Hb, Wt_in + (size_t)l * INW * DM, TOK, INW, DM}; pg8::StaticOrder S; S.init(TOK, INW, G, bx);
            pg8::EpiProj E{Pj, INW, kmean + (size_t)l * 4 * 6 * 32 * 64, rep == 0 ? OFF_KB : (1 << 28)};
            pg8::gemm_phase<pg8::EpiProj, pg8::StaticOrder, true, true>(lds, g, S, E);
        }
        SEAM(P + 0);
        if (IN(P + 1)) for (int rep = 0; rep < NREP(3); ++rep) {
            volatile LAS int* qw = (volatile LAS int*)(lds + att::A_END);
#define NEXT_UNIT(mode) int idx; { PHASE_BEGIN(); if (tid == 0) qw[0] = (int)atomicAdd(ctl + 64 * ((rep * DEPTH + l) * 4 + (mode)), 1u); __syncthreads(); idx = qw[0]; }
            if (ATM & 1) for (;;) {
                NEXT_UNIT(0); if (idx >= 512) break;
                PHASE_BEGIN();
                const int qb = 31 - idx / 16, j = idx % 16;
                att::attn_unit<0>(j >> 2, j & 3, qb, Pj, Ob, nullptr, scal[l * 4 + 0], scal[l * 4 + 1], args.in[I_SUBG] + l * 64, nullptr, lds);
            }
            __syncthreads();
            if (ATM & 2) for (;;) {
                NEXT_UNIT(1); if (idx >= 768) break;
                PHASE_BEGIN();
                const int qb = 31 - idx / 24, jj = idx % 24;
                att::attn_unit<1>(jj / 6, jj % 6, qb, Pj, Ob, kmean + (size_t)l * 4 * 6 * 32 * 64, 0.f, 0.f, nullptr, nullptr, lds);
            }
            __syncthreads();
            if (ATM & 4) for (;;) {
                NEXT_UNIT(2); if (idx >= 768) break;
                PHASE_BEGIN();
                const int qb = idx / 24, jj = idx % 24;
                att::attn_unit<2>(jj / 6, jj % 6, qb, Pj, Ob, nullptr, 0.f, 0.f, nullptr, args.in[I_SINK] + l * 6 + jj % 6, lds);
            }
            __syncthreads();
#undef NEXT_UNIT
        }
        SEAM(P + 1);
        if (IN(P + 2)) for (int rep = 0; rep < NREP(4); ++rep) {
            PHASE_BEGIN();
            pg8::Gemm g{Ob, Wt_out + (size_t)l * DM * DM, TOK, DM, DM}; pg8::StaticOrder S; S.init(TOK, DM, G, bx);
            pg8::EpiRes E{(l == 0) ? args.in[I_X] : (const float*)args.out, (rep + 1 < NREP(4)) ? (float*)(ws + WS_PROJ) : args.out, DM, modf + (size_t)l * 4 * 6144 + 2 * 1024, 6144};
            pg8::gemm_phase<pg8::EpiRes, pg8::StaticOrder, true, true>(lds, g, S, E);
        }
        SEAM(P + 2);
        if (IN(P + 3)) for (int rep = 0; rep < NREP(5); ++rep) {
            PHASE_BEGIN();
            LAS float* tab = (LAS float*)lds;
            build_table(tab, args.in[I_N2G] + l * DM, modf + (size_t)l * 4 * 6144, 3, 4);
            __syncthreads();
            for (int m = gw; m < TOK; m += NGW) norm_row(args.out + (size_t)m * DM, Hb + (size_t)m * DM, tab, m >> 13, lane);
            __syncthreads();
        }
        SEAM(P + 3);
        if (IN(P + 4)) for (int rep = 0; rep < NREP(6); ++rep) {
            PHASE_BEGIN();
            pg8::Gemm g{Hb, Wt_q + (size_t)l * PQW * DM, TOK, PQW, DM}; pg8::StaticOrder S; S.init(TOK, PQW, G, bx);
            pg8::EpiBf16Plain E{Qp, PQW};
            pg8::gemm_phase<pg8::EpiBf16Plain, pg8::StaticOrder, true, true>(lds, g, S, E);
        }
        SEAM(P + 4);
        if (IN(P + 5)) for (int rep = 0; rep < NREP(7); ++rep) {
            PHASE_BEGIN();
            for (int u = bx; u < (TOK / 256) * PHEADS; u += G) peer::pk_unit(u >> 3, u & 7, Qp, keysb + (size_t)l * PHEADS * 2 * 128 * 128, Eid, Gw, lds);
            __syncthreads();
        }
        SEAM(P + 5);
        if (IN(P + 6)) for (int rep = 0; rep < NREP(8); ++rep) {
            PHASE_BEGIN();
            LAS float* tab2 = (LAS float*)lds; LAS float* tabn = (LAS float*)(lds + 32768);
            const bool last = (l == DEPTH - 1);
            const float* mod_l = modf + (size_t)l * 4 * 6144;
            build_table(tab2, args.in[I_N2G] + l * DM, mod_l, 3, 4);
            if (!last) build_table(tabn, args.in[I_N1G] + (l + 1) * DM, mod_l + 4 * 6144, 0, 1);
            __syncthreads();
            float* dry = (float*)(ws + WS_PROJ);
            for (int m = gw; m < TOK; m += NGW)
                peer::pg_token(m, args.out, (rep + 1 < NREP(8)) ? dry : args.out, tab2, mod_l + 5 * 1024, 6144, Eid, Gw, U8 + (size_t)l * PNEXP * DM, V8 + (size_t)l * PNEXP * DM, Us + l * PNEXP, Vs + l * PNEXP,
                                last, tabn, args.in[I_FG], Hb, (rep + 1 < NREP(8)) ? dry : args.out, lane);
            __syncthreads();
        }
        if (l + 1 < DEPTH) SEAM(P + 6);
    }
#undef IN
#undef SEAM
}

#ifdef DBG
__global__ void dbg_chk16(const bf16_t* p, size_t n, unsigned* flag, unsigned bit) {
    bool bad = false;
    for (size_t i = (size_t)blockIdx.x * blockDim.x + threadIdx.x; i < n; i += (size_t)gridDim.x * blockDim.x) bad |= ((p[i] & 0x7f80u) == 0x7f80u);
    if (bad) atomicOr(flag, bit);
}
__global__ void dbg_chk32(const float* p, size_t n, unsigned* flag, unsigned bit) {
    bool bad = false;
    for (size_t i = (size_t)blockIdx.x * blockDim.x + threadIdx.x; i < n; i += (size_t)gridDim.x * blockDim.x) bad |= ((__builtin_bit_cast(unsigned, p[i]) & 0x7f800000u) == 0x7f800000u);
    if (bad) atomicOr(flag, bit);
}
__global__ void dbg_chk_o(const bf16_t* p, unsigned* flag) {
    unsigned bad = 0;
    for (size_t i = (size_t)blockIdx.x * blockDim.x + threadIdx.x; i < (size_t)TOK * DM; i += (size_t)gridDim.x * blockDim.x) {
        if ((p[i] & 0x7f80u) == 0x7f80u) { const int c = (int)(i & 1023); const int r = (int)((i >> 10) & 8191); bad |= (c < 256) ? 1u : (c < 640 ? 2u : 4u); if (r < 256) bad |= 8u; if ((r & 255) < 32) bad |= 16u; if (p[i] & 0x7fu) bad |= 32u; }
    }
    if (bad) atomicOr(flag, bad);
}
__global__ void dbg_fill(float* out, size_t n, const unsigned* flag) {
    const unsigned f = *flag; if (f == 0u) return;
    const float c = sqrtf((float)f);
    for (size_t i = (size_t)blockIdx.x * blockDim.x + threadIdx.x; i < n; i += (size_t)gridDim.x * blockDim.x) out[i] = c;
}
#endif
extern "C" void kernel_launch(void* const* d_in, const int* in_sizes, int n_in, void* d_out, int out_size, void* d_ws, size_t ws_size, hipStream_t stream) {
    static int grid = 0;
    if (grid == 0) {
        if (n_in != 19 || out_size != TOK * DM || ws_size < WS_END) { fprintf(stderr, "kernel_launch: unexpected shapes (n_in %d out %d ws %zu)\n", n_in, out_size, ws_size); grid = -1; return; }
        int dev = 0, cus = 0, per_cu = 0;
        hipGetDevice(&dev); hipDeviceGetAttribute(&cus, hipDeviceAttributeMultiprocessorCount, dev);
        hipFuncSetAttribute((const void*)hymba_fwd, hipFuncAttributeMaxDynamicSharedMemorySize, LDS_BYTES);
        hipOccupancyMaxActiveBlocksPerMultiprocessor(&per_cu, (const void*)hymba_fwd, NTHREADS, LDS_BYTES);
        (void)hipGetLastError();
        if (per_cu < 1) per_cu = 1;
        if (per_cu > 1) per_cu = 1;
        grid = cus * per_cu;
        if (grid <= 0) grid = 256;
    }
    if (grid < 0) return;
    hipMemsetAsync((char*)d_ws + WS_CTL, 0, CTL_ZERO_BYTES, stream);
    Args a{};
    for (int i = 0; i < 19; ++i) a.in[i] = (const float*)d_in[i];
    a.out = (float*)d_out; a.ws = (unsigned char*)d_ws;
#if MK_N_LAUNCHES == 1
    a.ph_lo = 0; a.ph_hi = N_PHASES;
    void* kargs[] = {&a};
    hipError_t e = hipLaunchCooperativeKernel((const void*)hymba_fwd, dim3(grid), dim3(NTHREADS), kargs, LDS_BYTES, stream);
    if (e != hipSuccess) fprintf(stderr, "cooperative launch failed: %s (grid %d)\n", hipGetErrorString(e), grid);
#else
    for (int p = 0; p < N_PHASES; ++p) { a.ph_lo = p; a.ph_hi = p + 1; hipLaunchKernelGGL(hymba_fwd, dim3(grid), dim3(NTHREADS), LDS_BYTES, stream, a);
#ifdef DBG
        unsigned* flag = (unsigned*)((char*)d_ws + WS_CTL); unsigned char* w = (unsigned char*)d_ws;
        const int base = DBG_BASE;
        if (p == 3) dbg_chk_o<<<1024, 256, 0, stream>>>((const bf16_t*)(w + WS_O), flag);
#endif
    }
#ifdef DBG
    dbg_fill<<<1024, 256, 0, stream>>>((float*)d_out, (size_t)TOK * DM, (const unsigned*)((char*)d_ws + WS_CTL));
#endif
#endif
}
```

```cpp
#include <hip/hip_runtime.h>
#include <hip/hip_cooperative_groups.h>
#include <cstdio>
#include <cstdint>
#include <cmath>
namespace cg = cooperative_groups;

constexpr int DM = 1024, NBATCH = 4, SEQ = 8192, DEPTH = 2, TOK = NBATCH * SEQ;
constexpr int INW = 2560, NMOD = 6;
constexpr int OFF_QA = 0, OFF_KA = 256, OFF_VA = 512, OFF_QB = 768, OFF_KB = 1152, OFF_VB = 1536, OFF_QC = 1920, OFF_KC = 2304, OFF_VC = 2432;
constexpr int PHEADS = 8, PQW = 2048, PNK = 128, PNEXP = 16384, PTOPK = 16;
constexpr float EPS = 1e-6f;
constexpr float LOG2E = 1.4426950408889634f;
constexpr int NWAVES = 8, NTHREADS = 512;

constexpr size_t MiB = 1u << 20;
constexpr size_t WS_CTL = 0, CTL_ZERO_BYTES = 64 * 1024;
constexpr size_t WS_WIN = 1 * MiB;
constexpr size_t WS_WOUT = 11 * MiB;
constexpr size_t WS_WQ = 15 * MiB;
constexpr size_t WS_KEYS = 23 * MiB;
constexpr size_t WS_MOD = 24 * MiB;
constexpr size_t WS_KMEAN = 24 * MiB + 256 * 1024;
constexpr size_t WS_SCAL = 25 * MiB;
constexpr size_t WS_U = 26 * MiB;
constexpr size_t WS_V = 90 * MiB;
constexpr size_t WS_H = 154 * MiB;
constexpr size_t WS_PROJ = 218 * MiB;
constexpr size_t WS_O = 378 * MiB;
constexpr size_t WS_END = 442 * MiB;

#define GAS __attribute__((address_space(1)))
#define LAS __attribute__((address_space(3)))
typedef unsigned short bf16_t;
typedef short bf16x8_t __attribute__((ext_vector_type(8)));
typedef short s16x4_t __attribute__((ext_vector_type(4)));
typedef float f32x4_t __attribute__((ext_vector_type(4)));
typedef float f32x16_t __attribute__((ext_vector_type(16)));
typedef unsigned u32x4_t __attribute__((ext_vector_type(4)));
typedef unsigned u32x2_t __attribute__((ext_vector_type(2)));

__device__ __forceinline__ unsigned f2bf(float f) { unsigned u = __builtin_bit_cast(unsigned, f); return (u + 0x7fffu + ((u >> 16) & 1u)) >> 16; }
__device__ __forceinline__ unsigned pk2(float lo, float hi) { return f2bf(lo) | (f2bf(hi) << 16); }
__device__ __forceinline__ float bf_lo(unsigned w) { return __builtin_bit_cast(float, w << 16); }
__device__ __forceinline__ float bf_hi(unsigned w) { return __builtin_bit_cast(float, w & 0xffff0000u); }
__device__ __forceinline__ float wave_sum(float v) {
#pragma unroll
    for (int o = 1; o < 64; o <<= 1) v += __shfl_xor(v, o);
    return v;
}
__device__ __forceinline__ float swap32_partner(float v, int) { return __shfl_xor(v, 32); }
__device__ __forceinline__ float alibi_slope(int i) { return exp2f(-0.5f * (float)(i + 1)); }

typedef GAS unsigned gu32;
#define RLX_AGENT __ATOMIC_RELAXED, __HIP_MEMORY_SCOPE_AGENT
#define XB_TMO      128
#define XB_XCNT(j)  (256  + 64 * (j))
#define XB_XSUB(j)  (1280 + 64 * (j))
#define XB_XGEN(j)  (2304 + 64 * (j))
#define XB_TOP      3328
#define XB_TOPGEN   3392
#define XCD_BAR_WORDS 3456
#define XB_SPIN_CAP (1u << 18)

__device__ __forceinline__ unsigned xb_ld(unsigned* p)              { return __hip_atomic_load(p, __ATOMIC_RELAXED, __HIP_MEMORY_SCOPE_AGENT); }
__device__ __forceinline__ unsigned xb_add(unsigned* p, unsigned v) { return __hip_atomic_fetch_add(p, v, __ATOMIC_RELAXED, __HIP_MEMORY_SCOPE_AGENT); }
__device__ __forceinline__ unsigned xb_xcc_id() { return (unsigned)__builtin_amdgcn_s_getreg((3 << 11) | 20) & 0xFu; }
#define XB_SPIN(cond, bar) do { unsigned _sp = 0; while (cond) { __builtin_amdgcn_s_sleep(1); \
    if ((++_sp & 255u) == 0u) { if (xb_ld(&(bar)[XB_TMO])) break; if (_sp > XB_SPIN_CAP) { atomicAdd(&(bar)[XB_TMO], 1u); break; } } } } while (0)

struct XcdBarrier {
    unsigned* bar; unsigned x;
    volatile LAS unsigned* st;
};

__device__ __forceinline__ XcdBarrier xcd_barrier_post(unsigned* bar, volatile LAS unsigned* st) {
    XcdBarrier b; b.bar = bar; b.x = xb_xcc_id(); b.st = st;
    if (threadIdx.x == 0) (void)xb_add(&bar[XB_XCNT(b.x)], 1u);
    return b;
}
__device__ __forceinline__ void xcd_barrier_complete(unsigned* bar, unsigned x, unsigned& nloc, unsigned& nx) {
    const unsigned G = gridDim.x * gridDim.y * gridDim.z;
    unsigned sum, cnt, mine, sp = 0u;
    for (;;) {
        sum = 0u; cnt = 0u; mine = 0u;
#pragma unroll
        for (unsigned j = 0; j < 16; ++j) { const unsigned c = xb_ld(&bar[XB_XCNT(j)]); sum += c; cnt += (c > 0u) ? 1u : 0u; mine = (j == x) ? c : mine; }
        if (sum == G) break;
        __builtin_amdgcn_s_sleep(1);
        if ((++sp & 255u) == 0u) { if (xb_ld(&bar[XB_TMO])) break; if (sp > XB_SPIN_CAP) { atomicAdd(&bar[XB_TMO], 1u); break; } }
    }
    nloc = mine > 0u ? mine : 1u; nx = cnt > 0u ? cnt : 1u;
}

__device__ __forceinline__ void xcd_barrier(const XcdBarrier& b) {
    asm volatile("s_waitcnt vmcnt(0)" ::: "memory");
    __syncthreads();
    if (threadIdx.x == 0) {
        unsigned* bar = b.bar;
        __builtin_amdgcn_s_waitcnt(0);
        unsigned nloc = b.st[0], nx = b.st[1];
        if (nloc == 0u) { xcd_barrier_complete(bar, b.x, nloc, nx); b.st[0] = nloc; b.st[1] = nx; }
        const unsigned old = xb_add(&bar[XB_XSUB(b.x)], 1u);
        const unsigned gen = old / nloc;
        if (old + 1u == (gen + 1u) * nloc) {
            __builtin_amdgcn_fence(__ATOMIC_RELEASE, "agent");
            asm volatile("s_waitcnt vmcnt(0)" ::: "memory");
            const unsigned og = xb_add(&bar[XB_TOP], 1u);
            const unsigned tg = og / nx;
            if (og + 1u == (tg + 1u) * nx) xb_add(&bar[XB_TOPGEN], 1u);
            else XB_SPIN(xb_ld(&bar[XB_TOPGEN]) == tg, bar);
            __builtin_amdgcn_fence(__ATOMIC_ACQUIRE, "agent");
            xb_add(&bar[XB_XGEN(b.x)], 1u);
            asm volatile("s_waitcnt vmcnt(0)" ::: "memory");
        } else {
            XB_SPIN(xb_ld(&bar[XB_XGEN(b.x)]) == gen, bar);
            __builtin_amdgcn_fence(__ATOMIC_ACQUIRE, "agent");
            asm volatile("s_waitcnt vmcnt(0)" ::: "memory");
        }
    }
    __syncthreads();
}

namespace pg8 {
#define PG8_LAS __attribute__((address_space(3)))
typedef unsigned short bf16_t;
typedef short bf16x8 __attribute__((ext_vector_type(8)));
typedef float f32x4 __attribute__((ext_vector_type(4)));
typedef unsigned u32x4 __attribute__((ext_vector_type(4)));
constexpr int BM = 256, BK = 64, HALF = 128, HTB = HALF * BK * 2  , STAGE_BYTES = 8 * HTB, NXCD = 8, WGM = 8;

__host__ __device__ __forceinline__ int lds_byte(int r, int c) { const int st = (r >> 4) * 2 + (c >> 5), rr = r & 15, cc = c & 31, ob = rr * 64 + cc * 2; return st * 1024 + (ob ^ (((ob >> 9) & 1) << 5)); }
__host__ __device__ __forceinline__ void stage_rc(int b, int& R, int& C) { const int st = b / 1024, sb = b % 1024, swz = sb ^ (((sb >> 9) & 1) << 5); R = (st >> 1) * 16 + swz / 64; C = (st & 1) * 32 + (swz % 64) / 2; }
__host__ __device__ __forceinline__ int perm32(int rho) { const int n = rho >> 4, i = rho & 15; return 8 * (i >> 2) + 4 * n + (i & 3); }

struct Unit { int pm, pn; };
struct Gemm { const bf16_t* A; const bf16_t* Bt; int M, N, K; };

struct StaticOrder {
    int nM, nN, nwg, G, c;
    __host__ __device__ void init(int M, int N, int G_, int c_) { nM = M / BM; nN = N / BM; nwg = nM * nN; G = G_; c = c_; }
    __host__ __device__ bool next(int i, Unit& u) const {
        const long L = (long)i * G + c; if (L >= nwg) return false;
        int wgid = (int)L; { const int q = nwg / NXCD, r = nwg % NXCD, xcd = wgid % NXCD, off = wgid / NXCD; wgid = (xcd < r ? xcd * (q + 1) : r * (q + 1) + (xcd - r) * q) + off; }
        const int nig = WGM * nN, gid = wgid / nig, fm = gid * WGM, gsz = (nM - fm) < WGM ? (nM - fm) : WGM;
        u.pm = fm + ((wgid % nig) % gsz); u.pn = (wgid % nig) / gsz; return true;
    }
    __device__ __forceinline__ void a_ready(const Unit&) const {}
    __device__ __forceinline__ void done(const Unit&) const {}
};

__device__ __forceinline__ unsigned cvt_pk_bf16(float lo, float hi) { unsigned r; asm volatile("v_cvt_pk_bf16_f32 %0, %1, %2" : "=v"(r) : "v"(lo), "v"(hi)); return r; }
struct EpiBf16Plain {
    static constexpr bool PERM = true, AFTER_DRAIN = false;
    bf16_t* O; int ldc;
    __device__ __forceinline__ void operator()(const f32x4 (&acc)[2][2][4][2], const Unit& u, int wr, int wc, int fr, int fq) const {
        const int row0 = u.pm * BM + wr * 64 + fr, col0 = u.pn * BM + wc * 32 + 8 * fq;
#pragma unroll
        for (int ai = 0; ai < 2; ++ai)
#pragma unroll
            for (int m = 0; m < 4; ++m) { bf16_t* rowp = O + (size_t)(row0 + ai * HALF + m * 16) * ldc + col0;
#pragma unroll
                for (int bj = 0; bj < 2; ++bj) { const f32x4 v0 = acc[ai][bj][m][0], v1 = acc[ai][bj][m][1];
                    u32x4 w; w.x = cvt_pk_bf16(v0[0], v0[1]); w.y = cvt_pk_bf16(v0[2], v0[3]); w.z = cvt_pk_bf16(v1[0], v1[1]); w.w = cvt_pk_bf16(v1[2], v1[3]);
                    *(u32x4*)(rowp + bj * HALF) = w; } }
    }
};
struct EpiProj {
    static constexpr bool PERM = true, AFTER_DRAIN = false;
    bf16_t* O; int ldc; float* kmean; int kb_lo;
    __device__ __forceinline__ void operator()(const f32x4 (&acc)[2][2][4][2], const Unit& u, int wr, int wc, int fr, int fq) const {
        const int row0 = u.pm * BM + wr * 64 + fr, col0 = u.pn * BM + wc * 32 + 8 * fq;
#pragma unroll
        for (int ai = 0; ai < 2; ++ai)
#pragma unroll
            for (int m = 0; m < 4; ++m) { bf16_t* rowp = O + (size_t)(row0 + ai * HALF + m * 16) * ldc + col0;
#pragma unroll
                for (int bj = 0; bj < 2; ++bj) { const f32x4 v0 = acc[ai][bj][m][0], v1 = acc[ai][bj][m][1];
                    u32x4 w; w.x = cvt_pk_bf16(v0[0], v0[1]); w.y = cvt_pk_bf16(v0[2], v0[3]); w.z = cvt_pk_bf16(v1[0], v1[1]); w.w = cvt_pk_bf16(v1[2], v1[3]);
                    *(u32x4*)(rowp + bj * HALF) = w; } }
#pragma unroll
        for (int bj = 0; bj < 2; ++bj) {
            const int cb = u.pn * BM + bj * HALF;
            if (cb >= kb_lo && cb < kb_lo + 384) {
                f32x4 s0 = {0.f, 0.f, 0.f, 0.f}, s1 = {0.f, 0.f, 0.f, 0.f};
#pragma unroll
                for (int ai = 0; ai < 2; ++ai)
#pragma unroll
                    for (int m = 0; m < 4; ++m) { s0 += acc[ai][bj][m][0]; s1 += acc[ai][bj][m][1]; }
#pragma unroll
                for (int i = 0; i < 4; ++i) {
#pragma unroll
                    for (int o = 1; o < 16; o <<= 1) { s0[i] += __shfl_xor(s0[i], o); s1[i] += __shfl_xor(s1[i], o); }
                }
                if (fr == 0) {
                    const int c = cb + wc * 32 + 8 * fq - kb_lo, h = c >> 6, d = c & 63, b = u.pm >> 5, nb = u.pm & 31;
                    float* kp = kmean + ((size_t)((b * 6 + h) * 32 + nb)) * 64 + d;
#pragma unroll
                    for (int i = 0; i < 4; ++i) { atomicAdd(kp + i, s0[i]); atomicAdd(kp + 4 + i, s1[i]); }
                }
            }
        }
    }
};
struct EpiRes {
    static constexpr bool PERM = false, AFTER_DRAIN = false;
    const float* base; float* out; int ldc; const float* gate; int gstride;
    __device__ __forceinline__ void operator()(const f32x4 (&acc)[2][2][4][2], const Unit& u, int wr, int wc, int fr, int fq) const {
        const int row0 = u.pm * BM + wr * 64 + fr, col0 = u.pn * BM + wc * 32 + 4 * fq;
        const float* gp = gate + (size_t)(u.pm >> 5) * gstride + col0;
        f32x4 gv[2][2];
#pragma unroll
        for (int bj = 0; bj < 2; ++bj)
#pragma unroll
            for (int n = 0; n < 2; ++n) gv[bj][n] = *(const f32x4*)(gp + bj * HALF + n * 16);
#pragma unroll
        for (int ai = 0; ai < 2; ++ai)
#pragma unroll
            for (int m = 0; m < 4; ++m) { const size_t off = (size_t)(row0 + ai * HALF + m * 16) * ldc + col0;
#pragma unroll
                for (int bj = 0; bj < 2; ++bj)
#pragma unroll
                    for (int n = 0; n < 2; ++n) { const f32x4 bs = *(const f32x4*)(base + off + bj * HALF + n * 16);
                        *(f32x4*)(out + off + bj * HALF + n * 16) = bs + gv[bj][n] * acc[ai][bj][m][n]; } }
    }
};

template <class Epi, class Sched, bool ALIGN_EPI = false, bool SP2 = false>
__device__ __forceinline__ void gemm_phase(PG8_LAS unsigned char* lds, const Gemm g, const Sched& S, const Epi& E) {
    int tid_ = threadIdx.x; asm volatile("" : "+v"(tid_));
    const int tid = tid_, wid = __builtin_amdgcn_readfirstlane(tid >> 6), lane = tid & 63, wr = wid >> 2, wc = wid & 3, fr = lane & 15, fq = lane >> 4;
    const int K = g.K, nt = K / BK;
    unsigned voffA[2], voffB[2];
#pragma unroll
    for (int i = 0; i < 2; ++i) { int R, C; stage_rc(tid * 16 + i * 8192, R, C); const int Rb = Epi::PERM ? ((R & ~31) + perm32(R & 31)) : R;
        voffA[i] = (unsigned)(R * K + C) * 2u; voffB[i] = (unsigned)(Rb * K + C) * 2u; }
    const size_t kstep = (size_t)(BK * 2);
    const size_t hstep = (size_t)HALF * K * 2;
    const size_t tstep = 2 * hstep;
    const unsigned ldsw = (unsigned)wid * 1024u;
    const int aoff = lds_byte(wr * 64 + fr, fq * 8), boff = lds_byte(wc * 32 + fr, fq * 8);
#define PG8_SA(b, h) (((b) * 2 + (h)) * HTB)
#define PG8_SB(b, h) ((4 + (b) * 2 + (h)) * HTB)
#define PG8_STAGE(bufoff, gbase, voff) do { _Pragma("unroll") for (int _i = 0; _i < 2; ++_i) \
        __builtin_amdgcn_global_load_lds((const unsigned*)((const char*)(gbase) + (voff)[_i]), (PG8_LAS unsigned*)(lds + (bufoff) + ldsw + _i * 8192), 16, 0, 0); } while (0)
#define PG8_LDA(dst, b, h) do { _Pragma("unroll") for (int m = 0; m < 4; ++m) _Pragma("unroll") for (int k = 0; k < 2; ++k) dst[m][k] = *(const PG8_LAS bf16x8*)(lds + PG8_SA(b, h) + aoff + m * 2048 + k * 1024); } while (0)
#define PG8_LDB(dst, b, h) do { _Pragma("unroll") for (int n = 0; n < 2; ++n) _Pragma("unroll") for (int k = 0; k < 2; ++k) dst[n][k] = *(const PG8_LAS bf16x8*)(lds + PG8_SB(b, h) + boff + n * 2048 + k * 1024); } while (0)
#define PG8_MMA(ai, bj, At, Bt) do { __builtin_amdgcn_s_setprio(1); _Pragma("unroll") for (int m = 0; m < 4; ++m) _Pragma("unroll") for (int n = 0; n < 2; ++n) _Pragma("unroll") for (int k = 0; k < 2; ++k) \
        acc[ai][bj][m][n] = __builtin_amdgcn_mfma_f32_16x16x32_bf16(Bt[n][k], At[m][k], acc[ai][bj][m][n], 0, 0, 0); __builtin_amdgcn_s_setprio(0); } while (0)
#define PG8_WAIT_V(n) asm volatile("s_waitcnt vmcnt(" #n ")" ::: "memory")
#define PG8_WAIT_L(n) asm volatile("s_waitcnt lgkmcnt(" #n ")" ::: "memory")
#define PG8_BAR __builtin_amdgcn_s_barrier()
#define PG8_SCHED __builtin_amdgcn_sched_barrier(0)
    Unit cur, nxt; int ui = 0;
    if (!S.next(0, cur)) return;
    f32x4 acc[2][2][4][2];
#pragma unroll
    for (int a = 0; a < 2; ++a)
#pragma unroll
        for (int b = 0; b < 2; ++b)
#pragma unroll
            for (int m = 0; m < 4; ++m)
#pragma unroll
                for (int n = 0; n < 2; ++n) acc[a][b][m][n] = (f32x4){0.f, 0.f, 0.f, 0.f};
    bf16x8 At[4][2], B0[2][2], B1[2][2];
    const char* cA = (const char*)g.A + (size_t)cur.pm * tstep; const char* cB = (const char*)g.Bt + (size_t)cur.pn * tstep;
    S.a_ready(cur);
    if constexpr (SP2) {
        PG8_STAGE(PG8_SB(0, 0), cB, voffB); PG8_STAGE(PG8_SB(0, 1), cB + hstep, voffB); PG8_STAGE(PG8_SA(0, 0), cA, voffA); PG8_STAGE(PG8_SA(0, 1), cA + hstep, voffA);
        if (wr == 1) PG8_BAR;
        PG8_WAIT_V(2); PG8_BAR;
        PG8_STAGE(PG8_SB(1, 0), cB + kstep, voffB); PG8_STAGE(PG8_SA(1, 0), cA + kstep, voffA); PG8_STAGE(PG8_SB(1, 1), cB + hstep + kstep, voffB);
        PG8_WAIT_V(6); PG8_BAR;
    } else {
        PG8_STAGE(PG8_SB(0, 0), cB, voffB); PG8_STAGE(PG8_SA(0, 0), cA, voffA); PG8_STAGE(PG8_SB(0, 1), cB + hstep, voffB); PG8_STAGE(PG8_SA(0, 1), cA + hstep, voffA);
        if (wr == 1) PG8_BAR;
        PG8_WAIT_V(4); PG8_BAR;
        PG8_STAGE(PG8_SB(1, 0), cB + kstep, voffB); PG8_STAGE(PG8_SA(1, 0), cA + kstep, voffA); PG8_STAGE(PG8_SB(1, 1), cB + hstep + kstep, voffB);
        PG8_WAIT_V(6); PG8_BAR;
    }
    for (;;) {
        const bool has_next = S.next(ui + 1, nxt);
        const char* nA = has_next ? (const char*)g.A + (size_t)nxt.pm * tstep : cA; const char* nB = has_next ? (const char*)g.Bt + (size_t)nxt.pn * tstep : cB;
        for (int t = 0; t < nt; t += 2) {
            const bool last = (t == nt - 2);
            const char* a1 = cA + (size_t)(t + 1) * kstep;
            const char* a2 = last ? nA : cA + (size_t)(t + 2) * kstep; const char* b2 = last ? nB : cB + (size_t)(t + 2) * kstep;
            const char* a3 = a2 + kstep; const char* b3 = b2 + kstep;
            if (last && has_next) S.a_ready(nxt);
            if constexpr (SP2) {
            PG8_LDB(B0, 0, 0); PG8_LDB(B1, 0, 1); PG8_SCHED; PG8_LDA(At, 0, 0); PG8_STAGE(PG8_SA(1, 1), a1 + hstep, voffA);
            PG8_WAIT_V(8); PG8_WAIT_L(0); PG8_BAR; PG8_MMA(0, 0, At, B0); PG8_MMA(0, 1, At, B1); PG8_BAR; PG8_SCHED;
            PG8_LDA(At, 0, 1); PG8_STAGE(PG8_SB(0, 0), b2, voffB); PG8_STAGE(PG8_SB(0, 1), b2 + hstep, voffB); PG8_STAGE(PG8_SA(0, 0), a2, voffA);
            PG8_WAIT_V(8); PG8_WAIT_L(0); PG8_BAR; PG8_MMA(1, 0, At, B0); PG8_MMA(1, 1, At, B1); PG8_BAR; PG8_SCHED;
            PG8_LDB(B0, 1, 0); PG8_LDB(B1, 1, 1); PG8_SCHED; PG8_LDA(At, 1, 0); PG8_STAGE(PG8_SA(0, 1), a2 + hstep, voffA);
            PG8_WAIT_V(8); PG8_WAIT_L(0); PG8_BAR; PG8_MMA(0, 0, At, B0); PG8_MMA(0, 1, At, B1); PG8_BAR; PG8_SCHED;
            PG8_LDA(At, 1, 1); PG8_STAGE(PG8_SB(1, 0), b3, voffB); PG8_STAGE(PG8_SB(1, 1), b3 + hstep, voffB); PG8_STAGE(PG8_SA(1, 0), a3, voffA);
            PG8_WAIT_V(8); PG8_WAIT_L(0); PG8_BAR; PG8_MMA(1, 0, At, B0); PG8_MMA(1, 1, At, B1); PG8_BAR; PG8_SCHED;
            } else {
            PG8_LDB(B0, 0, 0); PG8_SCHED; PG8_LDA(At, 0, 0); PG8_STAGE(PG8_SA(1, 1), a1 + hstep, voffA);
            PG8_WAIT_L(8); PG8_BAR; PG8_WAIT_L(0); PG8_MMA(0, 0, At, B0); PG8_BAR; PG8_SCHED;
            PG8_LDB(B1, 0, 1); PG8_STAGE(PG8_SB(0, 0), b2, voffB);
            PG8_BAR; PG8_WAIT_L(0); PG8_MMA(0, 1, At, B1); PG8_BAR;
            PG8_LDA(At, 0, 1); PG8_STAGE(PG8_SA(0, 0), a2, voffA);
            PG8_BAR; PG8_WAIT_L(0); PG8_MMA(1, 0, At, B0); PG8_BAR; PG8_SCHED;
            PG8_STAGE(PG8_SB(0, 1), b2 + hstep, voffB);
            PG8_WAIT_V(6); PG8_BAR; PG8_MMA(1, 1, At, B1); PG8_BAR;
            PG8_LDB(B0, 1, 0); PG8_SCHED; PG8_LDA(At, 1, 0); PG8_STAGE(PG8_SA(0, 1), a2 + hstep, voffA);
            PG8_WAIT_L(8); PG8_BAR; PG8_WAIT_L(0); PG8_MMA(0, 0, At, B0); PG8_BAR; PG8_SCHED;
            PG8_LDB(B1, 1, 1); PG8_STAGE(PG8_SB(1, 0), b3, voffB);
            PG8_BAR; PG8_WAIT_L(0); PG8_MMA(0, 1, At, B1); PG8_BAR;
            PG8_LDA(At, 1, 1); PG8_STAGE(PG8_SA(1, 0), a3, voffA);
            PG8_BAR; PG8_WAIT_L(0); PG8_MMA(1, 0, At, B0); PG8_BAR; PG8_SCHED;
            PG8_STAGE(PG8_SB(1, 1), b3 + hstep, voffB);
            PG8_WAIT_V(6); PG8_BAR; PG8_MMA(1, 1, At, B1); PG8_BAR;
            }
        }
        if constexpr (ALIGN_EPI) { if (wr == 0) PG8_BAR; }
        if constexpr (!Epi::AFTER_DRAIN) { E(acc, cur, wr, wc, fr, fq); S.done(cur); }
        if (!has_next) break;
#pragma unroll
        for (int a = 0; a < 2; ++a)
#pragma unroll
            for (int b = 0; b < 2; ++b)
#pragma unroll
                for (int m = 0; m < 4; ++m)
#pragma unroll
                    for (int n = 0; n < 2; ++n) acc[a][b][m][n] = (f32x4){0.f, 0.f, 0.f, 0.f};
        cur = nxt; cA = nA; cB = nB; ++ui;
        if constexpr (ALIGN_EPI) { if (wr == 1) PG8_BAR; }
    }
    PG8_WAIT_V(0);
    if constexpr (!ALIGN_EPI) { if (wr == 0) PG8_BAR; }
    PG8_BAR;
    if constexpr (Epi::AFTER_DRAIN) { E.fused(acc, cur, wr, wc, fr, fq, lds, wid, lane); S.done(cur); }
#undef PG8_SA
#undef PG8_SB
#undef PG8_STAGE
#undef PG8_LDA
#undef PG8_LDB
#undef PG8_MMA
#undef PG8_WAIT_V
#undef PG8_WAIT_L
#undef PG8_BAR
#undef PG8_SCHED
}
}
namespace att {
constexpr int A_K = 0, A_V = 16384, A_WSF = 32768, A_KM = A_WSF + 2048, A_STG = A_KM + 8192;
constexpr int STG_STRIDE = 68, STG_WAVE_BYTES = 32 * STG_STRIDE * 4, A_END = A_STG + NWAVES * STG_WAVE_BYTES;
__device__ __forceinline__ int crow(int r, int hi) { return (r & 3) + 8 * (r >> 2) + 4 * hi; }
__device__ __forceinline__ void dma16(const void* g, LAS unsigned char* l) { __builtin_amdgcn_global_load_lds((const unsigned*)g, (LAS unsigned*)l, 16, 0, 0); }
typedef float f32x2_t __attribute__((ext_vector_type(2))); typedef __bf16 bf16x2_t __attribute__((ext_vector_type(2)));
__device__ __forceinline__ unsigned cvtpk(float lo, float hi) { f32x2_t v = {lo, hi}; bf16x2_t b = __builtin_convertvector(v, bf16x2_t); return __builtin_bit_cast(unsigned, b); }
typedef short v4i16_t __attribute__((ext_vector_type(4)));
__device__ __forceinline__ s16x4_t vtr(LAS const unsigned char* p) { return __builtin_bit_cast(s16x4_t, __builtin_amdgcn_ds_read_tr16_b64_v4i16((LAS v4i16_t*)p)); }
#define LDSW() asm volatile("s_waitcnt lgkmcnt(0)" ::: "memory")

template <int MODE>
__device__ __forceinline__ void attn_unit(int b, int h, int qb, const bf16_t* __restrict__ proj, bf16_t* __restrict__ Obuf, const float* __restrict__ kmean,
                                          float lam, float lam_init, const float* __restrict__ subg, const float* sinkp, LAS unsigned char* lds) {
    constexpr int NMAP = (MODE == 0) ? 2 : 1;
    int tid_ = threadIdx.x; asm volatile("" : "+v"(tid_));
    const int tid = tid_, lane = tid & 63, r32 = lane & 31, hi = lane >> 5;
    const int wid = __builtin_amdgcn_readfirstlane(tid >> 6);
    const int q0 = qb * 256;
    int qcol, kcol, vcol, ocol; float slope;
    if (MODE == 0) { qcol = OFF_QA + h * 64; kcol = OFF_KA + h * 64; vcol = OFF_VA + h * 64; ocol = h * 64; slope = alibi_slope(6 + h); }
    else if (MODE == 1) { qcol = OFF_QB + h * 64; kcol = OFF_KB + h * 64; vcol = OFF_VB + h * 64; ocol = 256 + h * 64; slope = alibi_slope(10 + h); }
    else { qcol = OFF_QC + h * 64; kcol = OFF_KC + (h / 3) * 64; vcol = OFF_VC + (h / 3) * 64; ocol = 640 + h * 64; slope = alibi_slope(h); }
    const float slope2 = slope * LOG2E;
    const float cscale = (MODE == 0 ? 0.17677669529663687f : 0.125f) * LOG2E;
    const bf16_t* base = proj + (size_t)b * SEQ * INW;
    const int t_hi = 4 * qb + 4, t_lo = (MODE == 2) ? (qb > 0 ? 4 * qb - 2 : 0) : 0;
    const bf16_t* ksrc = base + kcol + (size_t)lane * INW + wid * 8;
    const bf16_t* vsrc = base + vcol + (size_t)(16 * (wid & 3) + (lane >> 2)) * INW + (wid >> 2) * 32 + (lane & 3) * 8;
#define DMA_TILE(t, bufi) do { dma16(ksrc + (size_t)(t) * 64 * INW, lds + A_K + (bufi) * 8192 + wid * 1024); dma16(vsrc + (size_t)(t) * 64 * INW, lds + A_V + (bufi) * 8192 + wid * 1024); } while (0)
    DMA_TILE(t_lo, 0);
    const bf16_t* Qw = base + (size_t)(q0 + wid * 32 + r32) * INW + qcol;
    bf16x8_t qr[4];
#pragma unroll
    for (int d0 = 0; d0 < 4; ++d0) qr[d0] = *(const bf16x8_t*)(Qw + d0 * 16 + hi * 8);
    const int qrel = wid * 32 + r32;
    const LAS unsigned char* qlds = lds + A_STG + wid * STG_WAVE_BYTES + lane * 16;
    if (MODE == 0) {
#pragma unroll
        for (int d0 = 0; d0 < 4; ++d0) *(LAS bf16x8_t*)(lds + A_STG + wid * STG_WAVE_BYTES + lane * 16 + d0 * 1024) = qr[d0];
    }
    unsigned rowmask = 0u;
    if (MODE == 1) {
        LAS float* km = (LAS float*)(lds + A_KM);
        const float* kmg = kmean + (size_t)((b * 6 + h) * 32) * 64;
        for (int i = tid; i < 2048; i += NTHREADS) km[i] = kmg[i] * (1.0f / 256.0f);
        __syncthreads();
        if (qb > 0) {
            float qf[32];
#pragma unroll
            for (int d0 = 0; d0 < 4; ++d0)
#pragma unroll
                for (int j = 0; j < 8; ++j) qf[d0 * 8 + j] = __builtin_bit_cast(float, ((unsigned)(unsigned short)qr[d0][j]) << 16);
            float v0 = -INFINITY, v1 = -INFINITY, v2 = -INFINITY; int i0 = 0, i1 = 0, i2 = 0;
            for (int n = 0; n < qb; ++n) {
                const LAS float* kp = km + n * 64 + 8 * hi;
                float part = 0.f;
#pragma unroll
                for (int d0 = 0; d0 < 4; ++d0) {
                    const f32x4_t a = *(const LAS f32x4_t*)(kp + d0 * 16), c = *(const LAS f32x4_t*)(kp + d0 * 16 + 4);
                    part += qf[d0 * 8 + 0] * a[0]; part += qf[d0 * 8 + 1] * a[1]; part += qf[d0 * 8 + 2] * a[2]; part += qf[d0 * 8 + 3] * a[3];
                    part += qf[d0 * 8 + 4] * c[0]; part += qf[d0 * 8 + 5] * c[1]; part += qf[d0 * 8 + 6] * c[2]; part += qf[d0 * 8 + 7] * c[3];
                }
                const float tot = part + swap32_partner(part, hi);
                if (tot > v0) { v2 = v1; i2 = i1; v1 = v0; i1 = i0; v0 = tot; i0 = n; }
                else if (tot > v1) { v2 = v1; i2 = i1; v1 = tot; i1 = n; }
                else if (tot > v2) { v2 = tot; i2 = n; }
            }
            if (v0 > -INFINITY) rowmask |= 1u << i0;
            if (v1 > -INFINITY) rowmask |= 1u << i1;
            if (v2 > -INFINITY) rowmask |= 1u << i2;
        }
    }
    float m_[NMAP], l_[NMAP]; f32x16_t o[NMAP][2];
#pragma unroll
    for (int mi = 0; mi < NMAP; ++mi) { m_[mi] = -INFINITY; l_[mi] = 0.f;
#pragma unroll
        for (int d0 = 0; d0 < 2; ++d0)
#pragma unroll
            for (int r = 0; r < 16; ++r) o[mi][d0][r] = 0.f; }
    LAS float* wsf = (LAS float*)(lds + A_WSF) + wid * 64;
    const int vlane = ((lane >> 4) & 1) * 32 + (lane & 3) * 8 + (4 * hi + ((lane & 15) >> 2)) * 64;

    for (int t = t_lo; t < t_hi; ++t) {
        const int bufi = (t - t_lo) & 1;
        asm volatile("s_waitcnt vmcnt(0)" ::: "memory");
        __syncthreads();
        if (t + 1 < t_hi) DMA_TILE(t + 1, bufi ^ 1);
        const int krel0 = 64 * t - q0;
        bool need = krel0 <= wid * 32 + 31;
        if (MODE == 2) need = need && (krel0 + 63 >= wid * 32 - 127);
        const bool past = (MODE == 1) && ((t >> 2) < qb);
        if (past) need = __any((int)((rowmask >> (t >> 2)) & 1u)) != 0;
        if (!need) continue;
        const bool diag = krel0 + 63 > wid * 32;
        const int kb = krel0 + 4 * hi;
        const LAS unsigned char* Ks = lds + A_K + bufi * 8192 + hi * 1024 + r32 * 16;
        const LAS unsigned char* Vs = lds + A_V + bufi * 8192 + vlane;
#pragma unroll
        for (int mi = 0; mi < NMAP; ++mi) {
            f32x16_t p0, p1;
#pragma unroll
            for (int r = 0; r < 16; ++r) { p0[r] = 0.f; p1[r] = 0.f; }
            constexpr int ND0 = (MODE == 0) ? 2 : 4;
#pragma unroll
            for (int dd = 0; dd < ND0; ++dd) {
                const int d0 = (MODE == 0) ? (2 * mi + dd) : dd;
                const bf16x8_t b0 = *(const LAS bf16x8_t*)(Ks + d0 * 2048);
                const bf16x8_t b1 = *(const LAS bf16x8_t*)(Ks + d0 * 2048 + 512);
                const bf16x8_t qa = (MODE == 0) ? *(const LAS bf16x8_t*)(qlds + d0 * 1024) : qr[d0];
                p0 = __builtin_amdgcn_mfma_f32_32x32x16_bf16(b0, qa, p0, 0, 0, 0);
                p1 = __builtin_amdgcn_mfma_f32_32x32x16_bf16(b1, qa, p1, 0, 0, 0);
            }
            float sl2 = slope2; asm volatile("" : "+v"(sl2));
            const float tb = sl2 * (float)kb;
#pragma unroll
            for (int r = 0; r < 16; ++r) { const int kk = (r & 3) + 8 * (r >> 2); const float bias = tb + sl2 * (float)kk;
                p0[r] = p0[r] * cscale + bias; p1[r] = p1[r] * cscale + (bias + sl2 * 32.0f); }
            if (diag) {
#pragma unroll
                for (int r = 0; r < 16; ++r) { const int kk = kb + (r & 3) + 8 * (r >> 2); if (kk > qrel) p0[r] = -INFINITY; if (kk + 32 > qrel) p1[r] = -INFINITY; }
            }
            if (MODE == 2) {
#pragma unroll
                for (int r = 0; r < 16; ++r) { const int kk = kb + (r & 3) + 8 * (r >> 2); if (qrel - kk >= 128) p0[r] = -INFINITY; if (qrel - (kk + 32) >= 128) p1[r] = -INFINITY; }
            }
            if (past) { if (!((rowmask >> (t >> 2)) & 1u)) {
#pragma unroll
                for (int r = 0; r < 16; ++r) { p0[r] = -INFINITY; p1[r] = -INFINITY; } } }
            float mx = fmaxf(p0[0], p1[0]);
#pragma unroll
            for (int r = 1; r < 16; ++r) mx = fmaxf(mx, fmaxf(p0[r], p1[r]));
            mx = fmaxf(mx, __shfl_xor(mx, 32));
            const float mnew = fmaxf(m_[mi], mx), msafe = (mnew == -INFINITY) ? 0.f : mnew;
            const float f = __builtin_amdgcn_exp2f(m_[mi] - msafe);
            float ps = 0.f;
#pragma unroll
            for (int r = 0; r < 16; ++r) { p0[r] = __builtin_amdgcn_exp2f(p0[r] - msafe); p1[r] = __builtin_amdgcn_exp2f(p1[r] - msafe); ps += p0[r] + p1[r]; }
            l_[mi] = l_[mi] * f + ps; m_[mi] = mnew;
            if (__any(f != 1.0f)) {
                if (hi == 0) wsf[mi * 32 + r32] = f;
                LDSW();
#pragma unroll
                for (int r = 0; r < 16; ++r) { const float fr_ = wsf[mi * 32 + crow(r, hi)]; o[mi][0][r] *= fr_; o[mi][1][r] *= fr_; }
            }
            u32x4_t pw[4];
#pragma unroll
            for (int j = 0; j < 4; ++j) { pw[0][j] = cvtpk(p0[2 * j], p0[2 * j + 1]); pw[1][j] = cvtpk(p0[8 + 2 * j], p0[8 + 2 * j + 1]);
                                          pw[2][j] = cvtpk(p1[2 * j], p1[2 * j + 1]); pw[3][j] = cvtpk(p1[8 + 2 * j], p1[8 + 2 * j + 1]); }
#pragma unroll
            for (int d0 = 0; d0 < 2; ++d0) {
                if (d0) __builtin_amdgcn_sched_barrier(0);
#pragma unroll
                for (int ks = 0; ks < 4; ++ks) {
                    const s16x4_t lo = vtr(Vs + d0 * 4096 + ks * 1024), hh = vtr(Vs + d0 * 4096 + ks * 1024 + 512);
                    const bf16x8_t vf = {lo[0], lo[1], lo[2], lo[3], hh[0], hh[1], hh[2], hh[3]};
                    o[mi][d0] = __builtin_amdgcn_mfma_f32_32x32x16_bf16(__builtin_bit_cast(bf16x8_t, pw[ks]), vf, o[mi][d0], 0, 0, 0);
                }
            }
            if (NMAP > 1) __builtin_amdgcn_sched_barrier(0);
        }
    }
#undef DMA_TILE
    float rl[NMAP][16];
#pragma unroll
    for (int mi = 0; mi < NMAP; ++mi) {
        float lt = l_[mi];
        lt += __shfl_xor(lt, 32);
        if (MODE == 2) lt += __builtin_amdgcn_exp2f(sinkp[0] * LOG2E + slope2 * (float)qrel - m_[mi]);
        if (hi == 0) wsf[mi * 32 + r32] = 1.0f / lt;
    }
    LDSW();
#pragma unroll
    for (int mi = 0; mi < NMAP; ++mi)
#pragma unroll
        for (int r = 0; r < 16; ++r) rl[mi][r] = wsf[mi * 32 + crow(r, hi)];
    LAS float* stg = (LAS float*)(lds + A_STG + wid * STG_WAVE_BYTES);
#pragma unroll
    for (int d0 = 0; d0 < 2; ++d0)
#pragma unroll
        for (int r = 0; r < 16; ++r) {
            float v = o[0][d0][r] * rl[0][r];
            if (MODE == 0) v -= lam * (o[NMAP - 1][d0][r] * rl[NMAP - 1][r]);
            stg[crow(r, hi) * STG_STRIDE + d0 * 32 + r32] = v;
        }
    LDSW();
    {
        const int row = lane >> 1, half = lane & 1;
        float v[32];
#pragma unroll
        for (int i = 0; i < 8; ++i) { const f32x4_t x = *(const LAS f32x4_t*)(stg + row * STG_STRIDE + half * 32 + i * 4); v[4 * i] = x[0]; v[4 * i + 1] = x[1]; v[4 * i + 2] = x[2]; v[4 * i + 3] = x[3]; }
        if (MODE == 0) {
            float ss = 0.f;
#pragma unroll
            for (int i = 0; i < 32; ++i) ss += v[i] * v[i];
            ss += __shfl_xor(ss, 1);
            const float rs = (1.0f / sqrtf(ss * (1.0f / 64.0f) + EPS)) * (1.0f - lam_init);
#pragma unroll
            for (int i = 0; i < 32; ++i) v[i] = v[i] * rs * subg[half * 32 + i];
        }
        bf16_t* op = Obuf + (size_t)(b * SEQ + q0 + wid * 32 + row) * DM + ocol + half * 32;
#pragma unroll
        for (int i = 0; i < 4; ++i) { u32x4_t w; w.x = cvtpk(v[8 * i], v[8 * i + 1]); w.y = cvtpk(v[8 * i + 2], v[8 * i + 3]); w.z = cvtpk(v[8 * i + 4], v[8 * i + 5]); w.w = cvtpk(v[8 * i + 6], v[8 * i + 7]);
            *(u32x4_t*)(op + 8 * i) = w; }
    }
    __syncthreads();
}
#undef LDSW
}

namespace peer {
constexpr int K_BYTES = 2 * 32768;
__device__ __forceinline__ int crow(int r, int hi) { return (r & 3) + 8 * (r >> 2) + 4 * hi; }

template <int N>
__device__ __forceinline__ void top16_pair(float (&s)[N], float (&out)[16], bool pair) {
#pragma unroll
    for (int it = 0; it < 16; ++it) {
        float mx = s[0];
#pragma unroll
        for (int i = 1; i < N; ++i) mx = fmaxf(mx, s[i]);
        if (pair) mx = fmaxf(mx, __shfl_xor(mx, 32));
        out[it] = mx;
#pragma unroll
        for (int i = 0; i < N; ++i) s[i] = (s[i] == mx) ? -INFINITY : s[i];
    }
}
__device__ __forceinline__ float pack_idx(float v, unsigned idx, unsigned mask) { return __builtin_bit_cast(float, (__builtin_bit_cast(unsigned, v) & ~mask) | idx); }
__device__ __forceinline__ unsigned byte16(unsigned t0, unsigned t1, unsigned t2, unsigned t3, unsigned i) {
    const unsigned s = i & 7u, a = __builtin_amdgcn_perm(t1, t0, s), b = __builtin_amdgcn_perm(t3, t2, s);
    return ((i & 8u) ? b : a) & 0xffu;
}

__device__ __forceinline__ void pk_unit(int tile, int h, const bf16_t* __restrict__ Q, const bf16_t* __restrict__ keysb, int* __restrict__ Eid, float* __restrict__ Gw, LAS unsigned char* lds) {
    int tid_ = threadIdx.x; asm volatile("" : "+v"(tid_));
    const int tid = tid_, lane = tid & 63, r32 = lane & 31, hi = lane >> 5;
    const int wid = __builtin_amdgcn_readfirstlane(tid >> 6);
    __syncthreads();
    {
        const bf16_t* kg = keysb + (size_t)h * 2 * 128 * 128;
        for (int i = tid; i < 2 * 128 * 16; i += NTHREADS) {
            const int n = i & 127, c = (i >> 7) & 15, p = i >> 11;
            const u32x4_t v = *(const u32x4_t*)(kg + ((size_t)(p * 128 + n)) * 128 + c * 8);
            *(LAS u32x4_t*)(lds + p * 32768 + c * 2048 + n * 16) = v;
        }
    }
    __syncthreads();
    const int tok = tile * 256 + wid * 32 + r32;
    float sv[2][16];
#pragma unroll
    for (int p = 0; p < 2; ++p) {
        const bf16_t* qp = Q + (size_t)tok * PQW + h * 256 + p * 128 + hi * 8;
        bf16x8_t qf[8];
#pragma unroll
        for (int ks = 0; ks < 8; ++ks) qf[ks] = *(const bf16x8_t*)(qp + ks * 16);
        float s[64];
#pragma unroll
        for (int blk = 0; blk < 4; ++blk) {
            f32x16_t acc;
#pragma unroll
            for (int r = 0; r < 16; ++r) acc[r] = 0.f;
#pragma unroll
            for (int ks = 0; ks < 8; ++ks) {
                const bf16x8_t kf = *(const LAS bf16x8_t*)(lds + p * 32768 + (2 * ks + hi) * 2048 + (blk * 32 + r32) * 16);
                acc = __builtin_amdgcn_mfma_f32_32x32x16_bf16(kf, qf[ks], acc, 0, 0, 0);
            }
#pragma unroll
            for (int r = 0; r < 16; ++r) s[blk * 16 + r] = pack_idx(acc[r], (unsigned)(blk * 32 + (r & 3) + 8 * (r >> 2) + 4 * hi), 127u);
        }
        top16_pair<64>(s, sv[p], true);
    }
    float cand[50];
    {
        int c = 0;
#pragma unroll
        for (int i = 0; i < 16; ++i)
#pragma unroll
            for (int j = 0; j < 16; ++j)
                if ((i + 1) * (j + 1) <= 16) { cand[c] = pack_idx(sv[0][i] + sv[1][j], (unsigned)(i * 16 + j), 255u); ++c; }
    }
    float top[16];
    top16_pair<50>(cand, top, false);
    unsigned t1[4], t2[4];
#pragma unroll
    for (int j = 0; j < 4; ++j) { t1[j] = 0u; t2[j] = 0u;
#pragma unroll
        for (int k = 0; k < 4; ++k) { t1[j] |= (__builtin_bit_cast(unsigned, sv[0][4 * j + k]) & 127u) << (8 * k); t2[j] |= (__builtin_bit_cast(unsigned, sv[1][4 * j + k]) & 127u) << (8 * k); } }
    float g[16]; int e[16]; float gs = 0.f;
#pragma unroll
    for (int k = 0; k < 16; ++k) {
        const unsigned code = __builtin_bit_cast(unsigned, top[k]) & 255u;
        e[k] = (int)(byte16(t1[0], t1[1], t1[2], t1[3], code >> 4) * 128u + byte16(t2[0], t2[1], t2[2], t2[3], code & 15u));
        g[k] = __expf(top[k] - top[0]); gs += g[k];
    }
    const float gi = 1.0f / gs;
    if (hi == 0) {
        int* ep = Eid + ((size_t)tok * PHEADS + h) * 16; float* gp = Gw + ((size_t)tok * PHEADS + h) * 16;
#pragma unroll
        for (int k = 0; k < 16; k += 4) {
            *(int4*)(ep + k) = make_int4(e[k], e[k + 1], e[k + 2], e[k + 3]);
            *(float4*)(gp + k) = make_float4(g[k] * gi, g[k + 1] * gi, g[k + 2] * gi, g[k + 3] * gi);
        }
    }
}

__device__ __forceinline__ float reduce16(float (&a)[16], int lane) {
    float b8[8];
    { const bool up = lane & 1;
#pragma unroll
      for (int i = 0; i < 8; ++i) { const float keep = up ? a[8 + i] : a[i], give = up ? a[i] : a[8 + i]; b8[i] = keep + __shfl_xor(give, 1); } }
    float b4[4];
    { const bool up = lane & 2;
#pragma unroll
      for (int i = 0; i < 4; ++i) { const float keep = up ? b8[4 + i] : b8[i], give = up ? b8[i] : b8[4 + i]; b4[i] = keep + __shfl_xor(give, 2); } }
    float b2[2];
    { const bool up = lane & 4;
#pragma unroll
      for (int i = 0; i < 2; ++i) { const float keep = up ? b4[2 + i] : b4[i], give = up ? b4[i] : b4[2 + i]; b2[i] = keep + __shfl_xor(give, 4); } }
    float b1;
    { const bool up = lane & 8; const float keep = up ? b2[1] : b2[0], give = up ? b2[0] : b2[1]; b1 = keep + __shfl_xor(give, 8); }
    b1 += __shfl_xor(b1, 16); b1 += __shfl_xor(b1, 32);
    return b1;
}
__device__ __forceinline__ int red16_index(int lane) { return 8 * (lane & 1) + 4 * ((lane >> 1) & 1) + 2 * ((lane >> 2) & 1) + ((lane >> 3) & 1); }

typedef float f32x2_t __attribute__((ext_vector_type(2)));
__device__ __forceinline__ void pg_token(int tok, const float* xres, float* xdst, const LAS float* tab2  , const float* __restrict__ g2  , int gstride,
                                         const int* __restrict__ Eid, const float* __restrict__ Gw, const unsigned char* __restrict__ U8, const unsigned char* __restrict__ V8,
                                         const float* __restrict__ Us, const float* __restrict__ Vs,
                                         bool last, const LAS float* tabn  , const float* __restrict__ final_g, bf16_t* __restrict__ Hn, float* __restrict__ outp, int lane) {
    const int b = tok >> 13;
    float x[16];
    const float* xp = xres + (size_t)tok * DM + 16 * lane;
    float* xw = xdst + (size_t)tok * DM + 16 * lane;
#pragma unroll
    for (int q = 0; q < 4; ++q) { const f32x4_t a = *(const f32x4_t*)(xp + 4 * q); x[4 * q] = a[0]; x[4 * q + 1] = a[1]; x[4 * q + 2] = a[2]; x[4 * q + 3] = a[3]; }
    float ss = 0.f;
#pragma unroll
    for (int i = 0; i < 16; ++i) ss += x[i] * x[i];
    const float rstd = 1.0f / sqrtf(wave_sum(ss) * (1.0f / DM) + EPS);
    float hh[16];
#pragma unroll
    for (int q = 0; q < 4; ++q) { const f32x4_t g = *(const LAS f32x4_t*)(tab2 + (b * 2 + 0) * 1024 + 16 * lane + 4 * q), s = *(const LAS f32x4_t*)(tab2 + (b * 2 + 1) * 1024 + 16 * lane + 4 * q);
#pragma unroll
        for (int i = 0; i < 4; ++i) hh[4 * q + i] = x[4 * q + i] * rstd * g[i] + s[i]; }
    float out[16];
#pragma unroll
    for (int i = 0; i < 16; ++i) out[i] = 0.f;
    const int ridx = red16_index(lane);
    for (int hd = 0; hd < PHEADS; ++hd) {
        const size_t eb = ((size_t)tok * PHEADS + hd) * 16;
        const int ev = Eid[eb + (lane & 15)];
        const int er = Eid[eb + ridx];
        const float gv = Gw[eb + ridx];
        const float su = Us[er], sv = Vs[er];
        float a[16];
        {
            u32x4_t w[16];
#pragma unroll
            for (int k = 0; k < 16; ++k) { const int e = __builtin_amdgcn_readlane(ev, k); w[k] = *(const u32x4_t*)(U8 + (size_t)e * DM + 16 * lane); }
#pragma unroll
            for (int k = 0; k < 16; ++k) { float acc = 0.f;
#pragma unroll
                for (int q = 0; q < 4; ++q) { const f32x2_t lo = __builtin_amdgcn_cvt_pk_f32_fp8((int)w[k][q], false), hi2 = __builtin_amdgcn_cvt_pk_f32_fp8((int)w[k][q], true);
                    acc += hh[4 * q] * lo[0]; acc += hh[4 * q + 1] * lo[1]; acc += hh[4 * q + 2] * hi2[0]; acc += hh[4 * q + 3] * hi2[1]; }
                a[k] = acc; }
        }
        __builtin_amdgcn_sched_barrier(0);
        const float dot = reduce16(a, lane) * su;
        const float wgt = gv * sv * 0.5f * dot * (1.0f + erff(dot * 0.70710678118654752f));
        {
            u32x4_t w[16];
#pragma unroll
            for (int k = 0; k < 16; ++k) { const int e = __builtin_amdgcn_readlane(ev, k); w[k] = *(const u32x4_t*)(V8 + (size_t)e * DM + 16 * lane); }
#pragma unroll
            for (int k = 0; k < 16; ++k) {
                const int src = ((k >> 3) & 1) | (((k >> 2) & 1) << 1) | (((k >> 1) & 1) << 2) | ((k & 1) << 3);
                const float wk = __builtin_bit_cast(float, __builtin_amdgcn_readlane(__builtin_bit_cast(int, wgt), src));
#pragma unroll
                for (int q = 0; q < 4; ++q) { const f32x2_t lo = __builtin_amdgcn_cvt_pk_f32_fp8((int)w[k][q], false), hi2 = __builtin_amdgcn_cvt_pk_f32_fp8((int)w[k][q], true);
                    out[4 * q] += wk * lo[0]; out[4 * q + 1] += wk * lo[1]; out[4 * q + 2] += wk * hi2[0]; out[4 * q + 3] += wk * hi2[1]; }
            }
        }
    }
    float y[16]; float s2 = 0.f;
#pragma unroll
    for (int q = 0; q < 4; ++q) { const f32x4_t gg = *(const f32x4_t*)(g2 + (size_t)b * gstride + 16 * lane + 4 * q);
#pragma unroll
        for (int i = 0; i < 4; ++i) { y[4 * q + i] = x[4 * q + i] + gg[i] * out[4 * q + i]; s2 += y[4 * q + i] * y[4 * q + i]; } }
    const float rn = 1.0f / sqrtf(wave_sum(s2) * (1.0f / DM) + EPS);
    if (!last) {
#pragma unroll
        for (int q = 0; q < 4; ++q) *(f32x4_t*)(xw + 4 * q) = (f32x4_t){y[4 * q], y[4 * q + 1], y[4 * q + 2], y[4 * q + 3]};
        float z[16];
#pragma unroll
        for (int q = 0; q < 4; ++q) { const f32x4_t g = *(const LAS f32x4_t*)(tabn + (b * 2 + 0) * 1024 + 16 * lane + 4 * q), s = *(const LAS f32x4_t*)(tabn + (b * 2 + 1) * 1024 + 16 * lane + 4 * q);
#pragma unroll
            for (int i = 0; i < 4; ++i) z[4 * q + i] = y[4 * q + i] * rn * g[i] + s[i]; }
        bf16_t* hp = Hn + (size_t)tok * DM + 16 * lane;
#pragma unroll
        for (int j = 0; j < 2; ++j) { u32x4_t wv; wv.x = pk2(z[8 * j], z[8 * j + 1]); wv.y = pk2(z[8 * j + 2], z[8 * j + 3]); wv.z = pk2(z[8 * j + 4], z[8 * j + 5]); wv.w = pk2(z[8 * j + 6], z[8 * j + 7]); *(u32x4_t*)(hp + 8 * j) = wv; }
    } else {
        float* op = outp + (size_t)tok * DM + 16 * lane;
#pragma unroll
        for (int q = 0; q < 4; ++q) { const f32x4_t fg = *(const f32x4_t*)(final_g + 16 * lane + 4 * q);
            *(f32x4_t*)(op + 4 * q) = (f32x4_t){y[4 * q] * rn * fg[0], y[4 * q + 1] * rn * fg[1], y[4 * q + 2] * rn * fg[2], y[4 * q + 3] * rn * fg[3]}; }
    }
}
__device__ __forceinline__ void row_to_fp8(const float* src, unsigned char* dst, float* scale_out, int lane) {
    float v[16]; float mx = 0.f;
#pragma unroll
    for (int q = 0; q < 4; ++q) { const f32x4_t a = *(const f32x4_t*)(src + 16 * lane + 4 * q); v[4 * q] = a[0]; v[4 * q + 1] = a[1]; v[4 * q + 2] = a[2]; v[4 * q + 3] = a[3]; }
#pragma unroll
    for (int i = 0; i < 16; ++i) mx = fmaxf(mx, fabsf(v[i]));
#pragma unroll
    for (int o = 1; o < 64; o <<= 1) mx = fmaxf(mx, __shfl_xor(mx, o));
    const float sc = mx > 0.f ? 384.0f / mx : 1.0f;
    u32x4_t w;
#pragma unroll
    for (int q = 0; q < 4; ++q) { int t = 0; t = __builtin_amdgcn_cvt_pk_fp8_f32(v[4 * q] * sc, v[4 * q + 1] * sc, t, false); t = __builtin_amdgcn_cvt_pk_fp8_f32(v[4 * q + 2] * sc, v[4 * q + 3] * sc, t, true); w[q] = (unsigned)t; }
    *(u32x4_t*)(dst + 16 * lane) = w;
    if (lane == 0) *scale_out = mx > 0.f ? mx / 384.0f : 1.0f;
}
}

constexpr int LDS_MISC = 131072, LDS_BYTES = 131072 + 64;
constexpr int CW_BAR = 4096;
#ifndef REPMASK
#define REPMASK 0u
#endif
#define NREP(k) ((((REPMASK) >> (k)) & 1u) ? 2 : 1)
#define DBG_BASE 0
#ifndef ATM
#define ATM 7
#endif
#ifndef MK_N_LAUNCHES
#define MK_N_LAUNCHES 1
#endif
constexpr int N_PHASES = 2 + 7 * DEPTH;

struct Args { const float* in[19]; float* out; unsigned char* ws; int ph_lo, ph_hi; };
enum { I_X = 0, I_C, I_N1G, I_N2G, I_WADA, I_BADA, I_WIN, I_WOUT, I_LQ1, I_LK1, I_LQ2, I_LK2, I_SUBG, I_SINK, I_PWQ, I_PKEYS, I_PU, I_PV, I_FG };

__device__ __forceinline__ void p0_transpose_item(const float* W, int K, int N, bf16_t* WT, LAS float* scr, int item, int lane) {
    const int nblk = N / 32, kb = item / nblk, nb = item % nblk, k0 = 64 * kb, n0 = 32 * nb;
#pragma unroll 8
    for (int i = 0; i < 32; ++i) { const int kk = 2 * i + (lane >> 5); scr[kk * 33 + (lane & 31)] = W[(size_t)(k0 + kk) * N + n0 + (lane & 31)]; }
    asm volatile("s_waitcnt lgkmcnt(0)" ::: "memory");
    const int c = lane & 7;
#pragma unroll
    for (int j = 0; j < 4; ++j) { const int n = (lane >> 3) + 8 * j; const LAS float* s = scr + (8 * c) * 33 + n;
        u32x4_t o; o.x = pk2(s[0 * 33], s[1 * 33]); o.y = pk2(s[2 * 33], s[3 * 33]); o.z = pk2(s[4 * 33], s[5 * 33]); o.w = pk2(s[6 * 33], s[7 * 33]);
        *(u32x4_t*)(WT + (size_t)(n0 + n) * K + k0 + 8 * c) = o; }
    asm volatile("s_waitcnt lgkmcnt(0)" ::: "memory");
}
__device__ __forceinline__ void cvt_rows(const float* src, bf16_t* dst, size_t n, size_t gtid, size_t gthreads) {
    for (size_t i = gtid * 8; i < n; i += gthreads * 8) {
        const f32x4_t a = *(const f32x4_t*)(src + i), c = *(const f32x4_t*)(src + i + 4);
        u32x4_t o; o.x = pk2(a[0], a[1]); o.y = pk2(a[2], a[3]); o.z = pk2(c[0], c[1]); o.w = pk2(c[2], c[3]);
        *(u32x4_t*)(dst + i) = o;
    }
}
__device__ __forceinline__ void build_table(LAS float* tab, const float* gvec, const float* mod_l, int sh_idx, int sc_idx) {
    for (int i = threadIdx.x; i < 4096; i += NTHREADS) { const int b = i >> 10, k = i & 1023;
        tab[(b * 2 + 0) * 1024 + k] = gvec[k] * (1.0f + mod_l[b * 6144 + sc_idx * 1024 + k]);
        tab[(b * 2 + 1) * 1024 + k] = mod_l[b * 6144 + sh_idx * 1024 + k]; }
}
__device__ __forceinline__ void norm_row(const float* xrow, bf16_t* orow, const LAS float* tab, int b, int lane) {
    const f32x4_t* xr = (const f32x4_t*)xrow + lane;
    f32x4_t v[4]; float s = 0.f;
#pragma unroll
    for (int j = 0; j < 4; ++j) { v[j] = xr[64 * j]; s += (v[j][0] * v[j][0] + v[j][1] * v[j][1]) + (v[j][2] * v[j][2] + v[j][3] * v[j][3]); }
    const float rstd = 1.0f / sqrtf(wave_sum(s) * (1.0f / DM) + EPS);
    unsigned long long* o8 = (unsigned long long*)orow + lane;
#pragma unroll
    for (int j = 0; j < 4; ++j) { const int k = 4 * lane + 256 * j;
        const f32x4_t g = *(const LAS f32x4_t*)(tab + (b * 2 + 0) * 1024 + k), sh = *(const LAS f32x4_t*)(tab + (b * 2 + 1) * 1024 + k);
        const f32x4_t y = v[j] * rstd * g + sh;
        o8[64 * j] = (unsigned long long)pk2(y[0], y[1]) | ((unsigned long long)pk2(y[2], y[3]) << 32); }
}

__global__ void __launch_bounds__(NTHREADS, 2) hymba_fwd(Args args) {
    extern __shared__ __attribute__((aligned(16))) unsigned char lds_raw[];
    LAS unsigned char* lds = (LAS unsigned char*)lds_raw;
    cg::grid_group grid = cg::this_grid();
    const int tid = threadIdx.x;
    const int wave = __builtin_amdgcn_readfirstlane(tid >> 6);
    const int G = gridDim.x, bx = blockIdx.x;
    const int gw = bx * NWAVES + wave, NGW = G * NWAVES;
    const int lo = args.ph_lo, hi_ = args.ph_hi;
#ifndef PHMASK
#define PHMASK 0xffffu
#endif
#define IN(k) (((PHMASK >> ((k) < 2 ? (k) : 2 + ((k) - 2) % 7)) & 1u) && lo <= (k) && (k) < hi_)
    if (tid < 16) ((volatile LAS unsigned*)(lds + LDS_MISC))[tid] = 0u;
    __syncthreads();
    (void)xcd_barrier_post((unsigned*)(args.ws + WS_CTL) + CW_BAR, (volatile LAS unsigned*)(lds + LDS_MISC));
#define SEAM(k) do { if (IN(k) && IN((k) + 1)) { if ((k) == 0) grid.sync(); else { XcdBarrier xb_; { unsigned char* w_ = args.ws; asm volatile("" : "+s"(w_)); xb_.bar = (unsigned*)(w_ + WS_CTL) + CW_BAR; } xb_.x = xb_xcc_id(); xb_.st = (volatile LAS unsigned*)(lds + LDS_MISC); xcd_barrier(xb_); } } } while (0)
#define PHASE_BEGIN() unsigned char* ws = args.ws; asm volatile("" : "+s"(ws)); int lane; { int t_ = threadIdx.x; asm volatile("" : "+v"(t_)); lane = t_ & 63; } (void)lane; \
    bf16_t* Wt_in = (bf16_t*)(ws + WS_WIN); bf16_t* Wt_out = (bf16_t*)(ws + WS_WOUT); bf16_t* Wt_q = (bf16_t*)(ws + WS_WQ); bf16_t* keysb = (bf16_t*)(ws + WS_KEYS); \
    float* modf = (float*)(ws + WS_MOD); float* kmean = (float*)(ws + WS_KMEAN); float* scal = (float*)(ws + WS_SCAL); \
    unsigned char* U8 = ws + WS_U; unsigned char* V8 = ws + WS_V; bf16_t* Hb = (bf16_t*)(ws + WS_H); \
    float* Us = (float*)(ws + WS_SCAL + 65536); float* Vs = (float*)(ws + WS_SCAL + 65536 + 262144); \
    bf16_t* Pj = (bf16_t*)(ws + WS_PROJ); bf16_t* Qp = (bf16_t*)(ws + WS_PROJ); bf16_t* Ob = (bf16_t*)(ws + WS_O); \
    int* Eid = (int*)(ws + WS_O); float* Gw = (float*)(ws + WS_O + 16 * MiB); unsigned* ctl = (unsigned*)(ws + WS_CTL); \
    (void)Wt_in; (void)Wt_out; (void)Wt_q; (void)keysb; (void)modf; (void)kmean; (void)scal; (void)U8; (void)V8; (void)Hb; (void)Us; (void)Vs; (void)Pj; (void)Qp; (void)Ob; (void)Eid; (void)Gw; (void)ctl

    if (IN(0)) for (int rep = 0; rep < NREP(0); ++rep) {
        PHASE_BEGIN();
        if (bx < 192) {
            LAS float* cs = (LAS float*)lds;
            LAS float* red = (LAS float*)(lds + 16384);
            for (int i = tid; i < 4096; i += NTHREADS) { const float cv = args.in[I_C][i]; cs[i] = cv / (1.0f + __expf(-cv)); }
            __syncthreads();
            for (int it = bx; it < 192; it += G) {
                const int l = it / 96, n = (it % 96) * 64 + lane;
                const float* wp = args.in[I_WADA] + (size_t)l * DM * 6144 + n;
                float a0 = 0.f, a1 = 0.f, a2 = 0.f, a3 = 0.f;
#pragma unroll 8
                for (int k = wave * 128; k < wave * 128 + 128; ++k) { const float wv = wp[(size_t)k * 6144]; a0 += cs[k] * wv; a1 += cs[1024 + k] * wv; a2 += cs[2048 + k] * wv; a3 += cs[3072 + k] * wv; }
                red[(wave * 4 + 0) * 64 + lane] = a0; red[(wave * 4 + 1) * 64 + lane] = a1; red[(wave * 4 + 2) * 64 + lane] = a2; red[(wave * 4 + 3) * 64 + lane] = a3;
                __syncthreads();
                if (wave < 4) { float s = args.in[I_BADA][l * 6144 + n];
#pragma unroll
                    for (int w = 0; w < 8; ++w) s += red[(w * 4 + wave) * 64 + lane];
                    modf[((size_t)l * 4 + wave) * 6144 + n] = s; }
                __syncthreads();
            }
        }
        __syncthreads();
        {
            LAS float* scr = (LAS float*)(lds + wave * 16384);
            constexpr int I_IN = 16 * (INW / 32), I_OUT = 16 * (DM / 32), I_Q = 16 * (PQW / 32), PER_L = I_IN + I_OUT + I_Q;
            for (int it = gw; it < DEPTH * PER_L; it += NGW) {
                const int l = it / PER_L; int r = it % PER_L;
                if (r < I_IN) { p0_transpose_item(args.in[I_WIN] + (size_t)l * DM * INW, DM, INW, Wt_in + (size_t)l * INW * DM, scr, r, lane); continue; } r -= I_IN;
                if (r < I_OUT) { p0_transpose_item(args.in[I_WOUT] + (size_t)l * DM * DM, DM, DM, Wt_out + (size_t)l * DM * DM, scr, r, lane); continue; } r -= I_OUT;
                p0_transpose_item(args.in[I_PWQ] + (size_t)l * DM * PQW, DM, PQW, Wt_q + (size_t)l * PQW * DM, scr, r, lane);
            }
        }
        {
            const size_t gtid = (size_t)bx * NTHREADS + tid, gth = (size_t)G * NTHREADS;
            cvt_rows(args.in[I_PKEYS], keysb, (size_t)DEPTH * PHEADS * 2 * 128 * 128, gtid, gth);
            for (int r = gw; r < 2 * DEPTH * PNEXP; r += NGW) { const int tb = r / (DEPTH * PNEXP), rr = r % (DEPTH * PNEXP);
                peer::row_to_fp8(args.in[tb ? I_PV : I_PU] + (size_t)rr * DM, (tb ? V8 : U8) + (size_t)rr * DM, (tb ? Vs : Us) + rr, lane); }
            for (size_t i = gtid; i < (size_t)DEPTH * 4 * 6 * 32 * 64; i += gth) kmean[i] = 0.f;
            if (gtid < DEPTH) { const int l = (int)gtid; float s1 = 0.f, s2 = 0.f;
                for (int i = 0; i < 32; ++i) { s1 += args.in[I_LQ1][l * 32 + i] * args.in[I_LK1][l * 32 + i]; s2 += args.in[I_LQ2][l * 32 + i] * args.in[I_LK2][l * 32 + i]; }
                const float lam_init = 0.8f - 0.6f * expf(-0.3f * (float)l);
                scal[l * 4 + 0] = expf(s1) - expf(s2) + lam_init; scal[l * 4 + 1] = lam_init; }
        }
    }
    SEAM(0);
    if (IN(1)) for (int rep = 0; rep < NREP(1); ++rep) {
        PHASE_BEGIN();
        LAS float* tab = (LAS float*)lds;
        build_table(tab, args.in[I_N1G], modf, 0, 1);
        __syncthreads();
        for (int m = gw; m < TOK; m += NGW) norm_row(args.in[I_X] + (size_t)m * DM, Hb + (size_t)m * DM, tab, m >> 13, lane);
        __syncthreads();
    }
    SEAM(1);

#pragma unroll 1
    for (int l = 0; l < DEPTH; ++l) {
        const int P = 2 + 7 * l;
        if (IN(P + 0)) for (int rep = 0; rep < NREP(2); ++rep) {
            PHASE_BEGIN();
            pg8::Gemm g{Hb, Wt_in + (size_t)l * INW * DM, TOK, INW, DM}; pg8::StaticOrder S; S.init(TOK, INW, G, bx);
            pg8::EpiProj E{Pj, INW, kmean + (size_t)l * 4 * 6 * 32 * 64, rep == 0 ? OFF_KB : (1 << 28)};
            pg8::gemm_phase<pg8::EpiProj, pg8::StaticOrder, true, true>(lds, g, S, E);
        }
        SEAM(P + 0);
        if (IN(P + 1)) for (int rep = 0; rep < NREP(3); ++rep) {
            volatile LAS int* qw = (volatile LAS int*)(lds + att::A_END);
#define NEXT_UNIT(mode) int idx; { PHASE_BEGIN(); if (tid == 0) qw[0] = (int)atomicAdd(ctl + 64 * ((rep * DEPTH + l) * 4 + (mode)), 1u); __syncthreads(); idx = qw[0]; }
            if (ATM & 1) for (;;) {
                NEXT_UNIT(0); if (idx >= 512) break;
                PHASE_BEGIN();
                const int qb = 31 - idx / 16, j = idx % 16;
                att::attn_unit<0>(j >> 2, j & 3, qb, Pj, Ob, nullptr, scal[l * 4 + 0], scal[l * 4 + 1], args.in[I_SUBG] + l * 64, nullptr, lds);
            }
            __syncthreads();
            if (ATM & 2) for (;;) {
                NEXT_UNIT(1); if (idx >= 768) break;
                PHASE_BEGIN();
                const int qb = 31 - idx / 24, jj = idx % 24;
                att::attn_unit<1>(jj / 6, jj % 6, qb, Pj, Ob, kmean + (size_t)l * 4 * 6 * 32 * 64, 0.f, 0.f, nullptr, nullptr, lds);
            }
            __syncthreads();
            if (ATM & 4) for (;;) {
                NEXT_UNIT(2); if (idx >= 768) break;
                PHASE_BEGIN();
                const int qb = idx / 24, jj = idx % 24;
                att::attn_unit<2>(jj / 6, jj % 6, qb, Pj, Ob, nullptr, 0.f, 0.f, nullptr, args.in[I_SINK] + l * 6 + jj % 6, lds);
            }
            __syncthreads();
#undef NEXT_UNIT
        }
        SEAM(P + 1);
        if (IN(P + 2)) for (int rep = 0; rep < NREP(4); ++rep) {
            PHASE_BEGIN();
            pg8::Gemm g{Ob, Wt_out + (size_t)l * DM * DM, TOK, DM, DM}; pg8::StaticOrder S; S.init(TOK, DM, G, bx);
            pg8::EpiRes E{(l == 0) ? args.in[I_X] : (const float*)args.out, (rep + 1 < NREP(4)) ? (float*)(ws + WS_PROJ) : args.out, DM, modf + (size_t)l * 4 * 6144 + 2 * 1024, 6144};
            pg8::gemm_phase<pg8::EpiRes, pg8::StaticOrder, true, true>(lds, g, S, E);
        }
        SEAM(P + 2);
        if (IN(P + 3)) for (int rep = 0; rep < NREP(5); ++rep) {
            PHASE_BEGIN();
            LAS float* tab = (LAS float*)lds;
            build_table(tab, args.in[I_N2G] + l * DM, modf + (size_t)l * 4 * 6144, 3, 4);
            __syncthreads();
            for (int m = gw; m < TOK; m += NGW) norm_row(args.out + (size_t)m * DM, Hb + (size_t)m * DM, tab, m >> 13, lane);
            __syncthreads();
        }
        SEAM(P + 3);
        if (IN(P + 4)) for (int rep = 0; rep < NREP(6); ++rep) {
            PHASE_BEGIN();
            pg8::Gemm g{Hb, Wt_q + (size_t)l * PQW * DM, TOK, PQW, DM}; pg8::StaticOrder S; S.init(TOK, PQW, G, bx);
            pg8::EpiBf16Plain E{Qp, PQW};
            pg8::gemm_phase<pg8::EpiBf16Plain, pg8::StaticOrder, true, true>(lds, g, S, E);
        }
        SEAM(P + 4);
        if (IN(P + 5)) for (int rep = 0; rep < NREP(7); ++rep) {
            PHASE_BEGIN();
            for (int u = bx; u < (TOK / 256) * PHEADS; u += G) peer::pk_unit(u >> 3, u & 7, Qp, keysb + (size_t)l * PHEADS * 2 * 128 * 128, Eid, Gw, lds);
            __syncthreads();
        }
        SEAM(P + 5);
        if (IN(P + 6)) for (int rep = 0; rep < NREP(8); ++rep) {
            PHASE_BEGIN();
            LAS float* tab2 = (LAS float*)lds; LAS float* tabn = (LAS float*)(lds + 32768);
            const bool last = (l == DEPTH - 1);
            const float* mod_l = modf + (size_t)l * 4 * 6144;
            build_table(tab2, args.in[I_N2G] + l * DM, mod_l, 3, 4);
            if (!last) build_table(tabn, args.in[I_N1G] + (l + 1) * DM, mod_l + 4 * 6144, 0, 1);
            __syncthreads();
            float* dry = (float*)(ws + WS_PROJ);
            for (int m = gw; m < TOK; m += NGW)
                peer::pg_token(m, args.out, (rep + 1 < NREP(8)) ? dry : args.out, tab2, mod_l + 5 * 1024, 6144, Eid, Gw, U8 + (size_t)l * PNEXP * DM, V8 + (size_t)l * PNEXP * DM, Us + l * PNEXP, Vs + l * PNEXP,
                                last, tabn, args.in[I_FG], Hb, (rep + 1 < NREP(8)) ? dry : args.out, lane);
            __syncthreads();
        }
        if (l + 1 < DEPTH) SEAM(P + 6);
    }
#undef IN
#undef SEAM
}

#ifdef DBG
__global__ void dbg_chk16(const bf16_t* p, size_t n, unsigned* flag, unsigned bit) {
    bool bad = false;
    for (size_t i = (size_t)blockIdx.x * blockDim.x + threadIdx.x; i < n; i += (size_t)gridDim.x * blockDim.x) bad |= ((p[i] & 0x7f80u) == 0x7f80u);
    if (bad) atomicOr(flag, bit);
}
__global__ void dbg_chk32(const float* p, size_t n, unsigned* flag, unsigned bit) {
    bool bad = false;
    for (size_t i = (size_t)blockIdx.x * blockDim.x + threadIdx.x; i < n; i += (size_t)gridDim.x * blockDim.x) bad |= ((__builtin_bit_cast(unsigned, p[i]) & 0x7f800000u) == 0x7f800000u);
    if (bad) atomicOr(flag, bit);
}
__global__ void dbg_chk_o(const bf16_t* p, unsigned* flag) {
    unsigned bad = 0;
    for (size_t i = (size_t)blockIdx.x * blockDim.x + threadIdx.x; i < (size_t)TOK * DM; i += (size_t)gridDim.x * blockDim.x) {
        if ((p[i] & 0x7f80u) == 0x7f80u) { const int c = (int)(i & 1023); const int r = (int)((i >> 10) & 8191); bad |= (c < 256) ? 1u : (c < 640 ? 2u : 4u); if (r < 256) bad |= 8u; if ((r & 255) < 32) bad |= 16u; if (p[i] & 0x7fu) bad |= 32u; }
    }
    if (bad) atomicOr(flag, bad);
}
__global__ void dbg_fill(float* out, size_t n, const unsigned* flag) {
    const unsigned f = *flag; if (f == 0u) return;
    const float c = sqrtf((float)f);
    for (size_t i = (size_t)blockIdx.x * blockDim.x + threadIdx.x; i < n; i += (size_t)gridDim.x * blockDim.x) out[i] = c;
}
#endif
extern "C" void kernel_launch(void* const* d_in, const int* in_sizes, int n_in, void* d_out, int out_size, void* d_ws, size_t ws_size, hipStream_t stream) {
    static int grid = 0;
    if (grid == 0) {
        if (n_in != 19 || out_size != TOK * DM || ws_size < WS_END) { fprintf(stderr, "kernel_launch: unexpected shapes (n_in %d out %d ws %zu)\n", n_in, out_size, ws_size); grid = -1; return; }
        int dev = 0, cus = 0, per_cu = 0;
        hipGetDevice(&dev); hipDeviceGetAttribute(&cus, hipDeviceAttributeMultiprocessorCount, dev);
        hipFuncSetAttribute((const void*)hymba_fwd, hipFuncAttributeMaxDynamicSharedMemorySize, LDS_BYTES);
        hipOccupancyMaxActiveBlocksPerMultiprocessor(&per_cu, (const void*)hymba_fwd, NTHREADS, LDS_BYTES);
        (void)hipGetLastError();
        if (per_cu < 1) per_cu = 1;
        if (per_cu > 1) per_cu = 1;
        grid = cus * per_cu;
        if (grid <= 0) grid = 256;
    }
    if (grid < 0) return;
    hipMemsetAsync((char*)d_ws + WS_CTL, 0, CTL_ZERO_BYTES, stream);
    Args a{};
    for (int i = 0; i < 19; ++i) a.in[i] = (const float*)d_in[i];
    a.out = (float*)d_out; a.ws = (unsigned char*)d_ws;
#if MK_N_LAUNCHES == 1
    a.ph_lo = 0; a.ph_hi = N_PHASES;
    void* kargs[] = {&a};
    hipError_t e = hipLaunchCooperativeKernel((const void*)hymba_fwd, dim3(grid), dim3(NTHREADS), kargs, LDS_BYTES, stream);
    if (e != hipSuccess) fprintf(stderr, "cooperative launch failed: %s (grid %d)\n", hipGetErrorString(e), grid);
#else
    for (int p = 0; p < N_PHASES; ++p) { a.ph_lo = p; a.ph_hi = p + 1; hipLaunchKernelGGL(hymba_fwd, dim3(grid), dim3(NTHREADS), LDS_BYTES, stream, a);
#ifdef DBG
        unsigned* flag = (unsigned*)((char*)d_ws + WS_CTL); unsigned char* w = (unsigned char*)d_ws;
        const int base = DBG_BASE;
        if (p == 3) dbg_chk_o<<<1024, 256, 0, stream>>>((const bf16_t*)(w + WS_O), flag);
#endif
    }
#ifdef DBG
    dbg_fill<<<1024, 256, 0, stream>>>((float*)d_out, (size_t)TOK * DM, (const unsigned*)((char*)d_ws + WS_CTL));
#endif
#endif
}
```

```cpp
#include <hip/hip_runtime.h>
#include <hip/hip_cooperative_groups.h>
#include <cstdio>
#include <cstdint>
#include <cmath>
namespace cg = cooperative_groups;

constexpr int DM = 1024, NBATCH = 4, SEQ = 8192, DEPTH = 2, TOK = NBATCH * SEQ;
constexpr int INW = 2560, NMOD = 6;
constexpr int OFF_QA = 0, OFF_KA = 256, OFF_VA = 512, OFF_QB = 768, OFF_KB = 1152, OFF_VB = 1536, OFF_QC = 1920, OFF_KC = 2304, OFF_VC = 2432;
constexpr int PHEADS = 8, PQW = 2048, PNK = 128, PNEXP = 16384, PTOPK = 16;
constexpr float EPS = 1e-6f;
constexpr float LOG2E = 1.4426950408889634f;
constexpr int NWAVES = 8, NTHREADS = 512;

constexpr size_t MiB = 1u << 20;
constexpr size_t WS_CTL = 0, CTL_ZERO_BYTES = 64 * 1024;
constexpr size_t WS_WIN = 1 * MiB;
constexpr size_t WS_WOUT = 11 * MiB;
constexpr size_t WS_WQ = 15 * MiB;
constexpr size_t WS_KEYS = 23 * MiB;
constexpr size_t WS_MOD = 24 * MiB;
constexpr size_t WS_KMEAN = 24 * MiB + 256 * 1024;
constexpr size_t WS_SCAL = 25 * MiB;
constexpr size_t WS_U = 26 * MiB;
constexpr size_t WS_V = 58 * MiB;
constexpr size_t WS_H = 90 * MiB;
constexpr size_t WS_PROJ = 154 * MiB;
constexpr size_t WS_O = 314 * MiB;
constexpr size_t WS_PBUF = 378 * MiB;
constexpr size_t WS_ML = 474 * MiB;
constexpr size_t WS_RM = 480 * MiB;
constexpr size_t WS_END = 482 * MiB;

#define GAS __attribute__((address_space(1)))
#define LAS __attribute__((address_space(3)))
typedef unsigned short bf16_t;
typedef short bf16x8_t __attribute__((ext_vector_type(8)));
typedef short s16x4_t __attribute__((ext_vector_type(4)));
typedef float f32x4_t __attribute__((ext_vector_type(4)));
typedef float f32x16_t __attribute__((ext_vector_type(16)));
typedef unsigned u32x4_t __attribute__((ext_vector_type(4)));
typedef unsigned u32x2_t __attribute__((ext_vector_type(2)));

__device__ __forceinline__ unsigned f2bf(float f) { unsigned u = __builtin_bit_cast(unsigned, f); return (u + 0x7fffu + ((u >> 16) & 1u)) >> 16; }
__device__ __forceinline__ unsigned pk2(float lo, float hi) { return f2bf(lo) | (f2bf(hi) << 16); }
__device__ __forceinline__ float bf_lo(unsigned w) { return __builtin_bit_cast(float, w << 16); }
__device__ __forceinline__ float bf_hi(unsigned w) { return __builtin_bit_cast(float, w & 0xffff0000u); }
__device__ __forceinline__ float wave_sum(float v) {
#pragma unroll
    for (int o = 1; o < 64; o <<= 1) v += __shfl_xor(v, o);
    return v;
}
__device__ __forceinline__ float swap32_partner(float v, int) { return __shfl_xor(v, 32); }
__device__ __forceinline__ float alibi_slope(int i) { return exp2f(-0.5f * (float)(i + 1)); }

typedef GAS unsigned gu32;
#define RLX_AGENT __ATOMIC_RELAXED, __HIP_MEMORY_SCOPE_AGENT
#define XB_TMO      128
#define XB_XCNT(j)  (256  + 64 * (j))
#define XB_XSUB(j)  (1280 + 64 * (j))
#define XB_XGEN(j)  (2304 + 64 * (j))
#define XB_TOP      3328
#define XB_TOPGEN   3392
#define XCD_BAR_WORDS 3456
#define XB_SPIN_CAP (1u << 18)

__device__ __forceinline__ unsigned xb_ld(unsigned* p)              { return __hip_atomic_load(p, __ATOMIC_RELAXED, __HIP_MEMORY_SCOPE_AGENT); }
__device__ __forceinline__ unsigned xb_add(unsigned* p, unsigned v) { return __hip_atomic_fetch_add(p, v, __ATOMIC_RELAXED, __HIP_MEMORY_SCOPE_AGENT); }
__device__ __forceinline__ unsigned xb_xcc_id() { return (unsigned)__builtin_amdgcn_s_getreg((3 << 11) | 20) & 0xFu; }
#define XB_SPIN(cond, bar) do { unsigned _sp = 0; while (cond) { __builtin_amdgcn_s_sleep(1); \
    if ((++_sp & 255u) == 0u) { if (xb_ld(&(bar)[XB_TMO])) break; if (_sp > XB_SPIN_CAP) { atomicAdd(&(bar)[XB_TMO], 1u); break; } } } } while (0)

struct XcdBarrier {
    unsigned* bar; unsigned x;
    volatile LAS unsigned* st;
};

__device__ __forceinline__ XcdBarrier xcd_barrier_post(unsigned* bar, volatile LAS unsigned* st) {
    XcdBarrier b; b.bar = bar; b.x = xb_xcc_id(); b.st = st;
    if (threadIdx.x == 0) (void)xb_add(&bar[XB_XCNT(b.x)], 1u);
    return b;
}
__device__ __forceinline__ void xcd_barrier_complete(unsigned* bar, unsigned x, unsigned& nloc, unsigned& nx) {
    const unsigned G = gridDim.x * gridDim.y * gridDim.z;
    unsigned sum, cnt, mine, sp = 0u;
    for (;;) {
        sum = 0u; cnt = 0u; mine = 0u;
#pragma unroll
        for (unsigned j = 0; j < 16; ++j) { const unsigned c = xb_ld(&bar[XB_XCNT(j)]); sum += c; cnt += (c > 0u) ? 1u : 0u; mine = (j == x) ? c : mine; }
        if (sum == G) break;
        __builtin_amdgcn_s_sleep(1);
        if ((++sp & 255u) == 0u) { if (xb_ld(&bar[XB_TMO])) break; if (sp > XB_SPIN_CAP) { atomicAdd(&bar[XB_TMO], 1u); break; } }
    }
    nloc = mine > 0u ? mine : 1u; nx = cnt > 0u ? cnt : 1u;
}

__device__ __forceinline__ void xcd_barrier(const XcdBarrier& b) {
    asm volatile("s_waitcnt vmcnt(0)" ::: "memory");
    __syncthreads();
    if (threadIdx.x == 0) {
        unsigned* bar = b.bar;
        __builtin_amdgcn_s_waitcnt(0);
        unsigned nloc = b.st[0], nx = b.st[1];
        if (nloc == 0u) { xcd_barrier_complete(bar, b.x, nloc, nx); b.st[0] = nloc; b.st[1] = nx; }
        const unsigned old = xb_add(&bar[XB_XSUB(b.x)], 1u);
        const unsigned gen = old / nloc;
        if (old + 1u == (gen + 1u) * nloc) {
            __builtin_amdgcn_fence(__ATOMIC_RELEASE, "agent");
            asm volatile("s_waitcnt vmcnt(0)" ::: "memory");
            const unsigned og = xb_add(&bar[XB_TOP], 1u);
            const unsigned tg = og / nx;
            if (og + 1u == (tg + 1u) * nx) xb_add(&bar[XB_TOPGEN], 1u);
            else XB_SPIN(xb_ld(&bar[XB_TOPGEN]) == tg, bar);
            __builtin_amdgcn_fence(__ATOMIC_ACQUIRE, "agent");
            xb_add(&bar[XB_XGEN(b.x)], 1u);
            asm volatile("s_waitcnt vmcnt(0)" ::: "memory");
        } else {
            XB_SPIN(xb_ld(&bar[XB_XGEN(b.x)]) == gen, bar);
            __builtin_amdgcn_fence(__ATOMIC_ACQUIRE, "agent");
            asm volatile("s_waitcnt vmcnt(0)" ::: "memory");
        }
    }
    __syncthreads();
}

namespace pg8 {
#define PG8_LAS __attribute__((address_space(3)))
typedef unsigned short bf16_t;
typedef short bf16x8 __attribute__((ext_vector_type(8)));
typedef float f32x4 __attribute__((ext_vector_type(4)));
typedef unsigned u32x4 __attribute__((ext_vector_type(4)));
constexpr int BM = 256, BK = 64, HALF = 128, HTB = HALF * BK * 2  , STAGE_BYTES = 8 * HTB, NXCD = 8, WGM = 8;

__host__ __device__ __forceinline__ int lds_byte(int r, int c) { const int st = (r >> 4) * 2 + (c >> 5), rr = r & 15, cc = c & 31, ob = rr * 64 + cc * 2; return st * 1024 + (ob ^ (((ob >> 9) & 1) << 5)); }
__host__ __device__ __forceinline__ void stage_rc(int b, int& R, int& C) { const int st = b / 1024, sb = b % 1024, swz = sb ^ (((sb >> 9) & 1) << 5); R = (st >> 1) * 16 + swz / 64; C = (st & 1) * 32 + (swz % 64) / 2; }
__host__ __device__ __forceinline__ int perm32(int rho) { const int n = rho >> 4, i = rho & 15; return 8 * (i >> 2) + 4 * n + (i & 3); }

struct Unit { int pm, pn; };
struct Gemm { const bf16_t* A; const bf16_t* Bt; int M, N, K; };

struct StaticOrder {
    int nM, nN, nwg, G, c;
    __host__ __device__ void init(int M, int N, int G_, int c_) { nM = M / BM; nN = N / BM; nwg = nM * nN; G = G_; c = c_; }
    __host__ __device__ bool next(int i, Unit& u) const {
        const long L = (long)i * G + c; if (L >= nwg) return false;
        int wgid = (int)L; { const int q = nwg / NXCD, r = nwg % NXCD, xcd = wgid % NXCD, off = wgid / NXCD; wgid = (xcd < r ? xcd * (q + 1) : r * (q + 1) + (xcd - r) * q) + off; }
        const int nig = WGM * nN, gid = wgid / nig, fm = gid * WGM, gsz = (nM - fm) < WGM ? (nM - fm) : WGM;
        u.pm = fm + ((wgid % nig) % gsz); u.pn = (wgid % nig) / gsz; return true;
    }
    __device__ __forceinline__ void a_ready(const Unit&) const {}
    __device__ __forceinline__ void done(const Unit&) const {}
};

__device__ __forceinline__ unsigned cvt_pk_bf16(float lo, float hi) { unsigned r; asm volatile("v_cvt_pk_bf16_f32 %0, %1, %2" : "=v"(r) : "v"(lo), "v"(hi)); return r; }
struct EpiBf16Plain {
    static constexpr bool PERM = true, AFTER_DRAIN = false;
    bf16_t* O; int ldc;
    __device__ __forceinline__ void operator()(const f32x4 (&acc)[2][2][4][2], const Unit& u, int wr, int wc, int fr, int fq) const {
        const int row0 = u.pm * BM + wr * 64 + fr, col0 = u.pn * BM + wc * 32 + 8 * fq;
#pragma unroll
        for (int ai = 0; ai < 2; ++ai)
#pragma unroll
            for (int m = 0; m < 4; ++m) { bf16_t* rowp = O + (size_t)(row0 + ai * HALF + m * 16) * ldc + col0;
#pragma unroll
                for (int bj = 0; bj < 2; ++bj) { const f32x4 v0 = acc[ai][bj][m][0], v1 = acc[ai][bj][m][1];
                    u32x4 w; w.x = cvt_pk_bf16(v0[0], v0[1]); w.y = cvt_pk_bf16(v0[2], v0[3]); w.z = cvt_pk_bf16(v1[0], v1[1]); w.w = cvt_pk_bf16(v1[2], v1[3]);
                    *(u32x4*)(rowp + bj * HALF) = w; } }
    }
};
struct EpiProj {
    static constexpr bool PERM = true, AFTER_DRAIN = false;
    bf16_t* O; int ldc; float* kmean; int kb_lo;
    __device__ __forceinline__ void operator()(const f32x4 (&acc)[2][2][4][2], const Unit& u, int wr, int wc, int fr, int fq) const {
        const int row0 = u.pm * BM + wr * 64 + fr, col0 = u.pn * BM + wc * 32 + 8 * fq;
#pragma unroll
        for (int ai = 0; ai < 2; ++ai)
#pragma unroll
            for (int m = 0; m < 4; ++m) { bf16_t* rowp = O + (size_t)(row0 + ai * HALF + m * 16) * ldc + col0;
#pragma unroll
                for (int bj = 0; bj < 2; ++bj) { const f32x4 v0 = acc[ai][bj][m][0], v1 = acc[ai][bj][m][1];
                    u32x4 w; w.x = cvt_pk_bf16(v0[0], v0[1]); w.y = cvt_pk_bf16(v0[2], v0[3]); w.z = cvt_pk_bf16(v1[0], v1[1]); w.w = cvt_pk_bf16(v1[2], v1[3]);
                    *(u32x4*)(rowp + bj * HALF) = w; } }
#pragma unroll
        for (int bj = 0; bj < 2; ++bj) {
            const int cb = u.pn * BM + bj * HALF;
            if (cb >= kb_lo && cb < kb_lo + 384) {
                f32x4 s0 = {0.f, 0.f, 0.f, 0.f}, s1 = {0.f, 0.f, 0.f, 0.f};
#pragma unroll
                for (int ai = 0; ai < 2; ++ai)
#pragma unroll
                    for (int m = 0; m < 4; ++m) { s0 += acc[ai][bj][m][0]; s1 += acc[ai][bj][m][1]; }
#pragma unroll
                for (int i = 0; i < 4; ++i) {
#pragma unroll
                    for (int o = 1; o < 16; o <<= 1) { s0[i] += __shfl_xor(s0[i], o); s1[i] += __shfl_xor(s1[i], o); }
                }
                if (fr == 0) {
                    const int c = cb + wc * 32 + 8 * fq - kb_lo, h = c >> 6, d = c & 63, b = u.pm >> 5, nb = u.pm & 31;
                    float* kp = kmean + ((size_t)((b * 6 + h) * 32 + nb)) * 64 + d;
#pragma unroll
                    for (int i = 0; i < 4; ++i) { atomicAdd(kp + i, s0[i]); atomicAdd(kp + 4 + i, s1[i]); }
                }
            }
        }
    }
};
struct EpiRes {
    static constexpr bool PERM = false, AFTER_DRAIN = false;
    const float* base; float* out; int ldc; const float* gate; int gstride;
    __device__ __forceinline__ void operator()(const f32x4 (&acc)[2][2][4][2], const Unit& u, int wr, int wc, int fr, int fq) const {
        const int row0 = u.pm * BM + wr * 64 + fr, col0 = u.pn * BM + wc * 32 + 4 * fq;
        const float* gp = gate + (size_t)(u.pm >> 5) * gstride + col0;
        f32x4 gv[2][2];
#pragma unroll
        for (int bj = 0; bj < 2; ++bj)
#pragma unroll
            for (int n = 0; n < 2; ++n) gv[bj][n] = *(const f32x4*)(gp + bj * HALF + n * 16);
#pragma unroll
        for (int ai = 0; ai < 2; ++ai)
#pragma unroll
            for (int m = 0; m < 4; ++m) { const size_t off = (size_t)(row0 + ai * HALF + m * 16) * ldc + col0;
#pragma unroll
                for (int bj = 0; bj < 2; ++bj)
#pragma unroll
                    for (int n = 0; n < 2; ++n) { const f32x4 bs = *(const f32x4*)(base + off + bj * HALF + n * 16);
                        *(f32x4*)(out + off + bj * HALF + n * 16) = bs + gv[bj][n] * acc[ai][bj][m][n]; } }
    }
};

template <class Epi, class Sched, bool ALIGN_EPI = false, bool SP2 = false>
__device__ __forceinline__ void gemm_phase(PG8_LAS unsigned char* lds, const Gemm g, const Sched& S, const Epi& E) {
    int tid_ = threadIdx.x; asm volatile("" : "+v"(tid_));
    const int tid = tid_, wid = __builtin_amdgcn_readfirstlane(tid >> 6), lane = tid & 63, wr = wid >> 2, wc = wid & 3, fr = lane & 15, fq = lane >> 4;
    const int K = g.K, nt = K / BK;
    unsigned voffA[2], voffB[2];
#pragma unroll
    for (int i = 0; i < 2; ++i) { int R, C; stage_rc(tid * 16 + i * 8192, R, C); const int Rb = Epi::PERM ? ((R & ~31) + perm32(R & 31)) : R;
        voffA[i] = (unsigned)(R * K + C) * 2u; voffB[i] = (unsigned)(Rb * K + C) * 2u; }
    const size_t kstep = (size_t)(BK * 2);
    const size_t hstep = (size_t)HALF * K * 2;
    const size_t tstep = 2 * hstep;
    const unsigned ldsw = (unsigned)wid * 1024u;
    const int aoff = lds_byte(wr * 64 + fr, fq * 8), boff = lds_byte(wc * 32 + fr, fq * 8);
#define PG8_SA(b, h) (((b) * 2 + (h)) * HTB)
#define PG8_SB(b, h) ((4 + (b) * 2 + (h)) * HTB)
#define PG8_STAGE(bufoff, gbase, voff) do { _Pragma("unroll") for (int _i = 0; _i < 2; ++_i) \
        __builtin_amdgcn_global_load_lds((const unsigned*)((const char*)(gbase) + (voff)[_i]), (PG8_LAS unsigned*)(lds + (bufoff) + ldsw + _i * 8192), 16, 0, 0); } while (0)
#define PG8_LDA(dst, b, h) do { _Pragma("unroll") for (int m = 0; m < 4; ++m) _Pragma("unroll") for (int k = 0; k < 2; ++k) dst[m][k] = *(const PG8_LAS bf16x8*)(lds + PG8_SA(b, h) + aoff + m * 2048 + k * 1024); } while (0)
#define PG8_LDB(dst, b, h) do { _Pragma("unroll") for (int n = 0; n < 2; ++n) _Pragma("unroll") for (int k = 0; k < 2; ++k) dst[n][k] = *(const PG8_LAS bf16x8*)(lds + PG8_SB(b, h) + boff + n * 2048 + k * 1024); } while (0)
#define PG8_MMA(ai, bj, At, Bt) do { __builtin_amdgcn_s_setprio(1); _Pragma("unroll") for (int m = 0; m < 4; ++m) _Pragma("unroll") for (int n = 0; n < 2; ++n) _Pragma("unroll") for (int k = 0; k < 2; ++k) \
        acc[ai][bj][m][n] = __builtin_amdgcn_mfma_f32_16x16x32_bf16(Bt[n][k], At[m][k], acc[ai][bj][m][n], 0, 0, 0); __builtin_amdgcn_s_setprio(0); } while (0)
#define PG8_WAIT_V(n) asm volatile("s_waitcnt vmcnt(" #n ")" ::: "memory")
#define PG8_WAIT_L(n) asm volatile("s_waitcnt lgkmcnt(" #n ")" ::: "memory")
#define PG8_BAR __builtin_amdgcn_s_barrier()
#define PG8_SCHED __builtin_amdgcn_sched_barrier(0)
    Unit cur, nxt; int ui = 0;
    if (!S.next(0, cur)) return;
    f32x4 acc[2][2][4][2];
#pragma unroll
    for (int a = 0; a < 2; ++a)
#pragma unroll
        for (int b = 0; b < 2; ++b)
#pragma unroll
            for (int m = 0; m < 4; ++m)
#pragma unroll
                for (int n = 0; n < 2; ++n) acc[a][b][m][n] = (f32x4){0.f, 0.f, 0.f, 0.f};
    bf16x8 At[4][2], B0[2][2], B1[2][2];
    const char* cA = (const char*)g.A + (size_t)cur.pm * tstep; const char* cB = (const char*)g.Bt + (size_t)cur.pn * tstep;
    S.a_ready(cur);
    if constexpr (SP2) {
        PG8_STAGE(PG8_SB(0, 0), cB, voffB); PG8_STAGE(PG8_SB(0, 1), cB + hstep, voffB); PG8_STAGE(PG8_SA(0, 0), cA, voffA); PG8_STAGE(PG8_SA(0, 1), cA + hstep, voffA);
        if (wr == 1) PG8_BAR;
        PG8_WAIT_V(2); PG8_BAR;
        PG8_STAGE(PG8_SB(1, 0), cB + kstep, voffB); PG8_STAGE(PG8_SA(1, 0), cA + kstep, voffA); PG8_STAGE(PG8_SB(1, 1), cB + hstep + kstep, voffB);
        PG8_WAIT_V(6); PG8_BAR;
    } else {
        PG8_STAGE(PG8_SB(0, 0), cB, voffB); PG8_STAGE(PG8_SA(0, 0), cA, voffA); PG8_STAGE(PG8_SB(0, 1), cB + hstep, voffB); PG8_STAGE(PG8_SA(0, 1), cA + hstep, voffA);
        if (wr == 1) PG8_BAR;
        PG8_WAIT_V(4); PG8_BAR;
        PG8_STAGE(PG8_SB(1, 0), cB + kstep, voffB); PG8_STAGE(PG8_SA(1, 0), cA + kstep, voffA); PG8_STAGE(PG8_SB(1, 1), cB + hstep + kstep, voffB);
        PG8_WAIT_V(6); PG8_BAR;
    }
    for (;;) {
        const bool has_next = S.next(ui + 1, nxt);
        const char* nA = has_next ? (const char*)g.A + (size_t)nxt.pm * tstep : cA; const char* nB = has_next ? (const char*)g.Bt + (size_t)nxt.pn * tstep : cB;
        for (int t = 0; t < nt; t += 2) {
            const bool last = (t == nt - 2);
            const char* a1 = cA + (size_t)(t + 1) * kstep;
            const char* a2 = last ? nA : cA + (size_t)(t + 2) * kstep; const char* b2 = last ? nB : cB + (size_t)(t + 2) * kstep;
            const char* a3 = a2 + kstep; const char* b3 = b2 + kstep;
            if (last && has_next) S.a_ready(nxt);
            if constexpr (SP2) {
            PG8_LDB(B0, 0, 0); PG8_LDB(B1, 0, 1); PG8_SCHED; PG8_LDA(At, 0, 0); PG8_STAGE(PG8_SA(1, 1), a1 + hstep, voffA);
            PG8_WAIT_V(8); PG8_WAIT_L(0); PG8_BAR; PG8_MMA(0, 0, At, B0); PG8_MMA(0, 1, At, B1); PG8_BAR; PG8_SCHED;
            PG8_LDA(At, 0, 1); PG8_STAGE(PG8_SB(0, 0), b2, voffB); PG8_STAGE(PG8_SB(0, 1), b2 + hstep, voffB); PG8_STAGE(PG8_SA(0, 0), a2, voffA);
            PG8_WAIT_V(8); PG8_WAIT_L(0); PG8_BAR; PG8_MMA(1, 0, At, B0); PG8_MMA(1, 1, At, B1); PG8_BAR; PG8_SCHED;
            PG8_LDB(B0, 1, 0); PG8_LDB(B1, 1, 1); PG8_SCHED; PG8_LDA(At, 1, 0); PG8_STAGE(PG8_SA(0, 1), a2 + hstep, voffA);
            PG8_WAIT_V(8); PG8_WAIT_L(0); PG8_BAR; PG8_MMA(0, 0, At, B0); PG8_MMA(0, 1, At, B1); PG8_BAR; PG8_SCHED;
            PG8_LDA(At, 1, 1); PG8_STAGE(PG8_SB(1, 0), b3, voffB); PG8_STAGE(PG8_SB(1, 1), b3 + hstep, voffB); PG8_STAGE(PG8_SA(1, 0), a3, voffA);
            PG8_WAIT_V(8); PG8_WAIT_L(0); PG8_BAR; PG8_MMA(1, 0, At, B0); PG8_MMA(1, 1, At, B1); PG8_BAR; PG8_SCHED;
            } else {
            PG8_LDB(B0, 0, 0); PG8_SCHED; PG8_LDA(At, 0, 0); PG8_STAGE(PG8_SA(1, 1), a1 + hstep, voffA);
            PG8_WAIT_L(8); PG8_BAR; PG8_WAIT_L(0); PG8_MMA(0, 0, At, B0); PG8_BAR; PG8_SCHED;
            PG8_LDB(B1, 0, 1); PG8_STAGE(PG8_SB(0, 0), b2, voffB);
            PG8_BAR; PG8_WAIT_L(0); PG8_MMA(0, 1, At, B1); PG8_BAR;
            PG8_LDA(At, 0, 1); PG8_STAGE(PG8_SA(0, 0), a2, voffA);
            PG8_BAR; PG8_WAIT_L(0); PG8_MMA(1, 0, At, B0); PG8_BAR; PG8_SCHED;
            PG8_STAGE(PG8_SB(0, 1), b2 + hstep, voffB);
            PG8_WAIT_V(6); PG8_BAR; PG8_MMA(1, 1, At, B1); PG8_BAR;
            PG8_LDB(B0, 1, 0); PG8_SCHED; PG8_LDA(At, 1, 0); PG8_STAGE(PG8_SA(0, 1), a2 + hstep, voffA);
            PG8_WAIT_L(8); PG8_BAR; PG8_WAIT_L(0); PG8_MMA(0, 0, At, B0); PG8_BAR; PG8_SCHED;
            PG8_LDB(B1, 1, 1); PG8_STAGE(PG8_SB(1, 0), b3, voffB);
            PG8_BAR; PG8_WAIT_L(0); PG8_MMA(0, 1, At, B1); PG8_BAR;
            PG8_LDA(At, 1, 1); PG8_STAGE(PG8_SA(1, 0), a3, voffA);
            PG8_BAR; PG8_WAIT_L(0); PG8_MMA(1, 0, At, B0); PG8_BAR; PG8_SCHED;
            PG8_STAGE(PG8_SB(1, 1), b3 + hstep, voffB);
            PG8_WAIT_V(6); PG8_BAR; PG8_MMA(1, 1, At, B1); PG8_BAR;
            }
        }
        if constexpr (ALIGN_EPI) { if (wr == 0) PG8_BAR; }
        if constexpr (!Epi::AFTER_DRAIN) { E(acc, cur, wr, wc, fr, fq); S.done(cur); }
        if (!has_next) break;
#pragma unroll
        for (int a = 0; a < 2; ++a)
#pragma unroll
            for (int b = 0; b < 2; ++b)
#pragma unroll
                for (int m = 0; m < 4; ++m)
#pragma unroll
                    for (int n = 0; n < 2; ++n) acc[a][b][m][n] = (f32x4){0.f, 0.f, 0.f, 0.f};
        cur = nxt; cA = nA; cB = nB; ++ui;
        if constexpr (ALIGN_EPI) { if (wr == 1) PG8_BAR; }
    }
    PG8_WAIT_V(0);
    if constexpr (!ALIGN_EPI) { if (wr == 0) PG8_BAR; }
    PG8_BAR;
    if constexpr (Epi::AFTER_DRAIN) { E.fused(acc, cur, wr, wc, fr, fq, lds, wid, lane); S.done(cur); }
#undef PG8_SA
#undef PG8_SB
#undef PG8_STAGE
#undef PG8_LDA
#undef PG8_LDB
#undef PG8_MMA
#undef PG8_WAIT_V
#undef PG8_WAIT_L
#undef PG8_BAR
#undef PG8_SCHED
}
}
namespace att {
constexpr int A_K = 0, A_V = 16384, A_WSF = 32768, A_KM = A_WSF + 2048, A_STG = A_KM + 8192;
constexpr int STG_STRIDE = 68, STG_WAVE_BYTES = 32 * STG_STRIDE * 4, A_END = A_STG + NWAVES * STG_WAVE_BYTES;
__device__ __forceinline__ int crow(int r, int hi) { return (r & 3) + 8 * (r >> 2) + 4 * hi; }
__device__ __forceinline__ void dma16(const void* g, LAS unsigned char* l) { __builtin_amdgcn_global_load_lds((const unsigned*)g, (LAS unsigned*)l, 16, 0, 0); }
typedef float f32x2_t __attribute__((ext_vector_type(2))); typedef __bf16 bf16x2_t __attribute__((ext_vector_type(2)));
__device__ __forceinline__ unsigned cvtpk(float lo, float hi) { f32x2_t v = {lo, hi}; bf16x2_t b = __builtin_convertvector(v, bf16x2_t); return __builtin_bit_cast(unsigned, b); }
typedef short v4i16_t __attribute__((ext_vector_type(4)));
__device__ __forceinline__ s16x4_t vtr(LAS const unsigned char* p) { return __builtin_bit_cast(s16x4_t, __builtin_amdgcn_ds_read_tr16_b64_v4i16((LAS v4i16_t*)p)); }
#define LDSW() asm volatile("s_waitcnt lgkmcnt(0)" ::: "memory")

template <int MODE>
__device__ __forceinline__ void attn_unit(int b, int h, int qb, const bf16_t* __restrict__ proj, bf16_t* __restrict__ Obuf, const float* __restrict__ kmean,
                                          float lam, float lam_init, const float* __restrict__ subg, const float* sinkp, LAS unsigned char* lds) {
    constexpr int NMAP = (MODE == 0) ? 2 : 1;
    int tid_ = threadIdx.x; asm volatile("" : "+v"(tid_));
    const int tid = tid_, lane = tid & 63, r32 = lane & 31, hi = lane >> 5;
    const int wid = __builtin_amdgcn_readfirstlane(tid >> 6);
    const int q0 = qb * 256;
    int qcol, kcol, vcol, ocol; float slope;
    if (MODE == 0) { qcol = OFF_QA + h * 64; kcol = OFF_KA + h * 64; vcol = OFF_VA + h * 64; ocol = h * 64; slope = alibi_slope(6 + h); }
    else if (MODE == 1) { qcol = OFF_QB + h * 64; kcol = OFF_KB + h * 64; vcol = OFF_VB + h * 64; ocol = 256 + h * 64; slope = alibi_slope(10 + h); }
    else { qcol = OFF_QC + h * 64; kcol = OFF_KC + (h / 3) * 64; vcol = OFF_VC + (h / 3) * 64; ocol = 640 + h * 64; slope = alibi_slope(h); }
    const float slope2 = slope * LOG2E;
    const float cscale = (MODE == 0 ? 0.17677669529663687f : 0.125f) * LOG2E;
    const bf16_t* base = proj + (size_t)b * SEQ * INW;
    const int t_hi = 4 * qb + 4, t_lo = (MODE == 2) ? (qb > 0 ? 4 * qb - 2 : 0) : 0;
    const bf16_t* ksrc = base + kcol + (size_t)lane * INW + wid * 8;
    const bf16_t* vsrc = base + vcol + (size_t)(16 * (wid & 3) + (lane >> 2)) * INW + (wid >> 2) * 32 + (lane & 3) * 8;
#define DMA_TILE(t, bufi) do { dma16(ksrc + (size_t)(t) * 64 * INW, lds + A_K + (bufi) * 8192 + wid * 1024); dma16(vsrc + (size_t)(t) * 64 * INW, lds + A_V + (bufi) * 8192 + wid * 1024); } while (0)
    DMA_TILE(t_lo, 0);
    const bf16_t* Qw = base + (size_t)(q0 + wid * 32 + r32) * INW + qcol;
    bf16x8_t qr[4];
#pragma unroll
    for (int d0 = 0; d0 < 4; ++d0) qr[d0] = *(const bf16x8_t*)(Qw + d0 * 16 + hi * 8);
    const int qrel = wid * 32 + r32;
    const LAS unsigned char* qlds = lds + A_STG + wid * STG_WAVE_BYTES + lane * 16;
    if (MODE == 0) {
#pragma unroll
        for (int d0 = 0; d0 < 4; ++d0) *(LAS bf16x8_t*)(lds + A_STG + wid * STG_WAVE_BYTES + lane * 16 + d0 * 1024) = qr[d0];
    }
    unsigned rowmask = 0u;
    if (MODE == 1) {
        LAS float* km = (LAS float*)(lds + A_KM);
        const float* kmg = kmean + (size_t)((b * 6 + h) * 32) * 64;
        for (int i = tid; i < 2048; i += NTHREADS) km[i] = kmg[i] * (1.0f / 256.0f);
        __syncthreads();
        if (qb > 0) {
            float qf[32];
#pragma unroll
            for (int d0 = 0; d0 < 4; ++d0)
#pragma unroll
                for (int j = 0; j < 8; ++j) qf[d0 * 8 + j] = __builtin_bit_cast(float, ((unsigned)(unsigned short)qr[d0][j]) << 16);
            float v0 = -INFINITY, v1 = -INFINITY, v2 = -INFINITY; int i0 = 0, i1 = 0, i2 = 0;
            for (int n = 0; n < qb; ++n) {
                const LAS float* kp = km + n * 64 + 8 * hi;
                float part = 0.f;
#pragma unroll
                for (int d0 = 0; d0 < 4; ++d0) {
                    const f32x4_t a = *(const LAS f32x4_t*)(kp + d0 * 16), c = *(const LAS f32x4_t*)(kp + d0 * 16 + 4);
                    part += qf[d0 * 8 + 0] * a[0]; part += qf[d0 * 8 + 1] * a[1]; part += qf[d0 * 8 + 2] * a[2]; part += qf[d0 * 8 + 3] * a[3];
                    part += qf[d0 * 8 + 4] * c[0]; part += qf[d0 * 8 + 5] * c[1]; part += qf[d0 * 8 + 6] * c[2]; part += qf[d0 * 8 + 7] * c[3];
                }
                const float tot = part + swap32_partner(part, hi);
                if (tot > v0) { v2 = v1; i2 = i1; v1 = v0; i1 = i0; v0 = tot; i0 = n; }
                else if (tot > v1) { v2 = v1; i2 = i1; v1 = tot; i1 = n; }
                else if (tot > v2) { v2 = tot; i2 = n; }
            }
            if (v0 > -INFINITY) rowmask |= 1u << i0;
            if (v1 > -INFINITY) rowmask |= 1u << i1;
            if (v2 > -INFINITY) rowmask |= 1u << i2;
        }
    }
    float m_[NMAP], l_[NMAP]; f32x16_t o[NMAP][2];
#pragma unroll
    for (int mi = 0; mi < NMAP; ++mi) { m_[mi] = -INFINITY; l_[mi] = 0.f;
#pragma unroll
        for (int d0 = 0; d0 < 2; ++d0)
#pragma unroll
            for (int r = 0; r < 16; ++r) o[mi][d0][r] = 0.f; }
    LAS float* wsf = (LAS float*)(lds + A_WSF) + wid * 64;
    const int vlane = ((lane >> 4) & 1) * 32 + (lane & 3) * 8 + (4 * hi + ((lane & 15) >> 2)) * 64;

    for (int t = t_lo; t < t_hi; ++t) {
        const int bufi = (t - t_lo) & 1;
        asm volatile("s_waitcnt vmcnt(0)" ::: "memory");
        __syncthreads();
        if (t + 1 < t_hi) DMA_TILE(t + 1, bufi ^ 1);
        const int krel0 = 64 * t - q0;
        bool need = krel0 <= wid * 32 + 31;
        if (MODE == 2) need = need && (krel0 + 63 >= wid * 32 - 127);
        const bool past = (MODE == 1) && ((t >> 2) < qb);
        if (past) need = __any((int)((rowmask >> (t >> 2)) & 1u)) != 0;
        if (!need) continue;
        const bool diag = krel0 + 63 > wid * 32;
        const int kb = krel0 + 4 * hi;
        const LAS unsigned char* Ks = lds + A_K + bufi * 8192 + hi * 1024 + r32 * 16;
        const LAS unsigned char* Vs = lds + A_V + bufi * 8192 + vlane;
#pragma unroll
        for (int mi = 0; mi < NMAP; ++mi) {
            f32x16_t p0, p1;
#pragma unroll
            for (int r = 0; r < 16; ++r) { p0[r] = 0.f; p1[r] = 0.f; }
            constexpr int ND0 = (MODE == 0) ? 2 : 4;
#pragma unroll
            for (int dd = 0; dd < ND0; ++dd) {
                const int d0 = (MODE == 0) ? (2 * mi + dd) : dd;
                const bf16x8_t b0 = *(const LAS bf16x8_t*)(Ks + d0 * 2048);
                const bf16x8_t b1 = *(const LAS bf16x8_t*)(Ks + d0 * 2048 + 512);
                const bf16x8_t qa = (MODE == 0) ? *(const LAS bf16x8_t*)(qlds + d0 * 1024) : qr[d0];
                p0 = __builtin_amdgcn_mfma_f32_32x32x16_bf16(b0, qa, p0, 0, 0, 0);
                p1 = __builtin_amdgcn_mfma_f32_32x32x16_bf16(b1, qa, p1, 0, 0, 0);
            }
            float sl2 = slope2; asm volatile("" : "+v"(sl2));
            const float tb = sl2 * (float)kb;
#pragma unroll
            for (int r = 0; r < 16; ++r) { const int kk = (r & 3) + 8 * (r >> 2); const float bias = tb + sl2 * (float)kk;
                p0[r] = p0[r] * cscale + bias; p1[r] = p1[r] * cscale + (bias + sl2 * 32.0f); }
            if (diag) {
#pragma unroll
                for (int r = 0; r < 16; ++r) { const int kk = kb + (r & 3) + 8 * (r >> 2); if (kk > qrel) p0[r] = -INFINITY; if (kk + 32 > qrel) p1[r] = -INFINITY; }
            }
            if (MODE == 2) {
#pragma unroll
                for (int r = 0; r < 16; ++r) { const int kk = kb + (r & 3) + 8 * (r >> 2); if (qrel - kk >= 128) p0[r] = -INFINITY; if (qrel - (kk + 32) >= 128) p1[r] = -INFINITY; }
            }
            if (past) { if (!((rowmask >> (t >> 2)) & 1u)) {
#pragma unroll
                for (int r = 0; r < 16; ++r) { p0[r] = -INFINITY; p1[r] = -INFINITY; } } }
            float mx = fmaxf(p0[0], p1[0]);
#pragma unroll
            for (int r = 1; r < 16; ++r) mx = fmaxf(mx, fmaxf(p0[r], p1[r]));
            mx = fmaxf(mx, __shfl_xor(mx, 32));
            const float mnew = fmaxf(m_[mi], mx), msafe = (mnew == -INFINITY) ? 0.f : mnew;
            const float f = __builtin_amdgcn_exp2f(m_[mi] - msafe);
            float ps = 0.f;
#pragma unroll
            for (int r = 0; r < 16; ++r) { p0[r] = __builtin_amdgcn_exp2f(p0[r] - msafe); p1[r] = __builtin_amdgcn_exp2f(p1[r] - msafe); ps += p0[r] + p1[r]; }
            l_[mi] = l_[mi] * f + ps; m_[mi] = mnew;
            if (__any(f != 1.0f)) {
                if (hi == 0) wsf[mi * 32 + r32] = f;
                LDSW();
#pragma unroll
                for (int r = 0; r < 16; ++r) { const float fr_ = wsf[mi * 32 + crow(r, hi)]; o[mi][0][r] *= fr_; o[mi][1][r] *= fr_; }
            }
            u32x4_t pw[4];
#pragma unroll
            for (int j = 0; j < 4; ++j) { pw[0][j] = cvtpk(p0[2 * j], p0[2 * j + 1]); pw[1][j] = cvtpk(p0[8 + 2 * j], p0[8 + 2 * j + 1]);
                                          pw[2][j] = cvtpk(p1[2 * j], p1[2 * j + 1]); pw[3][j] = cvtpk(p1[8 + 2 * j], p1[8 + 2 * j + 1]); }
#pragma unroll
            for (int d0 = 0; d0 < 2; ++d0) {
                if (d0) __builtin_amdgcn_sched_barrier(0);
#pragma unroll
                for (int ks = 0; ks < 4; ++ks) {
                    const s16x4_t lo = vtr(Vs + d0 * 4096 + ks * 1024), hh = vtr(Vs + d0 * 4096 + ks * 1024 + 512);
                    const bf16x8_t vf = {lo[0], lo[1], lo[2], lo[3], hh[0], hh[1], hh[2], hh[3]};
                    o[mi][d0] = __builtin_amdgcn_mfma_f32_32x32x16_bf16(__builtin_bit_cast(bf16x8_t, pw[ks]), vf, o[mi][d0], 0, 0, 0);
                }
            }
            if (NMAP > 1) __builtin_amdgcn_sched_barrier(0);
        }
    }
#undef DMA_TILE
    float rl[NMAP][16];
#pragma unroll
    for (int mi = 0; mi < NMAP; ++mi) {
        float lt = l_[mi];
        lt += __shfl_xor(lt, 32);
        if (MODE == 2) lt += __builtin_amdgcn_exp2f(sinkp[0] * LOG2E + slope2 * (float)qrel - m_[mi]);
        if (hi == 0) wsf[mi * 32 + r32] = 1.0f / lt;
    }
    LDSW();
#pragma unroll
    for (int mi = 0; mi < NMAP; ++mi)
#pragma unroll
        for (int r = 0; r < 16; ++r) rl[mi][r] = wsf[mi * 32 + crow(r, hi)];
    LAS float* stg = (LAS float*)(lds + A_STG + wid * STG_WAVE_BYTES);
#pragma unroll
    for (int d0 = 0; d0 < 2; ++d0)
#pragma unroll
        for (int r = 0; r < 16; ++r) {
            float v = o[0][d0][r] * rl[0][r];
            if (MODE == 0) v -= lam * (o[NMAP - 1][d0][r] * rl[NMAP - 1][r]);
            stg[crow(r, hi) * STG_STRIDE + d0 * 32 + r32] = v;
        }
    LDSW();
    {
        const int row = lane >> 1, half = lane & 1;
        float v[32];
#pragma unroll
        for (int i = 0; i < 8; ++i) { const f32x4_t x = *(const LAS f32x4_t*)(stg + row * STG_STRIDE + half * 32 + i * 4); v[4 * i] = x[0]; v[4 * i + 1] = x[1]; v[4 * i + 2] = x[2]; v[4 * i + 3] = x[3]; }
        if (MODE == 0) {
            float ss = 0.f;
#pragma unroll
            for (int i = 0; i < 32; ++i) ss += v[i] * v[i];
            ss += __shfl_xor(ss, 1);
            const float rs = (1.0f / sqrtf(ss * (1.0f / 64.0f) + EPS)) * (1.0f - lam_init);
#pragma unroll
            for (int i = 0; i < 32; ++i) v[i] = v[i] * rs * subg[half * 32 + i];
        }
        bf16_t* op = Obuf + (size_t)(b * SEQ + q0 + wid * 32 + row) * DM + ocol + half * 32;
#pragma unroll
        for (int i = 0; i < 4; ++i) { u32x4_t w; w.x = cvtpk(v[8 * i], v[8 * i + 1]); w.y = cvtpk(v[8 * i + 2], v[8 * i + 3]); w.z = cvtpk(v[8 * i + 4], v[8 * i + 5]); w.w = cvtpk(v[8 * i + 6], v[8 * i + 7]);
            *(u32x4_t*)(op + 8 * i) = w; }
    }
    __syncthreads();
}
#undef LDSW
}

namespace att {
#define LDSW() asm volatile("s_waitcnt lgkmcnt(0)" ::: "memory")
__device__ __forceinline__ void gate_unit(int b, int h, int qb, const bf16_t* __restrict__ proj, const float* __restrict__ kmean, unsigned* __restrict__ RM, LAS unsigned char* lds) {
    int tid_ = threadIdx.x; asm volatile("" : "+v"(tid_));
    const int tid = tid_, lane = tid & 63, r32 = lane & 31, hi = lane >> 5;
    const int wid = __builtin_amdgcn_readfirstlane(tid >> 6);
    const int q0 = qb * 256;
    LAS float* km = (LAS float*)lds;
    const float* kmg = kmean + (size_t)((b * 6 + h) * 32) * 64;
    for (int i = tid; i < 2048; i += NTHREADS) km[i] = kmg[i] * (1.0f / 256.0f);
    __syncthreads();
    const bf16_t* Qw = proj + ((size_t)b * SEQ + q0 + wid * 32 + r32) * INW + OFF_QB + h * 64;
    float qf[32];
#pragma unroll
    for (int d0 = 0; d0 < 4; ++d0) { const bf16x8_t q = *(const bf16x8_t*)(Qw + d0 * 16 + hi * 8);
#pragma unroll
        for (int j = 0; j < 8; ++j) qf[d0 * 8 + j] = __builtin_bit_cast(float, ((unsigned)(unsigned short)q[j]) << 16); }
    float v0 = -INFINITY, v1 = -INFINITY, v2 = -INFINITY; int i0 = 0, i1 = 0, i2 = 0;
    for (int n = 0; n < qb; ++n) {
        const LAS float* kp = km + n * 64 + 8 * hi;
        float part = 0.f;
#pragma unroll
        for (int d0 = 0; d0 < 4; ++d0) {
            const f32x4_t a = *(const LAS f32x4_t*)(kp + d0 * 16), c = *(const LAS f32x4_t*)(kp + d0 * 16 + 4);
            part += qf[d0 * 8 + 0] * a[0]; part += qf[d0 * 8 + 1] * a[1]; part += qf[d0 * 8 + 2] * a[2]; part += qf[d0 * 8 + 3] * a[3];
            part += qf[d0 * 8 + 4] * c[0]; part += qf[d0 * 8 + 5] * c[1]; part += qf[d0 * 8 + 6] * c[2]; part += qf[d0 * 8 + 7] * c[3];
        }
        const float tot = part + __shfl_xor(part, 32);
        if (tot > v0) { v2 = v1; i2 = i1; v1 = v0; i1 = i0; v0 = tot; i0 = n; }
        else if (tot > v1) { v2 = v1; i2 = i1; v1 = tot; i1 = n; }
        else if (tot > v2) { v2 = tot; i2 = n; }
    }
    unsigned rowmask = 0u;
    if (v0 > -INFINITY) rowmask |= 1u << i0;
    if (v1 > -INFINITY) rowmask |= 1u << i1;
    if (v2 > -INFINITY) rowmask |= 1u << i2;
    if (hi == 0) RM[(size_t)(b * 6 + h) * SEQ + q0 + wid * 32 + r32] = rowmask;
    __syncthreads();
}

constexpr int B_K = 0, B_V = 32768, B_LIST = 65536, B_WSF = 81920, B_CNT = 83968, B_STG = 84032, B_STG_ROW = 72  , B_STG_WAVE = 32 * B_STG_ROW * 2;
__device__ __forceinline__ void moba_unit(int b, int h, int n, const bf16_t* __restrict__ proj, const unsigned* __restrict__ RM, bf16_t* __restrict__ Pbuf, float* __restrict__ ML, LAS unsigned char* lds) {
    int tid_ = threadIdx.x; asm volatile("" : "+v"(tid_));
    const int tid = tid_, lane = tid & 63, r32 = lane & 31, hi = lane >> 5;
    const int wid = __builtin_amdgcn_readfirstlane(tid >> 6);
    const float slope2 = alibi_slope(10 + h) * LOG2E, cscale = 0.125f * LOG2E;
    const bf16_t* base = proj + (size_t)b * SEQ * INW;
    {
        const bf16_t* ksrc = base + OFF_KB + h * 64 + (size_t)(256 * n + lane) * INW + wid * 8;
        const bf16_t* vsrc = base + OFF_VB + h * 64 + (size_t)(256 * n + 16 * (wid & 3) + (lane >> 2)) * INW + (wid >> 2) * 32 + (lane & 3) * 8;
#pragma unroll
        for (int tt = 0; tt < 4; ++tt) { dma16(ksrc + (size_t)tt * 64 * INW, lds + B_K + tt * 8192 + wid * 1024); dma16(vsrc + (size_t)tt * 64 * INW, lds + B_V + tt * 8192 + wid * 1024); }
    }
    volatile LAS int* cntp = (volatile LAS int*)(lds + B_CNT);
    LAS unsigned short* list = (LAS unsigned short*)(lds + B_LIST);
    if (tid == 0) cntp[0] = 0;
    __syncthreads();
    const unsigned* rm = RM + (size_t)(b * 6 + h) * SEQ;
    for (int s0 = 256 * (n + 1); s0 < SEQ; s0 += NTHREADS) {
        const int s = s0 + tid;
        const bool sel = (s < SEQ) && ((rm[s < SEQ ? s : 0] >> n) & 1u);
        const unsigned long long bal = __ballot(sel);
        if (bal) {
            const int total = __popcll(bal), prefix = __builtin_amdgcn_mbcnt_hi((unsigned)(bal >> 32), __builtin_amdgcn_mbcnt_lo((unsigned)bal, 0u));
            int wb = 0;
            if (lane == 0) wb = __hip_atomic_fetch_add((LAS int*)(lds + B_CNT), total, __ATOMIC_RELAXED, __HIP_MEMORY_SCOPE_WORKGROUP);
            wb = __builtin_amdgcn_readfirstlane(wb);
            if (sel) list[wb + prefix] = (unsigned short)s;
        }
    }
    asm volatile("s_waitcnt vmcnt(0)" ::: "memory");
    __syncthreads();
    const int C = cntp[0], NG = (C + 31) >> 5;
    LAS float* wsf = (LAS float*)(lds + B_WSF) + wid * 64;
    LAS unsigned short* stg = (LAS unsigned short*)(lds + B_STG + wid * B_STG_WAVE);
    const int vlane = ((lane >> 4) & 1) * 32 + (lane & 3) * 8 + (4 * hi + ((lane & 15) >> 2)) * 64;
    for (int item = wid; item < 8 + NG; item += 8) {
        const bool own = item < 8;
        int li = own ? 0 : 32 * (item - 8) + r32;
        const bool valid = own || (li < C);
        if (li >= C) li = C - 1;
        const int qidx = own ? (256 * n + 32 * item + r32) : (int)list[own ? 0 : li];
        const unsigned qmask = rm[qidx];
        const int slot = own ? 3 : __popc(qmask & ((1u << n) - 1u));
        const bf16_t* Qw = base + (size_t)qidx * INW + OFF_QB + h * 64;
        bf16x8_t qr[4];
#pragma unroll
        for (int d0 = 0; d0 < 4; ++d0) qr[d0] = *(const bf16x8_t*)(Qw + d0 * 16 + hi * 8);
        const int qrel = 32 * item + r32;
        float m_ = -INFINITY, l_ = 0.f; f32x16_t o[2];
#pragma unroll
        for (int d0 = 0; d0 < 2; ++d0)
#pragma unroll
            for (int r = 0; r < 16; ++r) o[d0][r] = 0.f;
        const int ntile = own ? ((32 * item + 31) / 64 + 1) : 4;
        for (int tt = 0; tt < ntile; ++tt) {
            const LAS unsigned char* Ks = lds + B_K + tt * 8192 + hi * 1024 + r32 * 16;
            const LAS unsigned char* Vs = lds + B_V + tt * 8192 + vlane;
            f32x16_t p0, p1;
#pragma unroll
            for (int r = 0; r < 16; ++r) { p0[r] = 0.f; p1[r] = 0.f; }
#pragma unroll
            for (int d0 = 0; d0 < 4; ++d0) {
                const bf16x8_t b0 = *(const LAS bf16x8_t*)(Ks + d0 * 2048);
                const bf16x8_t b1 = *(const LAS bf16x8_t*)(Ks + d0 * 2048 + 512);
                p0 = __builtin_amdgcn_mfma_f32_32x32x16_bf16(b0, qr[d0], p0, 0, 0, 0);
                p1 = __builtin_amdgcn_mfma_f32_32x32x16_bf16(b1, qr[d0], p1, 0, 0, 0);
            }
            float sl2 = slope2; asm volatile("" : "+v"(sl2));
            const int kb = 64 * tt + 4 * hi;
            const float tb = sl2 * (float)kb;
#pragma unroll
            for (int r = 0; r < 16; ++r) { const int kk = (r & 3) + 8 * (r >> 2); const float bias = tb + sl2 * (float)kk;
                p0[r] = p0[r] * cscale + bias; p1[r] = p1[r] * cscale + (bias + sl2 * 32.0f); }
            if (own && (64 * tt + 63 > 32 * item)) {
#pragma unroll
                for (int r = 0; r < 16; ++r) { const int kk = kb + (r & 3) + 8 * (r >> 2); if (kk > qrel) p0[r] = -INFINITY; if (kk + 32 > qrel) p1[r] = -INFINITY; }
            }
            float mx = fmaxf(p0[0], p1[0]);
#pragma unroll
            for (int r = 1; r < 16; ++r) mx = fmaxf(mx, fmaxf(p0[r], p1[r]));
            mx = fmaxf(mx, __shfl_xor(mx, 32));
            const float mnew = fmaxf(m_, mx), msafe = (mnew == -INFINITY) ? 0.f : mnew;
            const float f = __builtin_amdgcn_exp2f(m_ - msafe);
            float ps = 0.f;
#pragma unroll
            for (int r = 0; r < 16; ++r) { p0[r] = __builtin_amdgcn_exp2f(p0[r] - msafe); p1[r] = __builtin_amdgcn_exp2f(p1[r] - msafe); ps += p0[r] + p1[r]; }
            l_ = l_ * f + ps; m_ = mnew;
            if (__any(f != 1.0f)) {
                if (hi == 0) wsf[r32] = f;
                LDSW();
#pragma unroll
                for (int r = 0; r < 16; ++r) { const float fr_ = wsf[crow(r, hi)]; o[0][r] *= fr_; o[1][r] *= fr_; }
            }
            u32x4_t pw[4];
#pragma unroll
            for (int j = 0; j < 4; ++j) { pw[0][j] = cvtpk(p0[2 * j], p0[2 * j + 1]); pw[1][j] = cvtpk(p0[8 + 2 * j], p0[8 + 2 * j + 1]);
                                          pw[2][j] = cvtpk(p1[2 * j], p1[2 * j + 1]); pw[3][j] = cvtpk(p1[8 + 2 * j], p1[8 + 2 * j + 1]); }
#pragma unroll
            for (int d0 = 0; d0 < 2; ++d0)
#pragma unroll
                for (int ks = 0; ks < 4; ++ks) {
                    const s16x4_t lo = vtr(Vs + d0 * 4096 + ks * 1024), hh = vtr(Vs + d0 * 4096 + ks * 1024 + 512);
                    const bf16x8_t vf = {lo[0], lo[1], lo[2], lo[3], hh[0], hh[1], hh[2], hh[3]};
                    o[d0] = __builtin_amdgcn_mfma_f32_32x32x16_bf16(__builtin_bit_cast(bf16x8_t, pw[ks]), vf, o[d0], 0, 0, 0);
                }
        }
        float lt = l_ + __shfl_xor(l_, 32);
        if (hi == 0) wsf[r32] = 1.0f / lt;
        LDSW();
#pragma unroll
        for (int d0 = 0; d0 < 2; ++d0)
#pragma unroll
            for (int r = 0; r < 16; ++r) stg[crow(r, hi) * B_STG_ROW + d0 * 32 + r32] = (unsigned short)f2bf(o[d0][r] * wsf[crow(r, hi)]);
        const size_t pidx = (((size_t)b * SEQ + qidx) * 6 + h) * 4 + slot;
        if (hi == 0 && valid) { float2 mlv; mlv.x = m_ + slope2 * (float)(256 * n - qidx); mlv.y = lt; *(float2*)(ML + pidx * 2) = mlv; }
        LDSW();
        {
            const int row = lane >> 1, half = lane & 1;
            const int pk_own = valid ? (qidx | (slot << 16)) : -1;
            const int pk = __shfl(pk_own, row);
            if (pk >= 0) {
                bf16_t* dst = Pbuf + ((((size_t)b * SEQ + (pk & 0xffff)) * 6 + h) * 4 + (pk >> 16)) * 64 + half * 32;
#pragma unroll
                for (int i = 0; i < 4; ++i) *(u32x4_t*)(dst + 8 * i) = *(const LAS u32x4_t*)((const LAS unsigned char*)stg + row * (B_STG_ROW * 2) + half * 64 + i * 16);
            }
        }
        LDSW();
    }
    __syncthreads();
}

__device__ __forceinline__ void moba_combine(const bf16_t* __restrict__ Pbuf, const float* __restrict__ ML, bf16_t* __restrict__ Obuf, size_t gtid, size_t gth) {
    for (size_t idx = gtid; idx < (size_t)TOK * 48; idx += gth) {
        const int t = (int)(idx / 48), r = (int)(idx % 48), h = r >> 3, c = r & 7;
        const int qb = (t & (SEQ - 1)) >> 8, ns = qb < 3 ? qb : 3;
        const size_t pb = ((size_t)t * 6 + h) * 4;
        float m[4], l[4];
        { const float2 v = *(const float2*)(ML + (pb + 3) * 2); m[3] = v.x; l[3] = v.y; }
        float M = m[3];
#pragma unroll
        for (int i = 0; i < 3; ++i) { if (i < ns) { const float2 v = *(const float2*)(ML + (pb + i) * 2); m[i] = v.x; l[i] = v.y; M = fmaxf(M, m[i]); } else { m[i] = -INFINITY; l[i] = 0.f; } }
        float acc[8]; float wsum = 0.f;
#pragma unroll
        for (int j = 0; j < 8; ++j) acc[j] = 0.f;
#pragma unroll
        for (int i = 0; i < 4; ++i) {
            if (i == 3 || i < ns) {
                const float w = l[i] * __builtin_amdgcn_exp2f(m[i] - M); wsum += w;
                const u32x4_t v = *(const u32x4_t*)(Pbuf + (pb + i) * 64 + c * 8);
#pragma unroll
                for (int j = 0; j < 4; ++j) { acc[2 * j] += w * bf_lo(v[j]); acc[2 * j + 1] += w * bf_hi(v[j]); }
            }
        }
        const float inv = 1.0f / wsum;
        u32x4_t o; o.x = pk2(acc[0] * inv, acc[1] * inv); o.y = pk2(acc[2] * inv, acc[3] * inv); o.z = pk2(acc[4] * inv, acc[5] * inv); o.w = pk2(acc[6] * inv, acc[7] * inv);
        *(u32x4_t*)(Obuf + (size_t)t * DM + 256 + h * 64 + c * 8) = o;
    }
}
#undef LDSW
}

namespace peer {
constexpr int K_BYTES = 2 * 32768;
__device__ __forceinline__ int crow(int r, int hi) { return (r & 3) + 8 * (r >> 2) + 4 * hi; }

template <int N>
__device__ __forceinline__ void top16_pair(float (&s)[N], float (&out)[16], bool pair) {
#pragma unroll
    for (int it = 0; it < 16; ++it) {
        float mx = s[0];
#pragma unroll
        for (int i = 1; i < N; ++i) mx = fmaxf(mx, s[i]);
        if (pair) mx = fmaxf(mx, __shfl_xor(mx, 32));
        out[it] = mx;
#pragma unroll
        for (int i = 0; i < N; ++i) s[i] = (s[i] == mx) ? -INFINITY : s[i];
    }
}
__device__ __forceinline__ float pack_idx(float v, unsigned idx, unsigned mask) { return __builtin_bit_cast(float, (__builtin_bit_cast(unsigned, v) & ~mask) | idx); }
__device__ __forceinline__ unsigned byte16(unsigned t0, unsigned t1, unsigned t2, unsigned t3, unsigned i) {
    const unsigned s = i & 7u, a = __builtin_amdgcn_perm(t1, t0, s), b = __builtin_amdgcn_perm(t3, t2, s);
    return ((i & 8u) ? b : a) & 0xffu;
}

__device__ __forceinline__ void pk_unit(int tile, int h, const bf16_t* __restrict__ Q, const bf16_t* __restrict__ keysb, int* __restrict__ Eid, float* __restrict__ Gw, LAS unsigned char* lds) {
    int tid_ = threadIdx.x; asm volatile("" : "+v"(tid_));
    const int tid = tid_, lane = tid & 63, r32 = lane & 31, hi = lane >> 5;
    const int wid = __builtin_amdgcn_readfirstlane(tid >> 6);
    __syncthreads();
    {
        const bf16_t* kg = keysb + (size_t)h * 2 * 128 * 128;
        for (int i = tid; i < 2 * 128 * 16; i += NTHREADS) {
            const int n = i & 127, c = (i >> 7) & 15, p = i >> 11;
            const u32x4_t v = *(const u32x4_t*)(kg + ((size_t)(p * 128 + n)) * 128 + c * 8);
            *(LAS u32x4_t*)(lds + p * 32768 + c * 2048 + n * 16) = v;
        }
    }
    __syncthreads();
    const int tok = tile * 256 + wid * 32 + r32;
    float sv[2][16];
#pragma unroll
    for (int p = 0; p < 2; ++p) {
        const bf16_t* qp = Q + (size_t)tok * PQW + h * 256 + p * 128 + hi * 8;
        bf16x8_t qf[8];
#pragma unroll
        for (int ks = 0; ks < 8; ++ks) qf[ks] = *(const bf16x8_t*)(qp + ks * 16);
        float s[64];
#pragma unroll
        for (int blk = 0; blk < 4; ++blk) {
            f32x16_t acc;
#pragma unroll
            for (int r = 0; r < 16; ++r) acc[r] = 0.f;
#pragma unroll
            for (int ks = 0; ks < 8; ++ks) {
                const bf16x8_t kf = *(const LAS bf16x8_t*)(lds + p * 32768 + (2 * ks + hi) * 2048 + (blk * 32 + r32) * 16);
                acc = __builtin_amdgcn_mfma_f32_32x32x16_bf16(kf, qf[ks], acc, 0, 0, 0);
            }
#pragma unroll
            for (int r = 0; r < 16; ++r) s[blk * 16 + r] = pack_idx(acc[r], (unsigned)(blk * 32 + (r & 3) + 8 * (r >> 2) + 4 * hi), 127u);
        }
        top16_pair<64>(s, sv[p], true);
    }
    float cand[50];
    {
        int c = 0;
#pragma unroll
        for (int i = 0; i < 16; ++i)
#pragma unroll
            for (int j = 0; j < 16; ++j)
                if ((i + 1) * (j + 1) <= 16) { cand[c] = pack_idx(sv[0][i] + sv[1][j], (unsigned)(i * 16 + j), 255u); ++c; }
    }
    float top[16];
    top16_pair<50>(cand, top, false);
    unsigned t1[4], t2[4];
#pragma unroll
    for (int j = 0; j < 4; ++j) { t1[j] = 0u; t2[j] = 0u;
#pragma unroll
        for (int k = 0; k < 4; ++k) { t1[j] |= (__builtin_bit_cast(unsigned, sv[0][4 * j + k]) & 127u) << (8 * k); t2[j] |= (__builtin_bit_cast(unsigned, sv[1][4 * j + k]) & 127u) << (8 * k); } }
    float g[16]; int e[16]; float gs = 0.f;
#pragma unroll
    for (int k = 0; k < 16; ++k) {
        const unsigned code = __builtin_bit_cast(unsigned, top[k]) & 255u;
        e[k] = (int)(byte16(t1[0], t1[1], t1[2], t1[3], code >> 4) * 128u + byte16(t2[0], t2[1], t2[2], t2[3], code & 15u));
        g[k] = __expf(top[k] - top[0]); gs += g[k];
    }
    const float gi = 1.0f / gs;
    if (hi == 0) {
        int* ep = Eid + ((size_t)tok * PHEADS + h) * 16; float* gp = Gw + ((size_t)tok * PHEADS + h) * 16;
#pragma unroll
        for (int k = 0; k < 16; k += 4) {
            *(int4*)(ep + k) = make_int4(e[k], e[k + 1], e[k + 2], e[k + 3]);
            *(float4*)(gp + k) = make_float4(g[k] * gi, g[k + 1] * gi, g[k + 2] * gi, g[k + 3] * gi);
        }
    }
}

__device__ __forceinline__ float reduce16(float (&a)[16], int lane) {
    float b8[8];
    { const bool up = lane & 1;
#pragma unroll
      for (int i = 0; i < 8; ++i) { const float keep = up ? a[8 + i] : a[i], give = up ? a[i] : a[8 + i]; b8[i] = keep + __shfl_xor(give, 1); } }
    float b4[4];
    { const bool up = lane & 2;
#pragma unroll
      for (int i = 0; i < 4; ++i) { const float keep = up ? b8[4 + i] : b8[i], give = up ? b8[i] : b8[4 + i]; b4[i] = keep + __shfl_xor(give, 2); } }
    float b2[2];
    { const bool up = lane & 4;
#pragma unroll
      for (int i = 0; i < 2; ++i) { const float keep = up ? b4[2 + i] : b4[i], give = up ? b4[i] : b4[2 + i]; b2[i] = keep + __shfl_xor(give, 4); } }
    float b1;
    { const bool up = lane & 8; const float keep = up ? b2[1] : b2[0], give = up ? b2[0] : b2[1]; b1 = keep + __shfl_xor(give, 8); }
    b1 += __shfl_xor(b1, 16); b1 += __shfl_xor(b1, 32);
    return b1;
}
__device__ __forceinline__ int red16_index(int lane) { return 8 * (lane & 1) + 4 * ((lane >> 1) & 1) + 2 * ((lane >> 2) & 1) + ((lane >> 3) & 1); }

typedef float f32x2_t __attribute__((ext_vector_type(2)));
__device__ __forceinline__ void pg_token(int tok, const float* xres, float* xdst, const LAS float* tab2  , const float* __restrict__ g2  , int gstride,
                                         const int* __restrict__ Eid, const float* __restrict__ Gw, const unsigned char* __restrict__ U8, const unsigned char* __restrict__ V8,
                                         const float* __restrict__ Us, const float* __restrict__ Vs,
                                         bool last, const LAS float* tabn  , const float* __restrict__ final_g, bf16_t* __restrict__ Hn, float* __restrict__ outp, int lane) {
    const int b = tok >> 13;
    float x[16];
    const float* xp = xres + (size_t)tok * DM + 16 * lane;
    float* xw = xdst + (size_t)tok * DM + 16 * lane;
#pragma unroll
    for (int q = 0; q < 4; ++q) { const f32x4_t a = *(const f32x4_t*)(xp + 4 * q); x[4 * q] = a[0]; x[4 * q + 1] = a[1]; x[4 * q + 2] = a[2]; x[4 * q + 3] = a[3]; }
    float ss = 0.f;
#pragma unroll
    for (int i = 0; i < 16; ++i) ss += x[i] * x[i];
    const float rstd = 1.0f / sqrtf(wave_sum(ss) * (1.0f / DM) + EPS);
    float hh[16];
#pragma unroll
    for (int q = 0; q < 4; ++q) { const f32x4_t g = *(const LAS f32x4_t*)(tab2 + (b * 2 + 0) * 1024 + 16 * lane + 4 * q), s = *(const LAS f32x4_t*)(tab2 + (b * 2 + 1) * 1024 + 16 * lane + 4 * q);
#pragma unroll
        for (int i = 0; i < 4; ++i) hh[4 * q + i] = x[4 * q + i] * rstd * g[i] + s[i]; }
    float out[16];
#pragma unroll
    for (int i = 0; i < 16; ++i) out[i] = 0.f;
    const int ridx = red16_index(lane);
#pragma unroll 1
    for (int hd = 0; hd < PHEADS; ++hd) {
        const size_t eb = ((size_t)tok * PHEADS + hd) * 16;
        const int ev = Eid[eb + (lane & 15)];
        const int er = Eid[eb + ridx];
        const float gv = Gw[eb + ridx];
        const float su = Us[er], sv = Vs[er];
        float a[16];
        {
            u32x4_t w[16];
#pragma unroll
            for (int k = 0; k < 16; ++k) { const int e = __builtin_amdgcn_readlane(ev, k); w[k] = *(const u32x4_t*)(U8 + (size_t)e * DM + 16 * lane); }
#pragma unroll
            for (int k = 0; k < 16; ++k) { float acc = 0.f;
#pragma unroll
                for (int q = 0; q < 4; ++q) { const f32x2_t lo = __builtin_amdgcn_cvt_pk_f32_fp8((int)w[k][q], false), hi2 = __builtin_amdgcn_cvt_pk_f32_fp8((int)w[k][q], true);
                    acc += hh[4 * q] * lo[0]; acc += hh[4 * q + 1] * lo[1]; acc += hh[4 * q + 2] * hi2[0]; acc += hh[4 * q + 3] * hi2[1]; }
                a[k] = acc; }
        }
        __builtin_amdgcn_sched_barrier(0);
        const float dot = reduce16(a, lane) * su;
        const float wgt = gv * sv * 0.5f * dot * (1.0f + erff(dot * 0.70710678118654752f));
        {
            u32x4_t w[16];
#pragma unroll
            for (int k = 0; k < 16; ++k) { const int e = __builtin_amdgcn_readlane(ev, k); w[k] = *(const u32x4_t*)(V8 + (size_t)e * DM + 16 * lane); }
#pragma unroll
            for (int k = 0; k < 16; ++k) {
                const int src = ((k >> 3) & 1) | (((k >> 2) & 1) << 1) | (((k >> 1) & 1) << 2) | ((k & 1) << 3);
                const float wk = __builtin_bit_cast(float, __builtin_amdgcn_readlane(__builtin_bit_cast(int, wgt), src));
#pragma unroll
                for (int q = 0; q < 4; ++q) { const f32x2_t lo = __builtin_amdgcn_cvt_pk_f32_fp8((int)w[k][q], false), hi2 = __builtin_amdgcn_cvt_pk_f32_fp8((int)w[k][q], true);
                    out[4 * q] += wk * lo[0]; out[4 * q + 1] += wk * lo[1]; out[4 * q + 2] += wk * hi2[0]; out[4 * q + 3] += wk * hi2[1]; }
            }
        }
    }
    float y[16]; float s2 = 0.f;
#pragma unroll
    for (int q = 0; q < 4; ++q) { const f32x4_t gg = *(const f32x4_t*)(g2 + (size_t)b * gstride + 16 * lane + 4 * q);
#pragma unroll
        for (int i = 0; i < 4; ++i) { y[4 * q + i] = x[4 * q + i] + gg[i] * out[4 * q + i]; s2 += y[4 * q + i] * y[4 * q + i]; } }
    const float rn = 1.0f / sqrtf(wave_sum(s2) * (1.0f / DM) + EPS);
    if (!last) {
#pragma unroll
        for (int q = 0; q < 4; ++q) *(f32x4_t*)(xw + 4 * q) = (f32x4_t){y[4 * q], y[4 * q + 1], y[4 * q + 2], y[4 * q + 3]};
        float z[16];
#pragma unroll
        for (int q = 0; q < 4; ++q) { const f32x4_t g = *(const LAS f32x4_t*)(tabn + (b * 2 + 0) * 1024 + 16 * lane + 4 * q), s = *(const LAS f32x4_t*)(tabn + (b * 2 + 1) * 1024 + 16 * lane + 4 * q);
#pragma unroll
            for (int i = 0; i < 4; ++i) z[4 * q + i] = y[4 * q + i] * rn * g[i] + s[i]; }
        bf16_t* hp = Hn + (size_t)tok * DM + 16 * lane;
#pragma unroll
        for (int j = 0; j < 2; ++j) { u32x4_t wv; wv.x = pk2(z[8 * j], z[8 * j + 1]); wv.y = pk2(z[8 * j + 2], z[8 * j + 3]); wv.z = pk2(z[8 * j + 4], z[8 * j + 5]); wv.w = pk2(z[8 * j + 6], z[8 * j + 7]); *(u32x4_t*)(hp + 8 * j) = wv; }
    } else {
        float* op = outp + (size_t)tok * DM + 16 * lane;
#pragma unroll
        for (int q = 0; q < 4; ++q) { const f32x4_t fg = *(const f32x4_t*)(final_g + 16 * lane + 4 * q);
            *(f32x4_t*)(op + 4 * q) = (f32x4_t){y[4 * q] * rn * fg[0], y[4 * q + 1] * rn * fg[1], y[4 * q + 2] * rn * fg[2], y[4 * q + 3] * rn * fg[3]}; }
    }
}
__device__ __forceinline__ void row_to_fp8(const float* src, unsigned char* dst, float* scale_out, int lane) {
    float v[16]; float mx = 0.f;
#pragma unroll
    for (int q = 0; q < 4; ++q) { const f32x4_t a = *(const f32x4_t*)(src + 16 * lane + 4 * q); v[4 * q] = a[0]; v[4 * q + 1] = a[1]; v[4 * q + 2] = a[2]; v[4 * q + 3] = a[3]; }
#pragma unroll
    for (int i = 0; i < 16; ++i) mx = fmaxf(mx, fabsf(v[i]));
#pragma unroll
    for (int o = 1; o < 64; o <<= 1) mx = fmaxf(mx, __shfl_xor(mx, o));
    const float sc = mx > 0.f ? 384.0f / mx : 1.0f;
    u32x4_t w;
#pragma unroll
    for (int q = 0; q < 4; ++q) { int t = 0; t = __builtin_amdgcn_cvt_pk_fp8_f32(v[4 * q] * sc, v[4 * q + 1] * sc, t, false); t = __builtin_amdgcn_cvt_pk_fp8_f32(v[4 * q + 2] * sc, v[4 * q + 3] * sc, t, true); w[q] = (unsigned)t; }
    *(u32x4_t*)(dst + 16 * lane) = w;
    if (lane == 0) *scale_out = mx > 0.f ? mx / 384.0f : 1.0f;
}
}

constexpr int LDS_MISC = 131072, LDS_BYTES = 131072 + 64;
constexpr int CW_BAR = 4096;
#ifndef REPMASK
#define REPMASK 0u
#endif
#define NREP(k) ((((REPMASK) >> (k)) & 1u) ? 2 : 1)
#define DBG_BASE 0
#ifndef ATM
#define ATM 7
#endif
#ifndef MK_N_LAUNCHES
#define MK_N_LAUNCHES 1
#endif
constexpr int PH_PER_LAYER = 9, N_PHASES = 2 + PH_PER_LAYER * DEPTH;

struct Args { const float* in[19]; float* out; unsigned char* ws; int ph_lo, ph_hi; };
enum { I_X = 0, I_C, I_N1G, I_N2G, I_WADA, I_BADA, I_WIN, I_WOUT, I_LQ1, I_LK1, I_LQ2, I_LK2, I_SUBG, I_SINK, I_PWQ, I_PKEYS, I_PU, I_PV, I_FG };

__device__ __forceinline__ void p0_transpose_item(const float* W, int K, int N, bf16_t* WT, LAS float* scr, int item, int lane) {
    const int nblk = N / 32, kb = item / nblk, nb = item % nblk, k0 = 64 * kb, n0 = 32 * nb;
#pragma unroll 8
    for (int i = 0; i < 32; ++i) { const int kk = 2 * i + (lane >> 5); scr[kk * 33 + (lane & 31)] = W[(size_t)(k0 + kk) * N + n0 + (lane & 31)]; }
    asm volatile("s_waitcnt lgkmcnt(0)" ::: "memory");
    const int c = lane & 7;
#pragma unroll
    for (int j = 0; j < 4; ++j) { const int n = (lane >> 3) + 8 * j; const LAS float* s = scr + (8 * c) * 33 + n;
        u32x4_t o; o.x = pk2(s[0 * 33], s[1 * 33]); o.y = pk2(s[2 * 33], s[3 * 33]); o.z = pk2(s[4 * 33], s[5 * 33]); o.w = pk2(s[6 * 33], s[7 * 33]);
        *(u32x4_t*)(WT + (size_t)(n0 + n) * K + k0 + 8 * c) = o; }
    asm volatile("s_waitcnt lgkmcnt(0)" ::: "memory");
}
__device__ __forceinline__ void cvt_rows(const float* src, bf16_t* dst, size_t n, size_t gtid, size_t gthreads) {
    for (size_t i = gtid * 8; i < n; i += gthreads * 8) {
        const f32x4_t a = *(const f32x4_t*)(src + i), c = *(const f32x4_t*)(src + i + 4);
        u32x4_t o; o.x = pk2(a[0], a[1]); o.y = pk2(a[2], a[3]); o.z = pk2(c[0], c[1]); o.w = pk2(c[2], c[3]);
        *(u32x4_t*)(dst + i) = o;
    }
}
__device__ __forceinline__ void build_table(LAS float* tab, const float* gvec, const float* mod_l, int sh_idx, int sc_idx) {
    for (int i = threadIdx.x; i < 4096; i += NTHREADS) { const int b = i >> 10, k = i & 1023;
        tab[(b * 2 + 0) * 1024 + k] = gvec[k] * (1.0f + mod_l[b * 6144 + sc_idx * 1024 + k]);
        tab[(b * 2 + 1) * 1024 + k] = mod_l[b * 6144 + sh_idx * 1024 + k]; }
}
__device__ __forceinline__ void norm_row(const float* xrow, bf16_t* orow, const LAS float* tab, int b, int lane) {
    const f32x4_t* xr = (const f32x4_t*)xrow + lane;
    f32x4_t v[4]; float s = 0.f;
#pragma unroll
    for (int j = 0; j < 4; ++j) { v[j] = xr[64 * j]; s += (v[j][0] * v[j][0] + v[j][1] * v[j][1]) + (v[j][2] * v[j][2] + v[j][3] * v[j][3]); }
    const float rstd = 1.0f / sqrtf(wave_sum(s) * (1.0f / DM) + EPS);
    unsigned long long* o8 = (unsigned long long*)orow + lane;
#pragma unroll
    for (int j = 0; j < 4; ++j) { const int k = 4 * lane + 256 * j;
        const f32x4_t g = *(const LAS f32x4_t*)(tab + (b * 2 + 0) * 1024 + k), sh = *(const LAS f32x4_t*)(tab + (b * 2 + 1) * 1024 + k);
        const f32x4_t y = v[j] * rstd * g + sh;
        o8[64 * j] = (unsigned long long)pk2(y[0], y[1]) | ((unsigned long long)pk2(y[2], y[3]) << 32); }
}

__global__ void __launch_bounds__(NTHREADS, 2) hymba_fwd(Args args) {
    extern __shared__ __attribute__((aligned(16))) unsigned char lds_raw[];
    LAS unsigned char* lds = (LAS unsigned char*)lds_raw;
    cg::grid_group grid = cg::this_grid();
    const int tid = threadIdx.x;
    const int wave = __builtin_amdgcn_readfirstlane(tid >> 6);
    const int G = gridDim.x, bx = blockIdx.x;
    const int gw = bx * NWAVES + wave, NGW = G * NWAVES;
    const int lo = args.ph_lo, hi_ = args.ph_hi;
#ifndef PHMASK
#define PHMASK 0xffffu
#endif
#define IN(k) (((PHMASK >> ((k) < 2 ? (k) : 2 + ((k) - 2) % PH_PER_LAYER)) & 1u) && lo <= (k) && (k) < hi_)
    if (tid < 16) ((volatile LAS unsigned*)(lds + LDS_MISC))[tid] = 0u;
    __syncthreads();
    (void)xcd_barrier_post((unsigned*)(args.ws + WS_CTL) + CW_BAR, (volatile LAS unsigned*)(lds + LDS_MISC));
#define SEAM(k) do { if (IN(k) && IN((k) + 1)) { if ((k) == 0) grid.sync(); else { XcdBarrier xb_; { size_t z_ = 0; asm volatile("" : "+s"(z_)); xb_.bar = (unsigned*)(args.ws + z_ + WS_CTL) + CW_BAR; } xb_.x = xb_xcc_id(); xb_.st = (volatile LAS unsigned*)(lds + LDS_MISC); xcd_barrier(xb_); } } } while (0)
#define PHASE_BEGIN() size_t wz_ = 0; asm volatile("" : "+s"(wz_)); unsigned char* ws = args.ws + wz_;     \
    int lane, ptid; { int t_ = threadIdx.x; asm volatile("" : "+v"(t_)); lane = t_ & 63; ptid = t_; } (void)lane; (void)ptid; \
    bf16_t* Wt_in = (bf16_t*)(ws + WS_WIN); bf16_t* Wt_out = (bf16_t*)(ws + WS_WOUT); bf16_t* Wt_q = (bf16_t*)(ws + WS_WQ); bf16_t* keysb = (bf16_t*)(ws + WS_KEYS); \
    float* modf = (float*)(ws + WS_MOD); float* kmean = (float*)(ws + WS_KMEAN); float* scal = (float*)(ws + WS_SCAL); \
    unsigned char* U8 = ws + WS_U; unsigned char* V8 = ws + WS_V; bf16_t* Hb = (bf16_t*)(ws + WS_H); \
    float* Us = (float*)(ws + WS_SCAL + 65536); float* Vs = (float*)(ws + WS_SCAL + 65536 + 262144); \
    bf16_t* Pj = (bf16_t*)(ws + WS_PROJ); bf16_t* Qp = (bf16_t*)(ws + WS_PROJ); bf16_t* Ob = (bf16_t*)(ws + WS_O); \
    int* Eid = (int*)(ws + WS_O); float* Gw = (float*)(ws + WS_O + 16 * MiB); unsigned* ctl = (unsigned*)(ws + WS_CTL); bf16_t* Pbuf = (bf16_t*)(ws + WS_PBUF); float* MLb = (float*)(ws + WS_ML); unsigned* RM = (unsigned*)(ws + WS_RM); (void)Pbuf; (void)MLb; (void)RM; \
    (void)Wt_in; (void)Wt_out; (void)Wt_q; (void)keysb; (void)modf; (void)kmean; (void)scal; (void)U8; (void)V8; (void)Hb; (void)Us; (void)Vs; (void)Pj; (void)Qp; (void)Ob; (void)Eid; (void)Gw; (void)ctl

    if (IN(0)) for (int rep = 0; rep < NREP(0); ++rep) {
        PHASE_BEGIN();
        if (bx < 192) {
            LAS float* cs = (LAS float*)lds;
            LAS float* red = (LAS float*)(lds + 16384);
            for (int i = tid; i < 4096; i += NTHREADS) { const float cv = args.in[I_C][i]; cs[i] = cv / (1.0f + __expf(-cv)); }
            __syncthreads();
            for (int it = bx; it < 192; it += G) {
                const int l = it / 96, n = (it % 96) * 64 + lane;
                const float* wp = args.in[I_WADA] + (size_t)l * DM * 6144 + n;
                float a0 = 0.f, a1 = 0.f, a2 = 0.f, a3 = 0.f;
#pragma unroll 8
                for (int k = wave * 128; k < wave * 128 + 128; ++k) { const float wv = wp[(size_t)k * 6144]; a0 += cs[k] * wv; a1 += cs[1024 + k] * wv; a2 += cs[2048 + k] * wv; a3 += cs[3072 + k] * wv; }
                red[(wave * 4 + 0) * 64 + lane] = a0; red[(wave * 4 + 1) * 64 + lane] = a1; red[(wave * 4 + 2) * 64 + lane] = a2; red[(wave * 4 + 3) * 64 + lane] = a3;
                __syncthreads();
                if (wave < 4) { float s = args.in[I_BADA][l * 6144 + n];
#pragma unroll
                    for (int w = 0; w < 8; ++w) s += red[(w * 4 + wave) * 64 + lane];
                    modf[((size_t)l * 4 + wave) * 6144 + n] = s; }
                __syncthreads();
            }
        }
        __syncthreads();
        {
            LAS float* scr = (LAS float*)(lds + wave * 16384);
            constexpr int I_IN = 16 * (INW / 32), I_OUT = 16 * (DM / 32), I_Q = 16 * (PQW / 32), PER_L = I_IN + I_OUT + I_Q;
            for (int it = gw; it < DEPTH * PER_L; it += NGW) {
                const int l = it / PER_L; int r = it % PER_L;
                if (r < I_IN) { p0_transpose_item(args.in[I_WIN] + (size_t)l * DM * INW, DM, INW, Wt_in + (size_t)l * INW * DM, scr, r, lane); continue; } r -= I_IN;
                if (r < I_OUT) { p0_transpose_item(args.in[I_WOUT] + (size_t)l * DM * DM, DM, DM, Wt_out + (size_t)l * DM * DM, scr, r, lane); continue; } r -= I_OUT;
                p0_transpose_item(args.in[I_PWQ] + (size_t)l * DM * PQW, DM, PQW, Wt_q + (size_t)l * PQW * DM, scr, r, lane);
            }
        }
        {
            const size_t gtid = (size_t)bx * NTHREADS + ptid, gth = (size_t)G * NTHREADS;
            cvt_rows(args.in[I_PKEYS], keysb, (size_t)DEPTH * PHEADS * 2 * 128 * 128, gtid, gth);
            for (int r = gw; r < 2 * DEPTH * PNEXP; r += NGW) { const int tb = r / (DEPTH * PNEXP), rr = r % (DEPTH * PNEXP);
                peer::row_to_fp8(args.in[tb ? I_PV : I_PU] + (size_t)rr * DM, (tb ? V8 : U8) + (size_t)rr * DM, (tb ? Vs : Us) + rr, lane); }
            for (size_t i = gtid; i < (size_t)DEPTH * 4 * 6 * 32 * 64; i += gth) kmean[i] = 0.f;
            if (gtid < DEPTH) { const int l = (int)gtid; float s1 = 0.f, s2 = 0.f;
                for (int i = 0; i < 32; ++i) { s1 += args.in[I_LQ1][l * 32 + i] * args.in[I_LK1][l * 32 + i]; s2 += args.in[I_LQ2][l * 32 + i] * args.in[I_LK2][l * 32 + i]; }
                const float lam_init = 0.8f - 0.6f * expf(-0.3f * (float)l);
                scal[l * 4 + 0] = expf(s1) - expf(s2) + lam_init; scal[l * 4 + 1] = lam_init; }
        }
    }
    SEAM(0);
    if (IN(1)) for (int rep = 0; rep < NREP(1); ++rep) {
        PHASE_BEGIN();
        LAS float* tab = (LAS float*)lds;
        build_table(tab, args.in[I_N1G], modf, 0, 1);
        __syncthreads();
        for (int m = gw; m < TOK; m += NGW) norm_row(args.in[I_X] + (size_t)m * DM, Hb + (size_t)m * DM, tab, m >> 13, lane);
        __syncthreads();
    }
    SEAM(1);

#pragma unroll 1
    for (int l = 0; l < DEPTH; ++l) {
        const int P = 2 + PH_PER_LAYER * l;
        if (IN(P + 0)) for (int rep = 0; rep < NREP(2); ++rep) {
            PHASE_BEGIN();
            pg8::Gemm g{Hb, Wt_in + (size_t)l * INW * DM, TOK, INW, DM}; pg8::StaticOrder S; S.init(TOK, INW, G, bx);
            pg8::EpiProj E{Pj, INW, kmean + (size_t)l * 4 * 6 * 32 * 64, rep == 0 ? OFF_KB : (1 << 28)};
            pg8::gemm_phase<pg8::EpiProj, pg8::StaticOrder, true, true>(lds, g, S, E);
        }
        SEAM(P + 0);
        if (IN(P + 1)) for (int rep = 0; rep < NREP(3); ++rep) {
            for (int u = bx; u < 768; u += G) { PHASE_BEGIN(); att::gate_unit((u % 24) / 6, u % 6, u / 24, Pj, kmean + (size_t)l * 4 * 6 * 32 * 64, RM, lds); }
        }
        SEAM(P + 1);
        if (IN(P + 2)) for (int rep = 0; rep < NREP(4); ++rep) {
            volatile LAS int* qw = (volatile LAS int*)(lds + LDS_MISC + 32);
#define NEXT_UNIT(mode) int idx; { PHASE_BEGIN(); if (tid == 0) qw[0] = (int)atomicAdd(ctl + 64 * ((rep * DEPTH + l) * 4 + (mode)), 1u); __syncthreads(); idx = qw[0]; }
            if (ATM & 1) for (;;) {
                NEXT_UNIT(0); if (idx >= 512) break;
                PHASE_BEGIN();
                const int qb = 31 - idx / 16, j = idx % 16;
                att::attn_unit<0>(j >> 2, j & 3, qb, Pj, Ob, nullptr, scal[l * 4 + 0], scal[l * 4 + 1], args.in[I_SUBG] + l * 64, nullptr, lds);
            }
            __syncthreads();
            if (ATM & 2) for (;;) {
                NEXT_UNIT(1); if (idx >= 768) break;
                PHASE_BEGIN();
                att::moba_unit((idx % 24) / 6, idx % 6, idx / 24, Pj, RM, Pbuf, MLb, lds);
            }
            __syncthreads();
            if (ATM & 4) for (;;) {
                NEXT_UNIT(2); if (idx >= 768) break;
                PHASE_BEGIN();
                const int qb = idx / 24, jj = idx % 24;
                att::attn_unit<2>(jj / 6, jj % 6, qb, Pj, Ob, nullptr, 0.f, 0.f, nullptr, args.in[I_SINK] + l * 6 + jj % 6, lds);
            }
            __syncthreads();
#undef NEXT_UNIT
        }
        SEAM(P + 2);
        if (IN(P + 3)) for (int rep = 0; rep < NREP(5); ++rep) {
            PHASE_BEGIN();
            att::moba_combine(Pbuf, MLb, Ob, (size_t)bx * NTHREADS + ptid, (size_t)G * NTHREADS);
        }
        SEAM(P + 3);
        if (IN(P + 4)) for (int rep = 0; rep < NREP(6); ++rep) {
            PHASE_BEGIN();
            pg8::Gemm g{Ob, Wt_out + (size_t)l * DM * DM, TOK, DM, DM}; pg8::StaticOrder S; S.init(TOK, DM, G, bx);
            pg8::EpiRes E{(l == 0) ? args.in[I_X] : (const float*)args.out, (rep + 1 < NREP(6)) ? (float*)(ws + WS_PROJ) : args.out, DM, modf + (size_t)l * 4 * 6144 + 2 * 1024, 6144};
            pg8::gemm_phase<pg8::EpiRes, pg8::StaticOrder, true, true>(lds, g, S, E);
        }
        SEAM(P + 4);
        if (IN(P + 5)) for (int rep = 0; rep < NREP(7); ++rep) {
            PHASE_BEGIN();
            LAS float* tab = (LAS float*)lds;
            build_table(tab, args.in[I_N2G] + l * DM, modf + (size_t)l * 4 * 6144, 3, 4);
            __syncthreads();
            for (int m = gw; m < TOK; m += NGW) norm_row(args.out + (size_t)m * DM, Hb + (size_t)m * DM, tab, m >> 13, lane);
            __syncthreads();
        }
        SEAM(P + 5);
        if (IN(P + 6)) for (int rep = 0; rep < NREP(8); ++rep) {
            PHASE_BEGIN();
            pg8::Gemm g{Hb, Wt_q + (size_t)l * PQW * DM, TOK, PQW, DM}; pg8::StaticOrder S; S.init(TOK, PQW, G, bx);
            pg8::EpiBf16Plain E{Qp, PQW};
            pg8::gemm_phase<pg8::EpiBf16Plain, pg8::StaticOrder, true, true>(lds, g, S, E);
        }
        SEAM(P + 6);
        if (IN(P + 7)) for (int rep = 0; rep < NREP(9); ++rep) {
            PHASE_BEGIN();
            for (int u = bx; u < (TOK / 256) * PHEADS; u += G) peer::pk_unit(u >> 3, u & 7, Qp, keysb + (size_t)l * PHEADS * 2 * 128 * 128, Eid, Gw, lds);
            __syncthreads();
        }
        SEAM(P + 7);
        if (IN(P + 8)) for (int rep = 0; rep < NREP(10); ++rep) {
            PHASE_BEGIN();
            LAS float* tab2 = (LAS float*)lds; LAS float* tabn = (LAS float*)(lds + 32768);
            const bool last = (l == DEPTH - 1);
            const float* mod_l = modf + (size_t)l * 4 * 6144;
            build_table(tab2, args.in[I_N2G] + l * DM, mod_l, 3, 4);
            if (!last) build_table(tabn, args.in[I_N1G] + (l + 1) * DM, mod_l + 4 * 6144, 0, 1);
            __syncthreads();
            float* dry = (float*)(ws + WS_PROJ);
            for (int m = gw; m < TOK; m += NGW)
                peer::pg_token(m, args.out, (rep + 1 < NREP(10)) ? dry : args.out, tab2, mod_l + 5 * 1024, 6144, Eid, Gw, U8 + (size_t)l * PNEXP * DM, V8 + (size_t)l * PNEXP * DM, Us + l * PNEXP, Vs + l * PNEXP,
                                last, tabn, args.in[I_FG], Hb, (rep + 1 < NREP(10)) ? dry : args.out, lane);
            __syncthreads();
        }
        if (l + 1 < DEPTH) SEAM(P + 8);
    }
#undef IN
#undef SEAM
}

#ifdef DBG
__global__ void dbg_chk16(const bf16_t* p, size_t n, unsigned* flag, unsigned bit) {
    bool bad = false;
    for (size_t i = (size_t)blockIdx.x * blockDim.x + threadIdx.x; i < n; i += (size_t)gridDim.x * blockDim.x) bad |= ((p[i] & 0x7f80u) == 0x7f80u);
    if (bad) atomicOr(flag, bit);
}
__global__ void dbg_chk32(const float* p, size_t n, unsigned* flag, unsigned bit) {
    bool bad = false;
    for (size_t i = (size_t)blockIdx.x * blockDim.x + threadIdx.x; i < n; i += (size_t)gridDim.x * blockDim.x) bad |= ((__builtin_bit_cast(unsigned, p[i]) & 0x7f800000u) == 0x7f800000u);
    if (bad) atomicOr(flag, bit);
}
__global__ void dbg_chk_o(const bf16_t* p, unsigned* flag) {
    unsigned bad = 0;
    for (size_t i = (size_t)blockIdx.x * blockDim.x + threadIdx.x; i < (size_t)TOK * DM; i += (size_t)gridDim.x * blockDim.x) {
        if ((p[i] & 0x7f80u) == 0x7f80u) { const int c = (int)(i & 1023); const int r = (int)((i >> 10) & 8191); bad |= (c < 256) ? 1u : (c < 640 ? 2u : 4u); if (r < 256) bad |= 8u; if ((r & 255) < 32) bad |= 16u; if (p[i] & 0x7fu) bad |= 32u; }
    }
    if (bad) atomicOr(flag, bad);
}
__global__ void dbg_fill(float* out, size_t n, const unsigned* flag) {
    const unsigned f = *flag; if (f == 0u) return;
    const float c = sqrtf((float)f);
    for (size_t i = (size_t)blockIdx.x * blockDim.x + threadIdx.x; i < n; i += (size_t)gridDim.x * blockDim.x) out[i] = c;
}
#endif
extern "C" void kernel_launch(void* const* d_in, const int* in_sizes, int n_in, void* d_out, int out_size, void* d_ws, size_t ws_size, hipStream_t stream) {
    static int grid = 0;
    if (grid == 0) {
        if (n_in != 19 || out_size != TOK * DM || ws_size < WS_END) { fprintf(stderr, "kernel_launch: unexpected shapes (n_in %d out %d ws %zu)\n", n_in, out_size, ws_size); grid = -1; return; }
        int dev = 0, cus = 0, per_cu = 0;
        hipGetDevice(&dev); hipDeviceGetAttribute(&cus, hipDeviceAttributeMultiprocessorCount, dev);
        hipFuncSetAttribute((const void*)hymba_fwd, hipFuncAttributeMaxDynamicSharedMemorySize, LDS_BYTES);
        hipOccupancyMaxActiveBlocksPerMultiprocessor(&per_cu, (const void*)hymba_fwd, NTHREADS, LDS_BYTES);
        (void)hipGetLastError();
        if (per_cu < 1) per_cu = 1;
        if (per_cu > 1) per_cu = 1;
        grid = cus * per_cu;
        if (grid <= 0) grid = 256;
    }
    if (grid < 0) return;
    hipMemsetAsync((char*)d_ws + WS_CTL, 0, CTL_ZERO_BYTES, stream);
    Args a{};
    for (int i = 0; i < 19; ++i) a.in[i] = (const float*)d_in[i];
    a.out = (float*)d_out; a.ws = (unsigned char*)d_ws;
#if MK_N_LAUNCHES == 1
    a.ph_lo = 0; a.ph_hi = N_PHASES;
    void* kargs[] = {&a};
    hipError_t e = hipLaunchCooperativeKernel((const void*)hymba_fwd, dim3(grid), dim3(NTHREADS), kargs, LDS_BYTES, stream);
    if (e != hipSuccess) fprintf(stderr, "cooperative launch failed: %s (grid %d)\n", hipGetErrorString(e), grid);
#else
    for (int p = 0; p < N_PHASES; ++p) { a.ph_lo = p; a.ph_hi = p + 1; hipLaunchKernelGGL(hymba_fwd, dim3(grid), dim3(NTHREADS), LDS_BYTES, stream, a);
#ifdef DBG
        unsigned* flag = (unsigned*)((char*)d_ws + WS_CTL); unsigned char* w = (unsigned char*)d_ws;
        const int base = DBG_BASE;
        if (p == 3) dbg_chk_o<<<1024, 256, 0, stream>>>((const bf16_t*)(w + WS_O), flag);
#endif
    }
#ifdef DBG
    dbg_fill<<<1024, 256, 0, stream>>>((float*)d_out, (size_t)TOK * DM, (const unsigned*)((char*)d_ws + WS_CTL));
#endif
#endif
}
```

```cpp
#include <hip/hip_runtime.h>
#include <hip/hip_cooperative_groups.h>
#include <cstdio>
#include <cstdint>
#include <cmath>
namespace cg = cooperative_groups;

constexpr int DM = 1024, NBATCH = 4, SEQ = 8192, DEPTH = 2, TOK = NBATCH * SEQ;
constexpr int INW = 2560, NMOD = 6;
constexpr int OFF_QA = 0, OFF_KA = 256, OFF_VA = 512, OFF_QB = 768, OFF_KB = 1152, OFF_VB = 1536, OFF_QC = 1920, OFF_KC = 2304, OFF_VC = 2432;
constexpr int PHEADS = 8, PQW = 2048, PNK = 128, PNEXP = 16384, PTOPK = 16;
constexpr float EPS = 1e-6f;
constexpr float LOG2E = 1.4426950408889634f;
constexpr int NWAVES = 8, NTHREADS = 512;

constexpr size_t MiB = 1u << 20;
constexpr size_t WS_CTL = 0, CTL_ZERO_BYTES = 64 * 1024;
constexpr size_t WS_WIN = 1 * MiB;
constexpr size_t WS_WOUT = 11 * MiB;
constexpr size_t WS_WQ = 15 * MiB;
constexpr size_t WS_KEYS = 23 * MiB;
constexpr size_t WS_MOD = 24 * MiB;
constexpr size_t WS_KMEAN = 24 * MiB + 256 * 1024;
constexpr size_t WS_SCAL = 25 * MiB;
constexpr size_t WS_U = 26 * MiB;
constexpr size_t WS_V = 58 * MiB;
constexpr size_t WS_H = 90 * MiB;
constexpr size_t WS_PROJ = 154 * MiB;
constexpr size_t WS_O = 314 * MiB;
constexpr size_t WS_PBUF = 378 * MiB;
constexpr size_t WS_ML = 474 * MiB;
constexpr size_t WS_RM = 480 * MiB;
constexpr size_t WS_END = 482 * MiB;

#define GAS __attribute__((address_space(1)))
#define LAS __attribute__((address_space(3)))
typedef unsigned short bf16_t;
typedef short bf16x8_t __attribute__((ext_vector_type(8)));
typedef short s16x4_t __attribute__((ext_vector_type(4)));
typedef float f32x4_t __attribute__((ext_vector_type(4)));
typedef float f32x16_t __attribute__((ext_vector_type(16)));
typedef unsigned u32x4_t __attribute__((ext_vector_type(4)));
typedef unsigned u32x2_t __attribute__((ext_vector_type(2)));

__device__ __forceinline__ unsigned f2bf(float f) { unsigned u = __builtin_bit_cast(unsigned, f); return (u + 0x7fffu + ((u >> 16) & 1u)) >> 16; }
__device__ __forceinline__ unsigned pk2(float lo, float hi) { return f2bf(lo) | (f2bf(hi) << 16); }
__device__ __forceinline__ float bf_lo(unsigned w) { return __builtin_bit_cast(float, w << 16); }
__device__ __forceinline__ float bf_hi(unsigned w) { return __builtin_bit_cast(float, w & 0xffff0000u); }
__device__ __forceinline__ float wave_sum(float v) {
#pragma unroll
    for (int o = 1; o < 64; o <<= 1) v += __shfl_xor(v, o);
    return v;
}
__device__ __forceinline__ float swap32_partner(float v, int) { return __shfl_xor(v, 32); }
__device__ __forceinline__ float alibi_slope(int i) { return exp2f(-0.5f * (float)(i + 1)); }

typedef GAS unsigned gu32;
#define RLX_AGENT __ATOMIC_RELAXED, __HIP_MEMORY_SCOPE_AGENT
#define XB_TMO      128
#define XB_XCNT(j)  (256  + 64 * (j))
#define XB_XSUB(j)  (1280 + 64 * (j))
#define XB_XGEN(j)  (2304 + 64 * (j))
#define XB_TOP      3328
#define XB_TOPGEN   3392
#define XCD_BAR_WORDS 3456
#define XB_SPIN_CAP (1u << 18)

__device__ __forceinline__ unsigned xb_ld(unsigned* p)              { return __hip_atomic_load(p, __ATOMIC_RELAXED, __HIP_MEMORY_SCOPE_AGENT); }
__device__ __forceinline__ unsigned xb_add(unsigned* p, unsigned v) { return __hip_atomic_fetch_add(p, v, __ATOMIC_RELAXED, __HIP_MEMORY_SCOPE_AGENT); }
__device__ __forceinline__ unsigned xb_xcc_id() { return (unsigned)__builtin_amdgcn_s_getreg((3 << 11) | 20) & 0xFu; }
#define XB_SPIN(cond, bar) do { unsigned _sp = 0; while (cond) { __builtin_amdgcn_s_sleep(1); \
    if ((++_sp & 255u) == 0u) { if (xb_ld(&(bar)[XB_TMO])) break; if (_sp > XB_SPIN_CAP) { atomicAdd(&(bar)[XB_TMO], 1u); break; } } } } while (0)

struct XcdBarrier {
    unsigned* bar; unsigned x;
    volatile LAS unsigned* st;
};

__device__ __forceinline__ XcdBarrier xcd_barrier_post(unsigned* bar, volatile LAS unsigned* st) {
    XcdBarrier b; b.bar = bar; b.x = xb_xcc_id(); b.st = st;
    if (threadIdx.x == 0) (void)xb_add(&bar[XB_XCNT(b.x)], 1u);
    return b;
}
__device__ __forceinline__ void xcd_barrier_complete(unsigned* bar, unsigned x, unsigned& nloc, unsigned& nx) {
    const unsigned G = gridDim.x * gridDim.y * gridDim.z;
    unsigned sum, cnt, mine, sp = 0u;
    for (;;) {
        sum = 0u; cnt = 0u; mine = 0u;
#pragma unroll
        for (unsigned j = 0; j < 16; ++j) { const unsigned c = xb_ld(&bar[XB_XCNT(j)]); sum += c; cnt += (c > 0u) ? 1u : 0u; mine = (j == x) ? c : mine; }
        if (sum == G) break;
        __builtin_amdgcn_s_sleep(1);
        if ((++sp & 255u) == 0u) { if (xb_ld(&bar[XB_TMO])) break; if (sp > XB_SPIN_CAP) { atomicAdd(&bar[XB_TMO], 1u); break; } }
    }
    nloc = mine > 0u ? mine : 1u; nx = cnt > 0u ? cnt : 1u;
}

__device__ __forceinline__ void xcd_barrier(const XcdBarrier& b) {
    asm volatile("s_waitcnt vmcnt(0)" ::: "memory");
    __syncthreads();
    if (threadIdx.x == 0) {
        unsigned* bar = b.bar;
        __builtin_amdgcn_s_waitcnt(0);
        unsigned nloc = b.st[0], nx = b.st[1];
        if (nloc == 0u) { xcd_barrier_complete(bar, b.x, nloc, nx); b.st[0] = nloc; b.st[1] = nx; }
        const unsigned old = xb_add(&bar[XB_XSUB(b.x)], 1u);
        const unsigned gen = old / nloc;
        if (old + 1u == (gen + 1u) * nloc) {
            __builtin_amdgcn_fence(__ATOMIC_RELEASE, "agent");
            asm volatile("s_waitcnt vmcnt(0)" ::: "memory");
            const unsigned og = xb_add(&bar[XB_TOP], 1u);
            const unsigned tg = og / nx;
            if (og + 1u == (tg + 1u) * nx) xb_add(&bar[XB_TOPGEN], 1u);
            else XB_SPIN(xb_ld(&bar[XB_TOPGEN]) == tg, bar);
            __builtin_amdgcn_fence(__ATOMIC_ACQUIRE, "agent");
            xb_add(&bar[XB_XGEN(b.x)], 1u);
            asm volatile("s_waitcnt vmcnt(0)" ::: "memory");
        } else {
            XB_SPIN(xb_ld(&bar[XB_XGEN(b.x)]) == gen, bar);
            __builtin_amdgcn_fence(__ATOMIC_ACQUIRE, "agent");
            asm volatile("s_waitcnt vmcnt(0)" ::: "memory");
        }
    }
    __syncthreads();
}

namespace pg8 {
#define PG8_LAS __attribute__((address_space(3)))
typedef unsigned short bf16_t;
typedef short bf16x8 __attribute__((ext_vector_type(8)));
typedef float f32x4 __attribute__((ext_vector_type(4)));
typedef unsigned u32x4 __attribute__((ext_vector_type(4)));
constexpr int BM = 256, BK = 64, HALF = 128, HTB = HALF * BK * 2  , STAGE_BYTES = 8 * HTB, NXCD = 8, WGM = 8;

__host__ __device__ __forceinline__ int lds_byte(int r, int c) { const int st = (r >> 4) * 2 + (c >> 5), rr = r & 15, cc = c & 31, ob = rr * 64 + cc * 2; return st * 1024 + (ob ^ (((ob >> 9) & 1) << 5)); }
__host__ __device__ __forceinline__ void stage_rc(int b, int& R, int& C) { const int st = b / 1024, sb = b % 1024, swz = sb ^ (((sb >> 9) & 1) << 5); R = (st >> 1) * 16 + swz / 64; C = (st & 1) * 32 + (swz % 64) / 2; }
__host__ __device__ __forceinline__ int perm32(int rho) { const int n = rho >> 4, i = rho & 15; return 8 * (i >> 2) + 4 * n + (i & 3); }

struct Unit { int pm, pn; };
struct Gemm { const bf16_t* A; const bf16_t* Bt; int M, N, K; };

struct StaticOrder {
    int nM, nN, nwg, G, c;
    __host__ __device__ void init(int M, int N, int G_, int c_) { nM = M / BM; nN = N / BM; nwg = nM * nN; G = G_; c = c_; }
    __host__ __device__ bool next(int i, Unit& u) const {
        const long L = (long)i * G + c; if (L >= nwg) return false;
        int wgid = (int)L; { const int q = nwg / NXCD, r = nwg % NXCD, xcd = wgid % NXCD, off = wgid / NXCD; wgid = (xcd < r ? xcd * (q + 1) : r * (q + 1) + (xcd - r) * q) + off; }
        const int nig = WGM * nN, gid = wgid / nig, fm = gid * WGM, gsz = (nM - fm) < WGM ? (nM - fm) : WGM;
        u.pm = fm + ((wgid % nig) % gsz); u.pn = (wgid % nig) / gsz; return true;
    }
    __device__ __forceinline__ void a_ready(const Unit&) const {}
    __device__ __forceinline__ void done(const Unit&) const {}
};

__device__ __forceinline__ unsigned cvt_pk_bf16(float lo, float hi) { unsigned r; asm volatile("v_cvt_pk_bf16_f32 %0, %1, %2" : "=v"(r) : "v"(lo), "v"(hi)); return r; }
struct EpiBf16Plain {
    static constexpr bool PERM = true, AFTER_DRAIN = false;
    bf16_t* O; int ldc;
    __device__ __forceinline__ void operator()(const f32x4 (&acc)[2][2][4][2], const Unit& u, int wr, int wc, int fr, int fq) const {
        const int row0 = u.pm * BM + wr * 64 + fr, col0 = u.pn * BM + wc * 32 + 8 * fq;
#pragma unroll
        for (int ai = 0; ai < 2; ++ai)
#pragma unroll
            for (int m = 0; m < 4; ++m) { bf16_t* rowp = O + (size_t)(row0 + ai * HALF + m * 16) * ldc + col0;
#pragma unroll
                for (int bj = 0; bj < 2; ++bj) { const f32x4 v0 = acc[ai][bj][m][0], v1 = acc[ai][bj][m][1];
                    u32x4 w; w.x = cvt_pk_bf16(v0[0], v0[1]); w.y = cvt_pk_bf16(v0[2], v0[3]); w.z = cvt_pk_bf16(v1[0], v1[1]); w.w = cvt_pk_bf16(v1[2], v1[3]);
                    *(u32x4*)(rowp + bj * HALF) = w; } }
    }
};
struct EpiProj {
    static constexpr bool PERM = true, AFTER_DRAIN = false;
    bf16_t* O; int ldc; float* kmean; int kb_lo;
    __device__ __forceinline__ void operator()(const f32x4 (&acc)[2][2][4][2], const Unit& u, int wr, int wc, int fr, int fq) const {
        const int row0 = u.pm * BM + wr * 64 + fr, col0 = u.pn * BM + wc * 32 + 8 * fq;
#pragma unroll
        for (int ai = 0; ai < 2; ++ai)
#pragma unroll
            for (int m = 0; m < 4; ++m) { bf16_t* rowp = O + (size_t)(row0 + ai * HALF + m * 16) * ldc + col0;
#pragma unroll
                for (int bj = 0; bj < 2; ++bj) { const f32x4 v0 = acc[ai][bj][m][0], v1 = acc[ai][bj][m][1];
                    u32x4 w; w.x = cvt_pk_bf16(v0[0], v0[1]); w.y = cvt_pk_bf16(v0[2], v0[3]); w.z = cvt_pk_bf16(v1[0], v1[1]); w.w = cvt_pk_bf16(v1[2], v1[3]);
                    *(u32x4*)(rowp + bj * HALF) = w; } }
#pragma unroll
        for (int bj = 0; bj < 2; ++bj) {
            const int cb = u.pn * BM + bj * HALF;
            if (cb >= kb_lo && cb < kb_lo + 384) {
                f32x4 s0 = {0.f, 0.f, 0.f, 0.f}, s1 = {0.f, 0.f, 0.f, 0.f};
#pragma unroll
                for (int ai = 0; ai < 2; ++ai)
#pragma unroll
                    for (int m = 0; m < 4; ++m) { s0 += acc[ai][bj][m][0]; s1 += acc[ai][bj][m][1]; }
#pragma unroll
                for (int i = 0; i < 4; ++i) {
#pragma unroll
                    for (int o = 1; o < 16; o <<= 1) { s0[i] += __shfl_xor(s0[i], o); s1[i] += __shfl_xor(s1[i], o); }
                }
                if (fr == 0) {
                    const int c = cb + wc * 32 + 8 * fq - kb_lo, h = c >> 6, d = c & 63, b = u.pm >> 5, nb = u.pm & 31;
                    float* kp = kmean + ((size_t)((b * 6 + h) * 32 + nb)) * 64 + d;
#pragma unroll
                    for (int i = 0; i < 4; ++i) { atomicAdd(kp + i, s0[i]); atomicAdd(kp + 4 + i, s1[i]); }
                }
            }
        }
    }
};
struct EpiRes {
    static constexpr bool PERM = false, AFTER_DRAIN = false;
    const float* base; float* out; int ldc; const float* gate; int gstride;
    __device__ __forceinline__ void operator()(const f32x4 (&acc)[2][2][4][2], const Unit& u, int wr, int wc, int fr, int fq) const {
        const int row0 = u.pm * BM + wr * 64 + fr, col0 = u.pn * BM + wc * 32 + 4 * fq;
        const float* gp = gate + (size_t)(u.pm >> 5) * gstride + col0;
        f32x4 gv[2][2];
#pragma unroll
        for (int bj = 0; bj < 2; ++bj)
#pragma unroll
            for (int n = 0; n < 2; ++n) gv[bj][n] = *(const f32x4*)(gp + bj * HALF + n * 16);
#pragma unroll
        for (int ai = 0; ai < 2; ++ai)
#pragma unroll
            for (int m = 0; m < 4; ++m) { const size_t off = (size_t)(row0 + ai * HALF + m * 16) * ldc + col0;
#pragma unroll
                for (int bj = 0; bj < 2; ++bj)
#pragma unroll
                    for (int n = 0; n < 2; ++n) { const f32x4 bs = *(const f32x4*)(base + off + bj * HALF + n * 16);
                        *(f32x4*)(out + off + bj * HALF + n * 16) = bs + gv[bj][n] * acc[ai][bj][m][n]; } }
    }
};

template <class Epi, class Sched, bool ALIGN_EPI = false, bool SP2 = false>
__device__ __forceinline__ void gemm_phase(PG8_LAS unsigned char* lds, const Gemm g, const Sched& S, const Epi& E) {
    int tid_ = threadIdx.x; asm volatile("" : "+v"(tid_));
    const int tid = tid_, wid = __builtin_amdgcn_readfirstlane(tid >> 6), lane = tid & 63, wr = wid >> 2, wc = wid & 3, fr = lane & 15, fq = lane >> 4;
    const int K = g.K, nt = K / BK;
    unsigned voffA[2], voffB[2];
#pragma unroll
    for (int i = 0; i < 2; ++i) { int R, C; stage_rc(tid * 16 + i * 8192, R, C); const int Rb = Epi::PERM ? ((R & ~31) + perm32(R & 31)) : R;
        voffA[i] = (unsigned)(R * K + C) * 2u; voffB[i] = (unsigned)(Rb * K + C) * 2u; }
    const size_t kstep = (size_t)(BK * 2);
    const size_t hstep = (size_t)HALF * K * 2;
    const size_t tstep = 2 * hstep;
    const unsigned ldsw = (unsigned)wid * 1024u;
    const int aoff = lds_byte(wr * 64 + fr, fq * 8), boff = lds_byte(wc * 32 + fr, fq * 8);
#define PG8_SA(b, h) (((b) * 2 + (h)) * HTB)
#define PG8_SB(b, h) ((4 + (b) * 2 + (h)) * HTB)
#define PG8_STAGE(bufoff, gbase, voff) do { _Pragma("unroll") for (int _i = 0; _i < 2; ++_i) \
        __builtin_amdgcn_global_load_lds((const unsigned*)((const char*)(gbase) + (voff)[_i]), (PG8_LAS unsigned*)(lds + (bufoff) + ldsw + _i * 8192), 16, 0, 0); } while (0)
#define PG8_LDA(dst, b, h) do { _Pragma("unroll") for (int m = 0; m < 4; ++m) _Pragma("unroll") for (int k = 0; k < 2; ++k) dst[m][k] = *(const PG8_LAS bf16x8*)(lds + PG8_SA(b, h) + aoff + m * 2048 + k * 1024); } while (0)
#define PG8_LDB(dst, b, h) do { _Pragma("unroll") for (int n = 0; n < 2; ++n) _Pragma("unroll") for (int k = 0; k < 2; ++k) dst[n][k] = *(const PG8_LAS bf16x8*)(lds + PG8_SB(b, h) + boff + n * 2048 + k * 1024); } while (0)
#define PG8_MMA(ai, bj, At, Bt) do { __builtin_amdgcn_s_setprio(1); _Pragma("unroll") for (int m = 0; m < 4; ++m) _Pragma("unroll") for (int n = 0; n < 2; ++n) _Pragma("unroll") for (int k = 0; k < 2; ++k) \
        acc[ai][bj][m][n] = __builtin_amdgcn_mfma_f32_16x16x32_bf16(Bt[n][k], At[m][k], acc[ai][bj][m][n], 0, 0, 0); __builtin_amdgcn_s_setprio(0); } while (0)
#define PG8_WAIT_V(n) asm volatile("s_waitcnt vmcnt(" #n ")" ::: "memory")
#define PG8_WAIT_L(n) asm volatile("s_waitcnt lgkmcnt(" #n ")" ::: "memory")
#define PG8_BAR __builtin_amdgcn_s_barrier()
#define PG8_SCHED __builtin_amdgcn_sched_barrier(0)
    Unit cur, nxt; int ui = 0;
    if (!S.next(0, cur)) return;
    f32x4 acc[2][2][4][2];
#pragma unroll
    for (int a = 0; a < 2; ++a)
#pragma unroll
        for (int b = 0; b < 2; ++b)
#pragma unroll
            for (int m = 0; m < 4; ++m)
#pragma unroll
                for (int n = 0; n < 2; ++n) acc[a][b][m][n] = (f32x4){0.f, 0.f, 0.f, 0.f};
    bf16x8 At[4][2], B0[2][2], B1[2][2];
    const char* cA = (const char*)g.A + (size_t)cur.pm * tstep; const char* cB = (const char*)g.Bt + (size_t)cur.pn * tstep;
    S.a_ready(cur);
    if constexpr (SP2) {
        PG8_STAGE(PG8_SB(0, 0), cB, voffB); PG8_STAGE(PG8_SB(0, 1), cB + hstep, voffB); PG8_STAGE(PG8_SA(0, 0), cA, voffA); PG8_STAGE(PG8_SA(0, 1), cA + hstep, voffA);
        if (wr == 1) PG8_BAR;
        PG8_WAIT_V(2); PG8_BAR;
        PG8_STAGE(PG8_SB(1, 0), cB + kstep, voffB); PG8_STAGE(PG8_SA(1, 0), cA + kstep, voffA); PG8_STAGE(PG8_SB(1, 1), cB + hstep + kstep, voffB);
        PG8_WAIT_V(6); PG8_BAR;
    } else {
        PG8_STAGE(PG8_SB(0, 0), cB, voffB); PG8_STAGE(PG8_SA(0, 0), cA, voffA); PG8_STAGE(PG8_SB(0, 1), cB + hstep, voffB); PG8_STAGE(PG8_SA(0, 1), cA + hstep, voffA);
        if (wr == 1) PG8_BAR;
        PG8_WAIT_V(4); PG8_BAR;
        PG8_STAGE(PG8_SB(1, 0), cB + kstep, voffB); PG8_STAGE(PG8_SA(1, 0), cA + kstep, voffA); PG8_STAGE(PG8_SB(1, 1), cB + hstep + kstep, voffB);
        PG8_WAIT_V(6); PG8_BAR;
    }
    for (;;) {
        const bool has_next = S.next(ui + 1, nxt);
        const char* nA = has_next ? (const char*)g.A + (size_t)nxt.pm * tstep : cA; const char* nB = has_next ? (const char*)g.Bt + (size_t)nxt.pn * tstep : cB;
        for (int t = 0; t < nt; t += 2) {
            const bool last = (t == nt - 2);
            const char* a1 = cA + (size_t)(t + 1) * kstep;
            const char* a2 = last ? nA : cA + (size_t)(t + 2) * kstep; const char* b2 = last ? nB : cB + (size_t)(t + 2) * kstep;
            const char* a3 = a2 + kstep; const char* b3 = b2 + kstep;
            if (last && has_next) S.a_ready(nxt);
            if constexpr (SP2) {
            PG8_LDB(B0, 0, 0); PG8_LDB(B1, 0, 1); PG8_SCHED; PG8_LDA(At, 0, 0); PG8_STAGE(PG8_SA(1, 1), a1 + hstep, voffA);
            PG8_WAIT_V(8); PG8_WAIT_L(0); PG8_BAR; PG8_MMA(0, 0, At, B0); PG8_MMA(0, 1, At, B1); PG8_BAR; PG8_SCHED;
            PG8_LDA(At, 0, 1); PG8_STAGE(PG8_SB(0, 0), b2, voffB); PG8_STAGE(PG8_SB(0, 1), b2 + hstep, voffB); PG8_STAGE(PG8_SA(0, 0), a2, voffA);
            PG8_WAIT_V(8); PG8_WAIT_L(0); PG8_BAR; PG8_MMA(1, 0, At, B0); PG8_MMA(1, 1, At, B1); PG8_BAR; PG8_SCHED;
            PG8_LDB(B0, 1, 0); PG8_LDB(B1, 1, 1); PG8_SCHED; PG8_LDA(At, 1, 0); PG8_STAGE(PG8_SA(0, 1), a2 + hstep, voffA);
            PG8_WAIT_V(8); PG8_WAIT_L(0); PG8_BAR; PG8_MMA(0, 0, At, B0); PG8_MMA(0, 1, At, B1); PG8_BAR; PG8_SCHED;
            PG8_LDA(At, 1, 1); PG8_STAGE(PG8_SB(1, 0), b3, voffB); PG8_STAGE(PG8_SB(1, 1), b3 + hstep, voffB); PG8_STAGE(PG8_SA(1, 0), a3, voffA);
            PG8_WAIT_V(8); PG8_WAIT_L(0); PG8_BAR; PG8_MMA(1, 0, At, B0); PG8_MMA(1, 1, At, B1); PG8_BAR; PG8_SCHED;
            } else {
            PG8_LDB(B0, 0, 0); PG8_SCHED; PG8_LDA(At, 0, 0); PG8_STAGE(PG8_SA(1, 1), a1 + hstep, voffA);
            PG8_WAIT_L(8); PG8_BAR; PG8_WAIT_L(0); PG8_MMA(0, 0, At, B0); PG8_BAR; PG8_SCHED;
            PG8_LDB(B1, 0, 1); PG8_STAGE(PG8_SB(0, 0), b2, voffB);
            PG8_BAR; PG8_WAIT_L(0); PG8_MMA(0, 1, At, B1); PG8_BAR;
            PG8_LDA(At, 0, 1); PG8_STAGE(PG8_SA(0, 0), a2, voffA);
            PG8_BAR; PG8_WAIT_L(0); PG8_MMA(1, 0, At, B0); PG8_BAR; PG8_SCHED;
            PG8_STAGE(PG8_SB(0, 1), b2 + hstep, voffB);
            PG8_WAIT_V(6); PG8_BAR; PG8_MMA(1, 1, At, B1); PG8_BAR;
            PG8_LDB(B0, 1, 0); PG8_SCHED; PG8_LDA(At, 1, 0); PG8_STAGE(PG8_SA(0, 1), a2 + hstep, voffA);
            PG8_WAIT_L(8); PG8_BAR; PG8_WAIT_L(0); PG8_MMA(0, 0, At, B0); PG8_BAR; PG8_SCHED;
            PG8_LDB(B1, 1, 1); PG8_STAGE(PG8_SB(1, 0), b3, voffB);
            PG8_BAR; PG8_WAIT_L(0); PG8_MMA(0, 1, At, B1); PG8_BAR;
            PG8_LDA(At, 1, 1); PG8_STAGE(PG8_SA(1, 0), a3, voffA);
            PG8_BAR; PG8_WAIT_L(0); PG8_MMA(1, 0, At, B0); PG8_BAR; PG8_SCHED;
            PG8_STAGE(PG8_SB(1, 1), b3 + hstep, voffB);
            PG8_WAIT_V(6); PG8_BAR; PG8_MMA(1, 1, At, B1); PG8_BAR;
            }
        }
        if constexpr (ALIGN_EPI) { if (wr == 0) PG8_BAR; }
        if constexpr (!Epi::AFTER_DRAIN) { E(acc, cur, wr, wc, fr, fq); S.done(cur); }
        if (!has_next) break;
#pragma unroll
        for (int a = 0; a < 2; ++a)
#pragma unroll
            for (int b = 0; b < 2; ++b)
#pragma unroll
                for (int m = 0; m < 4; ++m)
#pragma unroll
                    for (int n = 0; n < 2; ++n) acc[a][b][m][n] = (f32x4){0.f, 0.f, 0.f, 0.f};
        cur = nxt; cA = nA; cB = nB; ++ui;
        if constexpr (ALIGN_EPI) { if (wr == 1) PG8_BAR; }
    }
    PG8_WAIT_V(0);
    if constexpr (!ALIGN_EPI) { if (wr == 0) PG8_BAR; }
    PG8_BAR;
    if constexpr (Epi::AFTER_DRAIN) { E.fused(acc, cur, wr, wc, fr, fq, lds, wid, lane); S.done(cur); }
#undef PG8_SA
#undef PG8_SB
#undef PG8_STAGE
#undef PG8_LDA
#undef PG8_LDB
#undef PG8_MMA
#undef PG8_WAIT_V
#undef PG8_WAIT_L
#undef PG8_BAR
#undef PG8_SCHED
}
}
namespace att {
constexpr int A_K = 0, A_V = 16384, A_WSF = 32768, A_KM = A_WSF + 2048, A_STG = A_KM + 8192;
constexpr int STG_STRIDE = 68, STG_WAVE_BYTES = 32 * STG_STRIDE * 4, A_END = A_STG + NWAVES * STG_WAVE_BYTES;
__device__ __forceinline__ int crow(int r, int hi) { return (r & 3) + 8 * (r >> 2) + 4 * hi; }
__device__ __forceinline__ void dma16(const void* g, LAS unsigned char* l) { __builtin_amdgcn_global_load_lds((const unsigned*)g, (LAS unsigned*)l, 16, 0, 0); }
typedef float f32x2_t __attribute__((ext_vector_type(2))); typedef __bf16 bf16x2_t __attribute__((ext_vector_type(2)));
__device__ __forceinline__ unsigned cvtpk(float lo, float hi) { f32x2_t v = {lo, hi}; bf16x2_t b = __builtin_convertvector(v, bf16x2_t); return __builtin_bit_cast(unsigned, b); }
typedef short v4i16_t __attribute__((ext_vector_type(4)));
__device__ __forceinline__ s16x4_t vtr(LAS const unsigned char* p) { return __builtin_bit_cast(s16x4_t, __builtin_amdgcn_ds_read_tr16_b64_v4i16((LAS v4i16_t*)p)); }
#define LDSW() asm volatile("s_waitcnt lgkmcnt(0)" ::: "memory")

template <int MODE>
__device__ __forceinline__ void attn_unit(int b, int h, int qb, const bf16_t* __restrict__ proj, bf16_t* __restrict__ Obuf, const float* __restrict__ kmean,
                                          float lam, float lam_init, const float* __restrict__ subg, const float* sinkp, int dlim, LAS unsigned char* lds) {
    constexpr int NMAP = (MODE == 0) ? 2 : 1;
    int tid_ = threadIdx.x; asm volatile("" : "+v"(tid_));
    const int tid = tid_, lane = tid & 63, r32 = lane & 31, hi = lane >> 5;
    const int wid = __builtin_amdgcn_readfirstlane(tid >> 6);
    const int q0 = qb * 256;
    int qcol, kcol, vcol, ocol; float slope;
    if (MODE == 0) { qcol = OFF_QA + h * 64; kcol = OFF_KA + h * 64; vcol = OFF_VA + h * 64; ocol = h * 64; slope = alibi_slope(6 + h); }
    else if (MODE == 1) { qcol = OFF_QB + h * 64; kcol = OFF_KB + h * 64; vcol = OFF_VB + h * 64; ocol = 256 + h * 64; slope = alibi_slope(10 + h); }
    else { qcol = OFF_QC + h * 64; kcol = OFF_KC + (h / 3) * 64; vcol = OFF_VC + (h / 3) * 64; ocol = 640 + h * 64; slope = alibi_slope(h); }
    const float slope2 = slope * LOG2E;
    const float cscale = (MODE == 0 ? 0.17677669529663687f : 0.125f) * LOG2E;
    const bf16_t* base = proj + (size_t)b * SEQ * INW;
    const int t_hi = 4 * qb + 4, t_lo = (MODE == 2) ? (qb > 0 ? 4 * qb - 2 : 0) : ((MODE == 0 && q0 > dlim) ? (q0 - dlim) / 64 : 0);
    const bf16_t* ksrc = base + kcol + (size_t)lane * INW + wid * 8;
    const bf16_t* vsrc = base + vcol + (size_t)(16 * (wid & 3) + (lane >> 2)) * INW + (wid >> 2) * 32 + (lane & 3) * 8;
#define DMA_TILE(t, bufi) do { dma16(ksrc + (size_t)(t) * 64 * INW, lds + A_K + (bufi) * 8192 + wid * 1024); dma16(vsrc + (size_t)(t) * 64 * INW, lds + A_V + (bufi) * 8192 + wid * 1024); } while (0)
    DMA_TILE(t_lo, 0);
    const bf16_t* Qw = base + (size_t)(q0 + wid * 32 + r32) * INW + qcol;
    bf16x8_t qr[4];
#pragma unroll
    for (int d0 = 0; d0 < 4; ++d0) qr[d0] = *(const bf16x8_t*)(Qw + d0 * 16 + hi * 8);
    const int qrel = wid * 32 + r32;
    const LAS unsigned char* qlds = lds + A_STG + wid * STG_WAVE_BYTES + lane * 16;
    if (MODE == 0) {
#pragma unroll
        for (int d0 = 0; d0 < 4; ++d0) *(LAS bf16x8_t*)(lds + A_STG + wid * STG_WAVE_BYTES + lane * 16 + d0 * 1024) = qr[d0];
    }
    unsigned rowmask = 0u;
    if (MODE == 1) {
        LAS float* km = (LAS float*)(lds + A_KM);
        const float* kmg = kmean + (size_t)((b * 6 + h) * 32) * 64;
        for (int i = tid; i < 2048; i += NTHREADS) km[i] = kmg[i] * (1.0f / 256.0f);
        __syncthreads();
        if (qb > 0) {
            float qf[32];
#pragma unroll
            for (int d0 = 0; d0 < 4; ++d0)
#pragma unroll
                for (int j = 0; j < 8; ++j) qf[d0 * 8 + j] = __builtin_bit_cast(float, ((unsigned)(unsigned short)qr[d0][j]) << 16);
            float v0 = -INFINITY, v1 = -INFINITY, v2 = -INFINITY; int i0 = 0, i1 = 0, i2 = 0;
            for (int n = 0; n < qb; ++n) {
                const LAS float* kp = km + n * 64 + 8 * hi;
                float part = 0.f;
#pragma unroll
                for (int d0 = 0; d0 < 4; ++d0) {
                    const f32x4_t a = *(const LAS f32x4_t*)(kp + d0 * 16), c = *(const LAS f32x4_t*)(kp + d0 * 16 + 4);
                    part += qf[d0 * 8 + 0] * a[0]; part += qf[d0 * 8 + 1] * a[1]; part += qf[d0 * 8 + 2] * a[2]; part += qf[d0 * 8 + 3] * a[3];
                    part += qf[d0 * 8 + 4] * c[0]; part += qf[d0 * 8 + 5] * c[1]; part += qf[d0 * 8 + 6] * c[2]; part += qf[d0 * 8 + 7] * c[3];
                }
                const float tot = part + swap32_partner(part, hi);
                if (tot > v0) { v2 = v1; i2 = i1; v1 = v0; i1 = i0; v0 = tot; i0 = n; }
                else if (tot > v1) { v2 = v1; i2 = i1; v1 = tot; i1 = n; }
                else if (tot > v2) { v2 = tot; i2 = n; }
            }
            if (v0 > -INFINITY) rowmask |= 1u << i0;
            if (v1 > -INFINITY) rowmask |= 1u << i1;
            if (v2 > -INFINITY) rowmask |= 1u << i2;
        }
    }
    float m_[NMAP], l_[NMAP]; f32x16_t o[NMAP][2];
#pragma unroll
    for (int mi = 0; mi < NMAP; ++mi) { m_[mi] = -INFINITY; l_[mi] = 0.f;
#pragma unroll
        for (int d0 = 0; d0 < 2; ++d0)
#pragma unroll
            for (int r = 0; r < 16; ++r) o[mi][d0][r] = 0.f; }
    LAS float* wsf = (LAS float*)(lds + A_WSF) + wid * 64;
    const int vlane = ((lane >> 4) & 1) * 32 + (lane & 3) * 8 + (4 * hi + ((lane & 15) >> 2)) * 64;

    for (int t = t_lo; t < t_hi; ++t) {
        const int bufi = (t - t_lo) & 1;
        asm volatile("s_waitcnt vmcnt(0)" ::: "memory");
        __syncthreads();
        if (t + 1 < t_hi) DMA_TILE(t + 1, bufi ^ 1);
        const int krel0 = 64 * t - q0;
        bool need = krel0 <= wid * 32 + 31;
        if (MODE == 2) need = need && (krel0 + 63 >= wid * 32 - 127);
        const bool past = (MODE == 1) && ((t >> 2) < qb);
        if (past) need = __any((int)((rowmask >> (t >> 2)) & 1u)) != 0;
        if (!need) continue;
        const bool diag = krel0 + 63 > wid * 32;
        const int kb = krel0 + 4 * hi;
        const LAS unsigned char* Ks = lds + A_K + bufi * 8192 + hi * 1024 + r32 * 16;
        const LAS unsigned char* Vs = lds + A_V + bufi * 8192 + vlane;
#pragma unroll
        for (int mi = 0; mi < NMAP; ++mi) {
            f32x16_t p0, p1;
#pragma unroll
            for (int r = 0; r < 16; ++r) { p0[r] = 0.f; p1[r] = 0.f; }
            constexpr int ND0 = (MODE == 0) ? 2 : 4;
#pragma unroll
            for (int dd = 0; dd < ND0; ++dd) {
                const int d0 = (MODE == 0) ? (2 * mi + dd) : dd;
                const bf16x8_t b0 = *(const LAS bf16x8_t*)(Ks + d0 * 2048);
                const bf16x8_t b1 = *(const LAS bf16x8_t*)(Ks + d0 * 2048 + 512);
                const bf16x8_t qa = (MODE == 0) ? *(const LAS bf16x8_t*)(qlds + d0 * 1024) : qr[d0];
                p0 = __builtin_amdgcn_mfma_f32_32x32x16_bf16(b0, qa, p0, 0, 0, 0);
                p1 = __builtin_amdgcn_mfma_f32_32x32x16_bf16(b1, qa, p1, 0, 0, 0);
            }
            float sl2 = slope2; asm volatile("" : "+v"(sl2));
            const float tb = sl2 * (float)kb;
#pragma unroll
            for (int r = 0; r < 16; ++r) { const int kk = (r & 3) + 8 * (r >> 2); const float bias = tb + sl2 * (float)kk;
                p0[r] = p0[r] * cscale + bias; p1[r] = p1[r] * cscale + (bias + sl2 * 32.0f); }
            if (diag) {
#pragma unroll
                for (int r = 0; r < 16; ++r) { const int kk = kb + (r & 3) + 8 * (r >> 2); if (kk > qrel) p0[r] = -INFINITY; if (kk + 32 > qrel) p1[r] = -INFINITY; }
            }
            if (MODE == 2) {
#pragma unroll
                for (int r = 0; r < 16; ++r) { const int kk = kb + (r & 3) + 8 * (r >> 2); if (qrel - kk >= 128) p0[r] = -INFINITY; if (qrel - (kk + 32) >= 128) p1[r] = -INFINITY; }
            }
            if (past) { if (!((rowmask >> (t >> 2)) & 1u)) {
#pragma unroll
                for (int r = 0; r < 16; ++r) { p0[r] = -INFINITY; p1[r] = -INFINITY; } } }
            float mx = fmaxf(p0[0], p1[0]);
#pragma unroll
            for (int r = 1; r < 16; ++r) mx = fmaxf(mx, fmaxf(p0[r], p1[r]));
            mx = fmaxf(mx, __shfl_xor(mx, 32));
            const float mnew = fmaxf(m_[mi], mx), msafe = (mnew == -INFINITY) ? 0.f : mnew;
            const float f = __builtin_amdgcn_exp2f(m_[mi] - msafe);
            float ps = 0.f;
#pragma unroll
            for (int r = 0; r < 16; ++r) { p0[r] = __builtin_amdgcn_exp2f(p0[r] - msafe); p1[r] = __builtin_amdgcn_exp2f(p1[r] - msafe); ps += p0[r] + p1[r]; }
            l_[mi] = l_[mi] * f + ps; m_[mi] = mnew;
            if (__any(f != 1.0f)) {
                if (hi == 0) wsf[mi * 32 + r32] = f;
                LDSW();
#pragma unroll
                for (int r = 0; r < 16; ++r) { const float fr_ = wsf[mi * 32 + crow(r, hi)]; o[mi][0][r] *= fr_; o[mi][1][r] *= fr_; }
            }
            u32x4_t pw[4];
#pragma unroll
            for (int j = 0; j < 4; ++j) { pw[0][j] = cvtpk(p0[2 * j], p0[2 * j + 1]); pw[1][j] = cvtpk(p0[8 + 2 * j], p0[8 + 2 * j + 1]);
                                          pw[2][j] = cvtpk(p1[2 * j], p1[2 * j + 1]); pw[3][j] = cvtpk(p1[8 + 2 * j], p1[8 + 2 * j + 1]); }
#pragma unroll
            for (int d0 = 0; d0 < 2; ++d0) {
                if (d0) __builtin_amdgcn_sched_barrier(0);
#pragma unroll
                for (int ks = 0; ks < 4; ++ks) {
                    const s16x4_t lo = vtr(Vs + d0 * 4096 + ks * 1024), hh = vtr(Vs + d0 * 4096 + ks * 1024 + 512);
                    const bf16x8_t vf = {lo[0], lo[1], lo[2], lo[3], hh[0], hh[1], hh[2], hh[3]};
                    o[mi][d0] = __builtin_amdgcn_mfma_f32_32x32x16_bf16(__builtin_bit_cast(bf16x8_t, pw[ks]), vf, o[mi][d0], 0, 0, 0);
                }
            }
            if (NMAP > 1) __builtin_amdgcn_sched_barrier(0);
        }
    }
#undef DMA_TILE
    float rl[NMAP][16];
#pragma unroll
    for (int mi = 0; mi < NMAP; ++mi) {
        float lt = l_[mi];
        lt += __shfl_xor(lt, 32);
        if (MODE == 2) lt += __builtin_amdgcn_exp2f(sinkp[0] * LOG2E + slope2 * (float)qrel - m_[mi]);
        if (hi == 0) wsf[mi * 32 + r32] = 1.0f / lt;
    }
    LDSW();
#pragma unroll
    for (int mi = 0; mi < NMAP; ++mi)
#pragma unroll
        for (int r = 0; r < 16; ++r) rl[mi][r] = wsf[mi * 32 + crow(r, hi)];
    LAS float* stg = (LAS float*)(lds + A_STG + wid * STG_WAVE_BYTES);
#pragma unroll
    for (int d0 = 0; d0 < 2; ++d0)
#pragma unroll
        for (int r = 0; r < 16; ++r) {
            float v = o[0][d0][r] * rl[0][r];
            if (MODE == 0) v -= lam * (o[NMAP - 1][d0][r] * rl[NMAP - 1][r]);
            stg[crow(r, hi) * STG_STRIDE + d0 * 32 + r32] = v;
        }
    LDSW();
    {
        const int row = lane >> 1, half = lane & 1;
        float v[32];
#pragma unroll
        for (int i = 0; i < 8; ++i) { const f32x4_t x = *(const LAS f32x4_t*)(stg + row * STG_STRIDE + half * 32 + i * 4); v[4 * i] = x[0]; v[4 * i + 1] = x[1]; v[4 * i + 2] = x[2]; v[4 * i + 3] = x[3]; }
        if (MODE == 0) {
            float ss = 0.f;
#pragma unroll
            for (int i = 0; i < 32; ++i) ss += v[i] * v[i];
            ss += __shfl_xor(ss, 1);
            const float rs = (1.0f / sqrtf(ss * (1.0f / 64.0f) + EPS)) * (1.0f - lam_init);
#pragma unroll
            for (int i = 0; i < 32; ++i) v[i] = v[i] * rs * subg[half * 32 + i];
        }
        bf16_t* op = Obuf + (size_t)(b * SEQ + q0 + wid * 32 + row) * DM + ocol + half * 32;
#pragma unroll
        for (int i = 0; i < 4; ++i) { u32x4_t w; w.x = cvtpk(v[8 * i], v[8 * i + 1]); w.y = cvtpk(v[8 * i + 2], v[8 * i + 3]); w.z = cvtpk(v[8 * i + 4], v[8 * i + 5]); w.w = cvtpk(v[8 * i + 6], v[8 * i + 7]);
            *(u32x4_t*)(op + 8 * i) = w; }
    }
    __syncthreads();
}
#undef LDSW
}

namespace att {
#define LDSW() asm volatile("s_waitcnt lgkmcnt(0)" ::: "memory")
__device__ __forceinline__ void gate_unit(int b, int h, int qb, const bf16_t* __restrict__ proj, const float* __restrict__ kmean, unsigned* __restrict__ RM, LAS unsigned char* lds) {
    int tid_ = threadIdx.x; asm volatile("" : "+v"(tid_));
    const int tid = tid_, lane = tid & 63, r32 = lane & 31, hi = lane >> 5;
    const int wid = __builtin_amdgcn_readfirstlane(tid >> 6);
    const int q0 = qb * 256;
    LAS float* km = (LAS float*)lds;
    const float* kmg = kmean + (size_t)((b * 6 + h) * 32) * 64;
    for (int i = tid; i < 2048; i += NTHREADS) km[i] = kmg[i] * (1.0f / 256.0f);
    __syncthreads();
    const bf16_t* Qw = proj + ((size_t)b * SEQ + q0 + wid * 32 + r32) * INW + OFF_QB + h * 64;
    float qf[32];
#pragma unroll
    for (int d0 = 0; d0 < 4; ++d0) { const bf16x8_t q = *(const bf16x8_t*)(Qw + d0 * 16 + hi * 8);
#pragma unroll
        for (int j = 0; j < 8; ++j) qf[d0 * 8 + j] = __builtin_bit_cast(float, ((unsigned)(unsigned short)q[j]) << 16); }
    float v0 = -INFINITY, v1 = -INFINITY, v2 = -INFINITY; int i0 = 0, i1 = 0, i2 = 0;
    for (int n = 0; n < qb; ++n) {
        const LAS float* kp = km + n * 64 + 8 * hi;
        float part = 0.f;
#pragma unroll
        for (int d0 = 0; d0 < 4; ++d0) {
            const f32x4_t a = *(const LAS f32x4_t*)(kp + d0 * 16), c = *(const LAS f32x4_t*)(kp + d0 * 16 + 4);
            part += qf[d0 * 8 + 0] * a[0]; part += qf[d0 * 8 + 1] * a[1]; part += qf[d0 * 8 + 2] * a[2]; part += qf[d0 * 8 + 3] * a[3];
            part += qf[d0 * 8 + 4] * c[0]; part += qf[d0 * 8 + 5] * c[1]; part += qf[d0 * 8 + 6] * c[2]; part += qf[d0 * 8 + 7] * c[3];
        }
        const float tot = part + __shfl_xor(part, 32);
        if (tot > v0) { v2 = v1; i2 = i1; v1 = v0; i1 = i0; v0 = tot; i0 = n; }
        else if (tot > v1) { v2 = v1; i2 = i1; v1 = tot; i1 = n; }
        else if (tot > v2) { v2 = tot; i2 = n; }
    }
    unsigned rowmask = 0u;
    if (v0 > -INFINITY) rowmask |= 1u << i0;
    if (v1 > -INFINITY) rowmask |= 1u << i1;
    if (v2 > -INFINITY) rowmask |= 1u << i2;
    if (hi == 0) RM[(size_t)(b * 6 + h) * SEQ + q0 + wid * 32 + r32] = rowmask;
    __syncthreads();
}

constexpr int B_K = 0, B_V = 32768, B_LIST = 65536, B_WSF = 81920, B_CNT = 83968, B_STG = 84032, B_STG_ROW = 72  , B_STG_WAVE = 32 * B_STG_ROW * 2;
__device__ __forceinline__ void moba_unit(int b, int h, int n, const bf16_t* __restrict__ proj, const unsigned* __restrict__ RM, bf16_t* __restrict__ Pbuf, float* __restrict__ ML, LAS unsigned char* lds) {
    int tid_ = threadIdx.x; asm volatile("" : "+v"(tid_));
    const int tid = tid_, lane = tid & 63, r32 = lane & 31, hi = lane >> 5;
    const int wid = __builtin_amdgcn_readfirstlane(tid >> 6);
    const float slope2 = alibi_slope(10 + h) * LOG2E, cscale = 0.125f * LOG2E;
    const bf16_t* base = proj + (size_t)b * SEQ * INW;
    {
        const bf16_t* ksrc = base + OFF_KB + h * 64 + (size_t)(256 * n + lane) * INW + wid * 8;
        const bf16_t* vsrc = base + OFF_VB + h * 64 + (size_t)(256 * n + 16 * (wid & 3) + (lane >> 2)) * INW + (wid >> 2) * 32 + (lane & 3) * 8;
#pragma unroll
        for (int tt = 0; tt < 4; ++tt) { dma16(ksrc + (size_t)tt * 64 * INW, lds + B_K + tt * 8192 + wid * 1024); dma16(vsrc + (size_t)tt * 64 * INW, lds + B_V + tt * 8192 + wid * 1024); }
    }
    volatile LAS int* cntp = (volatile LAS int*)(lds + B_CNT);
    LAS unsigned short* list = (LAS unsigned short*)(lds + B_LIST);
    if (tid == 0) cntp[0] = 0;
    __syncthreads();
    const unsigned* rm = RM + (size_t)(b * 6 + h) * SEQ;
    for (int s0 = 256 * (n + 1); s0 < SEQ; s0 += NTHREADS) {
        const int s = s0 + tid;
        const bool sel = (s < SEQ) && ((rm[s < SEQ ? s : 0] >> n) & 1u);
        const unsigned long long bal = __ballot(sel);
        if (bal) {
            const int total = __popcll(bal), prefix = __builtin_amdgcn_mbcnt_hi((unsigned)(bal >> 32), __builtin_amdgcn_mbcnt_lo((unsigned)bal, 0u));
            int wb = 0;
            if (lane == 0) wb = __hip_atomic_fetch_add((LAS int*)(lds + B_CNT), total, __ATOMIC_RELAXED, __HIP_MEMORY_SCOPE_WORKGROUP);
            wb = __builtin_amdgcn_readfirstlane(wb);
            if (sel) list[wb + prefix] = (unsigned short)s;
        }
    }
    asm volatile("s_waitcnt vmcnt(0)" ::: "memory");
    __syncthreads();
    const int C = cntp[0], NG = (C + 31) >> 5;
    LAS float* wsf = (LAS float*)(lds + B_WSF) + wid * 64;
    LAS unsigned short* stg = (LAS unsigned short*)(lds + B_STG + wid * B_STG_WAVE);
    const int vlane = ((lane >> 4) & 1) * 32 + (lane & 3) * 8 + (4 * hi + ((lane & 15) >> 2)) * 64;
    for (int item = wid; item < 8 + NG; item += 8) {
        const bool own = item < 8;
        int li = own ? 0 : 32 * (item - 8) + r32;
        const bool valid = own || (li < C);
        if (li >= C) li = C - 1;
        const int qidx = own ? (256 * n + 32 * item + r32) : (int)list[own ? 0 : li];
        const unsigned qmask = rm[qidx];
        const int slot = own ? 3 : __popc(qmask & ((1u << n) - 1u));
        const bf16_t* Qw = base + (size_t)qidx * INW + OFF_QB + h * 64;
        bf16x8_t qr[4];
#pragma unroll
        for (int d0 = 0; d0 < 4; ++d0) qr[d0] = *(const bf16x8_t*)(Qw + d0 * 16 + hi * 8);
        const int qrel = 32 * item + r32;
        float m_ = -INFINITY, l_ = 0.f; f32x16_t o[2];
#pragma unroll
        for (int d0 = 0; d0 < 2; ++d0)
#pragma unroll
            for (int r = 0; r < 16; ++r) o[d0][r] = 0.f;
        const int ntile = own ? ((32 * item + 31) / 64 + 1) : 4;
        for (int tt = 0; tt < ntile; ++tt) {
            const LAS unsigned char* Ks = lds + B_K + tt * 8192 + hi * 1024 + r32 * 16;
            const LAS unsigned char* Vs = lds + B_V + tt * 8192 + vlane;
            f32x16_t p0, p1;
#pragma unroll
            for (int r = 0; r < 16; ++r) { p0[r] = 0.f; p1[r] = 0.f; }
#pragma unroll
            for (int d0 = 0; d0 < 4; ++d0) {
                const bf16x8_t b0 = *(const LAS bf16x8_t*)(Ks + d0 * 2048);
                const bf16x8_t b1 = *(const LAS bf16x8_t*)(Ks + d0 * 2048 + 512);
                p0 = __builtin_amdgcn_mfma_f32_32x32x16_bf16(b0, qr[d0], p0, 0, 0, 0);
                p1 = __builtin_amdgcn_mfma_f32_32x32x16_bf16(b1, qr[d0], p1, 0, 0, 0);
            }
            float sl2 = slope2; asm volatile("" : "+v"(sl2));
            const int kb = 64 * tt + 4 * hi;
            const float tb = sl2 * (float)kb;
#pragma unroll
            for (int r = 0; r < 16; ++r) { const int kk = (r & 3) + 8 * (r >> 2); const float bias = tb + sl2 * (float)kk;
                p0[r] = p0[r] * cscale + bias; p1[r] = p1[r] * cscale + (bias + sl2 * 32.0f); }
            if (own && (64 * tt + 63 > 32 * item)) {
#pragma unroll
                for (int r = 0; r < 16; ++r) { const int kk = kb + (r & 3) + 8 * (r >> 2); if (kk > qrel) p0[r] = -INFINITY; if (kk + 32 > qrel) p1[r] = -INFINITY; }
            }
            float mx = fmaxf(p0[0], p1[0]);
#pragma unroll
            for (int r = 1; r < 16; ++r) mx = fmaxf(mx, fmaxf(p0[r], p1[r]));
            mx = fmaxf(mx, __shfl_xor(mx, 32));
            const float mnew = fmaxf(m_, mx), msafe = (mnew == -INFINITY) ? 0.f : mnew;
            const float f = __builtin_amdgcn_exp2f(m_ - msafe);
            float ps = 0.f;
#pragma unroll
            for (int r = 0; r < 16; ++r) { p0[r] = __builtin_amdgcn_exp2f(p0[r] - msafe); p1[r] = __builtin_amdgcn_exp2f(p1[r] - msafe); ps += p0[r] + p1[r]; }
            l_ = l_ * f + ps; m_ = mnew;
            if (__any(f != 1.0f)) {
                if (hi == 0) wsf[r32] = f;
                LDSW();
#pragma unroll
                for (int r = 0; r < 16; ++r) { const float fr_ = wsf[crow(r, hi)]; o[0][r] *= fr_; o[1][r] *= fr_; }
            }
            u32x4_t pw[4];
#pragma unroll
            for (int j = 0; j < 4; ++j) { pw[0][j] = cvtpk(p0[2 * j], p0[2 * j + 1]); pw[1][j] = cvtpk(p0[8 + 2 * j], p0[8 + 2 * j + 1]);
                                          pw[2][j] = cvtpk(p1[2 * j], p1[2 * j + 1]); pw[3][j] = cvtpk(p1[8 + 2 * j], p1[8 + 2 * j + 1]); }
#pragma unroll
            for (int d0 = 0; d0 < 2; ++d0)
#pragma unroll
                for (int ks = 0; ks < 4; ++ks) {
                    const s16x4_t lo = vtr(Vs + d0 * 4096 + ks * 1024), hh = vtr(Vs + d0 * 4096 + ks * 1024 + 512);
                    const bf16x8_t vf = {lo[0], lo[1], lo[2], lo[3], hh[0], hh[1], hh[2], hh[3]};
                    o[d0] = __builtin_amdgcn_mfma_f32_32x32x16_bf16(__builtin_bit_cast(bf16x8_t, pw[ks]), vf, o[d0], 0, 0, 0);
                }
        }
        float lt = l_ + __shfl_xor(l_, 32);
        if (hi == 0) wsf[r32] = 1.0f / lt;
        LDSW();
#pragma unroll
        for (int d0 = 0; d0 < 2; ++d0)
#pragma unroll
            for (int r = 0; r < 16; ++r) stg[crow(r, hi) * B_STG_ROW + d0 * 32 + r32] = (unsigned short)f2bf(o[d0][r] * wsf[crow(r, hi)]);
        const size_t pidx = (((size_t)b * SEQ + qidx) * 6 + h) * 4 + slot;
        if (hi == 0 && valid) { float2 mlv; mlv.x = m_ + slope2 * (float)(256 * n - qidx); mlv.y = lt; *(float2*)(ML + pidx * 2) = mlv; }
        LDSW();
        {
            const int row = lane >> 1, half = lane & 1;
            const int pk_own = valid ? (qidx | (slot << 16)) : -1;
            const int pk = __shfl(pk_own, row);
            if (pk >= 0) {
                bf16_t* dst = Pbuf + ((((size_t)b * SEQ + (pk & 0xffff)) * 6 + h) * 4 + (pk >> 16)) * 64 + half * 32;
#pragma unroll
                for (int i = 0; i < 4; ++i) *(u32x4_t*)(dst + 8 * i) = *(const LAS u32x4_t*)((const LAS unsigned char*)stg + row * (B_STG_ROW * 2) + half * 64 + i * 16);
            }
        }
        LDSW();
    }
    __syncthreads();
}

__device__ __forceinline__ void moba_combine(const bf16_t* __restrict__ Pbuf, const float* __restrict__ ML, bf16_t* __restrict__ Obuf, size_t gtid, size_t gth) {
    for (size_t idx = gtid; idx < (size_t)TOK * 48; idx += gth) {
        const int t = (int)(idx / 48), r = (int)(idx % 48), h = r >> 3, c = r & 7;
        const int qb = (t & (SEQ - 1)) >> 8, ns = qb < 3 ? qb : 3;
        const size_t pb = ((size_t)t * 6 + h) * 4;
        float m[4], l[4];
        { const float2 v = *(const float2*)(ML + (pb + 3) * 2); m[3] = v.x; l[3] = v.y; }
        float M = m[3];
#pragma unroll
        for (int i = 0; i < 3; ++i) { if (i < ns) { const float2 v = *(const float2*)(ML + (pb + i) * 2); m[i] = v.x; l[i] = v.y; M = fmaxf(M, m[i]); } else { m[i] = -INFINITY; l[i] = 0.f; } }
        float acc[8]; float wsum = 0.f;
#pragma unroll
        for (int j = 0; j < 8; ++j) acc[j] = 0.f;
#pragma unroll
        for (int i = 0; i < 4; ++i) {
            if (i == 3 || i < ns) {
                const float w = l[i] * __builtin_amdgcn_exp2f(m[i] - M); wsum += w;
                const u32x4_t v = *(const u32x4_t*)(Pbuf + (pb + i) * 64 + c * 8);
#pragma unroll
                for (int j = 0; j < 4; ++j) { acc[2 * j] += w * bf_lo(v[j]); acc[2 * j + 1] += w * bf_hi(v[j]); }
            }
        }
        const float inv = 1.0f / wsum;
        u32x4_t o; o.x = pk2(acc[0] * inv, acc[1] * inv); o.y = pk2(acc[2] * inv, acc[3] * inv); o.z = pk2(acc[4] * inv, acc[5] * inv); o.w = pk2(acc[6] * inv, acc[7] * inv);
        *(u32x4_t*)(Obuf + (size_t)t * DM + 256 + h * 64 + c * 8) = o;
    }
}

__device__ __forceinline__ void qknorm_unit(int b, int h, int chunk, const bf16_t* __restrict__ proj, unsigned* __restrict__ words  , int tid) {
    float mq = 0.f, mk = 0.f;
    for (int rr = tid; rr < 2048; rr += NTHREADS) {
        const int row = chunk * 1024 + (rr >> 1), mp = rr & 1;
        const bf16_t* p = proj + ((size_t)b * SEQ + row) * INW + h * 64 + mp * 32;
        float sq = 0.f, sk = 0.f;
#pragma unroll
        for (int j = 0; j < 4; ++j) { const u32x4_t a = *(const u32x4_t*)(p + OFF_QA + 8 * j), c = *(const u32x4_t*)(p + OFF_KA + 8 * j);
#pragma unroll
            for (int e = 0; e < 4; ++e) { const float a0 = bf_lo(a[e]), a1 = bf_hi(a[e]), c0 = bf_lo(c[e]), c1 = bf_hi(c[e]); sq += a0 * a0 + a1 * a1; sk += c0 * c0 + c1 * c1; } }
        mq = fmaxf(mq, sq); mk = fmaxf(mk, sk);
    }
#pragma unroll
    for (int o = 1; o < 64; o <<= 1) { mq = fmaxf(mq, __shfl_xor(mq, o)); mk = fmaxf(mk, __shfl_xor(mk, o)); }
    if ((tid & 63) == 0) { atomicMax(words + 0, __builtin_bit_cast(unsigned, mq)); atomicMax(words + 1, __builtin_bit_cast(unsigned, mk)); }
}
#undef LDSW
}

namespace peer {
constexpr int K_BYTES = 2 * 32768;
__device__ __forceinline__ int crow(int r, int hi) { return (r & 3) + 8 * (r >> 2) + 4 * hi; }

template <int N>
__device__ __forceinline__ void top16_pair(float (&s)[N], float (&out)[16], bool pair) {
#pragma unroll
    for (int it = 0; it < 16; ++it) {
        float mx = s[0];
#pragma unroll
        for (int i = 1; i < N; ++i) mx = fmaxf(mx, s[i]);
        if (pair) mx = fmaxf(mx, __shfl_xor(mx, 32));
        out[it] = mx;
#pragma unroll
        for (int i = 0; i < N; ++i) s[i] = (s[i] == mx) ? -INFINITY : s[i];
    }
}
__device__ __forceinline__ float pack_idx(float v, unsigned idx, unsigned mask) { return __builtin_bit_cast(float, (__builtin_bit_cast(unsigned, v) & ~mask) | idx); }
__device__ __forceinline__ unsigned byte16(unsigned t0, unsigned t1, unsigned t2, unsigned t3, unsigned i) {
    const unsigned s = i & 7u, a = __builtin_amdgcn_perm(t1, t0, s), b = __builtin_amdgcn_perm(t3, t2, s);
    return ((i & 8u) ? b : a) & 0xffu;
}

__device__ __forceinline__ void pk_unit(int tile, int h, const bf16_t* __restrict__ Q, const bf16_t* __restrict__ keysb, int* __restrict__ Eid, float* __restrict__ Gw, LAS unsigned char* lds) {
    int tid_ = threadIdx.x; asm volatile("" : "+v"(tid_));
    const int tid = tid_, lane = tid & 63, r32 = lane & 31, hi = lane >> 5;
    const int wid = __builtin_amdgcn_readfirstlane(tid >> 6);
    __syncthreads();
    {
        const bf16_t* kg = keysb + (size_t)h * 2 * 128 * 128;
        for (int i = tid; i < 2 * 128 * 16; i += NTHREADS) {
            const int n = i & 127, c = (i >> 7) & 15, p = i >> 11;
            const u32x4_t v = *(const u32x4_t*)(kg + ((size_t)(p * 128 + n)) * 128 + c * 8);
            *(LAS u32x4_t*)(lds + p * 32768 + c * 2048 + n * 16) = v;
        }
    }
    __syncthreads();
    const int tok = tile * 256 + wid * 32 + r32;
    float sv[2][16];
#pragma unroll
    for (int p = 0; p < 2; ++p) {
        const bf16_t* qp = Q + (size_t)tok * PQW + h * 256 + p * 128 + hi * 8;
        bf16x8_t qf[8];
#pragma unroll
        for (int ks = 0; ks < 8; ++ks) qf[ks] = *(const bf16x8_t*)(qp + ks * 16);
        float s[64];
#pragma unroll
        for (int blk = 0; blk < 4; ++blk) {
            f32x16_t acc;
#pragma unroll
            for (int r = 0; r < 16; ++r) acc[r] = 0.f;
#pragma unroll
            for (int ks = 0; ks < 8; ++ks) {
                const bf16x8_t kf = *(const LAS bf16x8_t*)(lds + p * 32768 + (2 * ks + hi) * 2048 + (blk * 32 + r32) * 16);
                acc = __builtin_amdgcn_mfma_f32_32x32x16_bf16(kf, qf[ks], acc, 0, 0, 0);
            }
#pragma unroll
            for (int r = 0; r < 16; ++r) s[blk * 16 + r] = pack_idx(acc[r], (unsigned)(blk * 32 + (r & 3) + 8 * (r >> 2) + 4 * hi), 127u);
        }
        top16_pair<64>(s, sv[p], true);
    }
    float cand[50];
    {
        int c = 0;
#pragma unroll
        for (int i = 0; i < 16; ++i)
#pragma unroll
            for (int j = 0; j < 16; ++j)
                if ((i + 1) * (j + 1) <= 16) { cand[c] = pack_idx(sv[0][i] + sv[1][j], (unsigned)(i * 16 + j), 255u); ++c; }
    }
    float top[16];
    top16_pair<50>(cand, top, false);
    unsigned t1[4], t2[4];
#pragma unroll
    for (int j = 0; j < 4; ++j) { t1[j] = 0u; t2[j] = 0u;
#pragma unroll
        for (int k = 0; k < 4; ++k) { t1[j] |= (__builtin_bit_cast(unsigned, sv[0][4 * j + k]) & 127u) << (8 * k); t2[j] |= (__builtin_bit_cast(unsigned, sv[1][4 * j + k]) & 127u) << (8 * k); } }
    float g[16]; int e[16]; float gs = 0.f;
#pragma unroll
    for (int k = 0; k < 16; ++k) {
        const unsigned code = __builtin_bit_cast(unsigned, top[k]) & 255u;
        e[k] = (int)(byte16(t1[0], t1[1], t1[2], t1[3], code >> 4) * 128u + byte16(t2[0], t2[1], t2[2], t2[3], code & 15u));
        g[k] = __expf(top[k] - top[0]); gs += g[k];
    }
    const float gi = 1.0f / gs;
    if (hi == 0) {
        int* ep = Eid + ((size_t)tok * PHEADS + h) * 16; float* gp = Gw + ((size_t)tok * PHEADS + h) * 16;
#pragma unroll
        for (int k = 0; k < 16; k += 4) {
            *(int4*)(ep + k) = make_int4(e[k], e[k + 1], e[k + 2], e[k + 3]);
            *(float4*)(gp + k) = make_float4(g[k] * gi, g[k + 1] * gi, g[k + 2] * gi, g[k + 3] * gi);
        }
    }
}

__device__ __forceinline__ float reduce16(float (&a)[16], int lane) {
    float b8[8];
    { const bool up = lane & 1;
#pragma unroll
      for (int i = 0; i < 8; ++i) { const float keep = up ? a[8 + i] : a[i], give = up ? a[i] : a[8 + i]; b8[i] = keep + __shfl_xor(give, 1); } }
    float b4[4];
    { const bool up = lane & 2;
#pragma unroll
      for (int i = 0; i < 4; ++i) { const float keep = up ? b8[4 + i] : b8[i], give = up ? b8[i] : b8[4 + i]; b4[i] = keep + __shfl_xor(give, 2); } }
    float b2[2];
    { const bool up = lane & 4;
#pragma unroll
      for (int i = 0; i < 2; ++i) { const float keep = up ? b4[2 + i] : b4[i], give = up ? b4[i] : b4[2 + i]; b2[i] = keep + __shfl_xor(give, 4); } }
    float b1;
    { const bool up = lane & 8; const float keep = up ? b2[1] : b2[0], give = up ? b2[0] : b2[1]; b1 = keep + __shfl_xor(give, 8); }
    b1 += __shfl_xor(b1, 16); b1 += __shfl_xor(b1, 32);
    return b1;
}
__device__ __forceinline__ int red16_index(int lane) { return 8 * (lane & 1) + 4 * ((lane >> 1) & 1) + 2 * ((lane >> 2) & 1) + ((lane >> 3) & 1); }

typedef float f32x2_t __attribute__((ext_vector_type(2)));
__device__ __forceinline__ void pg_token(int tok, const float* xres, float* xdst, const LAS float* tab2  , const float* __restrict__ g2  , int gstride,
                                         const int* __restrict__ Eid, const float* __restrict__ Gw, const unsigned char* __restrict__ U8, const unsigned char* __restrict__ V8,
                                         const float* __restrict__ Us, const float* __restrict__ Vs,
                                         bool last, const LAS float* tabn  , const float* __restrict__ final_g, bf16_t* __restrict__ Hn, float* __restrict__ outp, int lane) {
    const int b = tok >> 13;
    float x[16];
    const float* xp = xres + (size_t)tok * DM + 16 * lane;
    float* xw = xdst + (size_t)tok * DM + 16 * lane;
#pragma unroll
    for (int q = 0; q < 4; ++q) { const f32x4_t a = *(const f32x4_t*)(xp + 4 * q); x[4 * q] = a[0]; x[4 * q + 1] = a[1]; x[4 * q + 2] = a[2]; x[4 * q + 3] = a[3]; }
    float ss = 0.f;
#pragma unroll
    for (int i = 0; i < 16; ++i) ss += x[i] * x[i];
    const float rstd = 1.0f / sqrtf(wave_sum(ss) * (1.0f / DM) + EPS);
    float hh[16];
#pragma unroll
    for (int q = 0; q < 4; ++q) { const f32x4_t g = *(const LAS f32x4_t*)(tab2 + (b * 2 + 0) * 1024 + 16 * lane + 4 * q), s = *(const LAS f32x4_t*)(tab2 + (b * 2 + 1) * 1024 + 16 * lane + 4 * q);
#pragma unroll
        for (int i = 0; i < 4; ++i) hh[4 * q + i] = x[4 * q + i] * rstd * g[i] + s[i]; }
    float out[16];
#pragma unroll
    for (int i = 0; i < 16; ++i) out[i] = 0.f;
    const int ridx = red16_index(lane);
#pragma unroll 1
    for (int hd = 0; hd < PHEADS; ++hd) {
        const size_t eb = ((size_t)tok * PHEADS + hd) * 16;
        const int ev = Eid[eb + (lane & 15)];
        const int er = Eid[eb + ridx];
        const float gv = Gw[eb + ridx];
        const float su = Us[er], sv = Vs[er];
        float a[16];
        {
            u32x4_t w[16];
#pragma unroll
            for (int k = 0; k < 16; ++k) { const int e = __builtin_amdgcn_readlane(ev, k); w[k] = *(const u32x4_t*)(U8 + (size_t)e * DM + 16 * lane); }
#pragma unroll
            for (int k = 0; k < 16; ++k) { float acc = 0.f;
#pragma unroll
                for (int q = 0; q < 4; ++q) { const f32x2_t lo = __builtin_amdgcn_cvt_pk_f32_fp8((int)w[k][q], false), hi2 = __builtin_amdgcn_cvt_pk_f32_fp8((int)w[k][q], true);
                    acc += hh[4 * q] * lo[0]; acc += hh[4 * q + 1] * lo[1]; acc += hh[4 * q + 2] * hi2[0]; acc += hh[4 * q + 3] * hi2[1]; }
                a[k] = acc; }
        }
        __builtin_amdgcn_sched_barrier(0);
        const float dot = reduce16(a, lane) * su;
        const float wgt = gv * sv * 0.5f * dot * (1.0f + erff(dot * 0.70710678118654752f));
        {
            u32x4_t w[16];
#pragma unroll
            for (int k = 0; k < 16; ++k) { const int e = __builtin_amdgcn_readlane(ev, k); w[k] = *(const u32x4_t*)(V8 + (size_t)e * DM + 16 * lane); }
#pragma unroll
            for (int k = 0; k < 16; ++k) {
                const int src = ((k >> 3) & 1) | (((k >> 2) & 1) << 1) | (((k >> 1) & 1) << 2) | ((k & 1) << 3);
                const float wk = __builtin_bit_cast(float, __builtin_amdgcn_readlane(__builtin_bit_cast(int, wgt), src));
#pragma unroll
                for (int q = 0; q < 4; ++q) { const f32x2_t lo = __builtin_amdgcn_cvt_pk_f32_fp8((int)w[k][q], false), hi2 = __builtin_amdgcn_cvt_pk_f32_fp8((int)w[k][q], true);
                    out[4 * q] += wk * lo[0]; out[4 * q + 1] += wk * lo[1]; out[4 * q + 2] += wk * hi2[0]; out[4 * q + 3] += wk * hi2[1]; }
            }
        }
    }
    float y[16]; float s2 = 0.f;
#pragma unroll
    for (int q = 0; q < 4; ++q) { const f32x4_t gg = *(const f32x4_t*)(g2 + (size_t)b * gstride + 16 * lane + 4 * q);
#pragma unroll
        for (int i = 0; i < 4; ++i) { y[4 * q + i] = x[4 * q + i] + gg[i] * out[4 * q + i]; s2 += y[4 * q + i] * y[4 * q + i]; } }
    const float rn = 1.0f / sqrtf(wave_sum(s2) * (1.0f / DM) + EPS);
    if (!last) {
#pragma unroll
        for (int q = 0; q < 4; ++q) *(f32x4_t*)(xw + 4 * q) = (f32x4_t){y[4 * q], y[4 * q + 1], y[4 * q + 2], y[4 * q + 3]};
        float z[16];
#pragma unroll
        for (int q = 0; q < 4; ++q) { const f32x4_t g = *(const LAS f32x4_t*)(tabn + (b * 2 + 0) * 1024 + 16 * lane + 4 * q), s = *(const LAS f32x4_t*)(tabn + (b * 2 + 1) * 1024 + 16 * lane + 4 * q);
#pragma unroll
            for (int i = 0; i < 4; ++i) z[4 * q + i] = y[4 * q + i] * rn * g[i] + s[i]; }
        bf16_t* hp = Hn + (size_t)tok * DM + 16 * lane;
#pragma unroll
        for (int j = 0; j < 2; ++j) { u32x4_t wv; wv.x = pk2(z[8 * j], z[8 * j + 1]); wv.y = pk2(z[8 * j + 2], z[8 * j + 3]); wv.z = pk2(z[8 * j + 4], z[8 * j + 5]); wv.w = pk2(z[8 * j + 6], z[8 * j + 7]); *(u32x4_t*)(hp + 8 * j) = wv; }
    } else {
        float* op = outp + (size_t)tok * DM + 16 * lane;
#pragma unroll
        for (int q = 0; q < 4; ++q) { const f32x4_t fg = *(const f32x4_t*)(final_g + 16 * lane + 4 * q);
            *(f32x4_t*)(op + 4 * q) = (f32x4_t){y[4 * q] * rn * fg[0], y[4 * q + 1] * rn * fg[1], y[4 * q + 2] * rn * fg[2], y[4 * q + 3] * rn * fg[3]}; }
    }
}
__device__ __forceinline__ void row_to_fp8(const float* src, unsigned char* dst, float* scale_out, int lane) {
    float v[16]; float mx = 0.f;
#pragma unroll
    for (int q = 0; q < 4; ++q) { const f32x4_t a = *(const f32x4_t*)(src + 16 * lane + 4 * q); v[4 * q] = a[0]; v[4 * q + 1] = a[1]; v[4 * q + 2] = a[2]; v[4 * q + 3] = a[3]; }
#pragma unroll
    for (int i = 0; i < 16; ++i) mx = fmaxf(mx, fabsf(v[i]));
#pragma unroll
    for (int o = 1; o < 64; o <<= 1) mx = fmaxf(mx, __shfl_xor(mx, o));
    const float sc = mx > 0.f ? 384.0f / mx : 1.0f;
    u32x4_t w;
#pragma unroll
    for (int q = 0; q < 4; ++q) { int t = 0; t = __builtin_amdgcn_cvt_pk_fp8_f32(v[4 * q] * sc, v[4 * q + 1] * sc, t, false); t = __builtin_amdgcn_cvt_pk_fp8_f32(v[4 * q + 2] * sc, v[4 * q + 3] * sc, t, true); w[q] = (unsigned)t; }
    *(u32x4_t*)(dst + 16 * lane) = w;
    if (lane == 0) *scale_out = mx > 0.f ? mx / 384.0f : 1.0f;
}
}

constexpr int LDS_MISC = 131072, LDS_BYTES = 131072 + 64;
constexpr int CW_BAR = 4096;
#ifndef REPMASK
#define REPMASK 0u
#endif
#define NREP(k) ((((REPMASK) >> (k)) & 1u) ? 2 : 1)
#define DBG_BASE 0
#ifndef ATM
#define ATM 7
#endif
#ifndef MK_N_LAUNCHES
#define MK_N_LAUNCHES 1
#endif
constexpr int PH_PER_LAYER = 9, N_PHASES = 2 + PH_PER_LAYER * DEPTH;

struct Args { const float* in[19]; float* out; unsigned char* ws; int ph_lo, ph_hi; };
enum { I_X = 0, I_C, I_N1G, I_N2G, I_WADA, I_BADA, I_WIN, I_WOUT, I_LQ1, I_LK1, I_LQ2, I_LK2, I_SUBG, I_SINK, I_PWQ, I_PKEYS, I_PU, I_PV, I_FG };

__device__ __forceinline__ void p0_transpose_item(const float* W, int K, int N, bf16_t* WT, LAS float* scr, int item, int lane) {
    const int nblk = N / 32, kb = item / nblk, nb = item % nblk, k0 = 64 * kb, n0 = 32 * nb;
#pragma unroll 8
    for (int i = 0; i < 32; ++i) { const int kk = 2 * i + (lane >> 5); scr[kk * 33 + (lane & 31)] = W[(size_t)(k0 + kk) * N + n0 + (lane & 31)]; }
    asm volatile("s_waitcnt lgkmcnt(0)" ::: "memory");
    const int c = lane & 7;
#pragma unroll
    for (int j = 0; j < 4; ++j) { const int n = (lane >> 3) + 8 * j; const LAS float* s = scr + (8 * c) * 33 + n;
        u32x4_t o; o.x = pk2(s[0 * 33], s[1 * 33]); o.y = pk2(s[2 * 33], s[3 * 33]); o.z = pk2(s[4 * 33], s[5 * 33]); o.w = pk2(s[6 * 33], s[7 * 33]);
        *(u32x4_t*)(WT + (size_t)(n0 + n) * K + k0 + 8 * c) = o; }
    asm volatile("s_waitcnt lgkmcnt(0)" ::: "memory");
}
__device__ __forceinline__ void cvt_rows(const float* src, bf16_t* dst, size_t n, size_t gtid, size_t gthreads) {
    for (size_t i = gtid * 8; i < n; i += gthreads * 8) {
        const f32x4_t a = *(const f32x4_t*)(src + i), c = *(const f32x4_t*)(src + i + 4);
        u32x4_t o; o.x = pk2(a[0], a[1]); o.y = pk2(a[2], a[3]); o.z = pk2(c[0], c[1]); o.w = pk2(c[2], c[3]);
        *(u32x4_t*)(dst + i) = o;
    }
}
__device__ __forceinline__ void build_table(LAS float* tab, const float* gvec, const float* mod_l, int sh_idx, int sc_idx) {
    for (int i = threadIdx.x; i < 4096; i += NTHREADS) { const int b = i >> 10, k = i & 1023;
        tab[(b * 2 + 0) * 1024 + k] = gvec[k] * (1.0f + mod_l[b * 6144 + sc_idx * 1024 + k]);
        tab[(b * 2 + 1) * 1024 + k] = mod_l[b * 6144 + sh_idx * 1024 + k]; }
}
__device__ __forceinline__ void norm_row(const float* xrow, bf16_t* orow, const LAS float* tab, int b, int lane) {
    const f32x4_t* xr = (const f32x4_t*)xrow + lane;
    f32x4_t v[4]; float s = 0.f;
#pragma unroll
    for (int j = 0; j < 4; ++j) { v[j] = xr[64 * j]; s += (v[j][0] * v[j][0] + v[j][1] * v[j][1]) + (v[j][2] * v[j][2] + v[j][3] * v[j][3]); }
    const float rstd = 1.0f / sqrtf(wave_sum(s) * (1.0f / DM) + EPS);
    unsigned long long* o8 = (unsigned long long*)orow + lane;
#pragma unroll
    for (int j = 0; j < 4; ++j) { const int k = 4 * lane + 256 * j;
        const f32x4_t g = *(const LAS f32x4_t*)(tab + (b * 2 + 0) * 1024 + k), sh = *(const LAS f32x4_t*)(tab + (b * 2 + 1) * 1024 + k);
        const f32x4_t y = v[j] * rstd * g + sh;
        o8[64 * j] = (unsigned long long)pk2(y[0], y[1]) | ((unsigned long long)pk2(y[2], y[3]) << 32); }
}

__global__ void __launch_bounds__(NTHREADS, 2) hymba_fwd(Args args) {
    extern __shared__ __attribute__((aligned(16))) unsigned char lds_raw[];
    LAS unsigned char* lds = (LAS unsigned char*)lds_raw;
    cg::grid_group grid = cg::this_grid();
    const int tid = threadIdx.x;
    const int wave = __builtin_amdgcn_readfirstlane(tid >> 6);
    const int G = gridDim.x, bx = blockIdx.x;
    const int gw = bx * NWAVES + wave, NGW = G * NWAVES;
    const int lo = args.ph_lo, hi_ = args.ph_hi;
#ifndef PHMASK
#define PHMASK 0xffffu
#endif
#define IN(k) (((PHMASK >> ((k) < 2 ? (k) : 2 + ((k) - 2) % PH_PER_LAYER)) & 1u) && lo <= (k) && (k) < hi_)
    if (tid < 16) ((volatile LAS unsigned*)(lds + LDS_MISC))[tid] = 0u;
    __syncthreads();
    (void)xcd_barrier_post((unsigned*)(args.ws + WS_CTL) + CW_BAR, (volatile LAS unsigned*)(lds + LDS_MISC));
#define SEAM(k) do { if (IN(k) && IN((k) + 1)) { if ((k) == 0) grid.sync(); else { XcdBarrier xb_; { size_t z_ = 0; asm volatile("" : "+s"(z_)); xb_.bar = (unsigned*)(args.ws + z_ + WS_CTL) + CW_BAR; } xb_.x = xb_xcc_id(); xb_.st = (volatile LAS unsigned*)(lds + LDS_MISC); xcd_barrier(xb_); } } } while (0)
#define PHASE_BEGIN() size_t wz_ = 0; asm volatile("" : "+s"(wz_)); unsigned char* ws = args.ws + wz_;     \
    int lane, ptid; { int t_ = threadIdx.x; asm volatile("" : "+v"(t_)); lane = t_ & 63; ptid = t_; } (void)lane; (void)ptid; \
    bf16_t* Wt_in = (bf16_t*)(ws + WS_WIN); bf16_t* Wt_out = (bf16_t*)(ws + WS_WOUT); bf16_t* Wt_q = (bf16_t*)(ws + WS_WQ); bf16_t* keysb = (bf16_t*)(ws + WS_KEYS); \
    float* modf = (float*)(ws + WS_MOD); float* kmean = (float*)(ws + WS_KMEAN); float* scal = (float*)(ws + WS_SCAL); \
    unsigned char* U8 = ws + WS_U; unsigned char* V8 = ws + WS_V; bf16_t* Hb = (bf16_t*)(ws + WS_H); \
    float* Us = (float*)(ws + WS_SCAL + 65536); float* Vs = (float*)(ws + WS_SCAL + 65536 + 262144); \
    bf16_t* Pj = (bf16_t*)(ws + WS_PROJ); bf16_t* Qp = (bf16_t*)(ws + WS_PROJ); bf16_t* Ob = (bf16_t*)(ws + WS_O); \
    int* Eid = (int*)(ws + WS_O); float* Gw = (float*)(ws + WS_O + 16 * MiB); unsigned* ctl = (unsigned*)(ws + WS_CTL); bf16_t* Pbuf = (bf16_t*)(ws + WS_PBUF); float* MLb = (float*)(ws + WS_ML); unsigned* RM = (unsigned*)(ws + WS_RM); (void)Pbuf; (void)MLb; (void)RM; \
    (void)Wt_in; (void)Wt_out; (void)Wt_q; (void)keysb; (void)modf; (void)kmean; (void)scal; (void)U8; (void)V8; (void)Hb; (void)Us; (void)Vs; (void)Pj; (void)Qp; (void)Ob; (void)Eid; (void)Gw; (void)ctl

    if (IN(0)) for (int rep = 0; rep < NREP(0); ++rep) {
        PHASE_BEGIN();
        if (bx < 192) {
            LAS float* cs = (LAS float*)lds;
            LAS float* red = (LAS float*)(lds + 16384);
            for (int i = tid; i < 4096; i += NTHREADS) { const float cv = args.in[I_C][i]; cs[i] = cv / (1.0f + __expf(-cv)); }
            __syncthreads();
            for (int it = bx; it < 192; it += G) {
                const int l = it / 96, n = (it % 96) * 64 + lane;
                const float* wp = args.in[I_WADA] + (size_t)l * DM * 6144 + n;
                float a0 = 0.f, a1 = 0.f, a2 = 0.f, a3 = 0.f;
#pragma unroll 8
                for (int k = wave * 128; k < wave * 128 + 128; ++k) { const float wv = wp[(size_t)k * 6144]; a0 += cs[k] * wv; a1 += cs[1024 + k] * wv; a2 += cs[2048 + k] * wv; a3 += cs[3072 + k] * wv; }
                red[(wave * 4 + 0) * 64 + lane] = a0; red[(wave * 4 + 1) * 64 + lane] = a1; red[(wave * 4 + 2) * 64 + lane] = a2; red[(wave * 4 + 3) * 64 + lane] = a3;
                __syncthreads();
                if (wave < 4) { float s = args.in[I_BADA][l * 6144 + n];
#pragma unroll
                    for (int w = 0; w < 8; ++w) s += red[(w * 4 + wave) * 64 + lane];
                    modf[((size_t)l * 4 + wave) * 6144 + n] = s; }
                __syncthreads();
            }
        }
        __syncthreads();
        {
            LAS float* scr = (LAS float*)(lds + wave * 16384);
            constexpr int I_IN = 16 * (INW / 32), I_OUT = 16 * (DM / 32), I_Q = 16 * (PQW / 32), PER_L = I_IN + I_OUT + I_Q;
            for (int it = gw; it < DEPTH * PER_L; it += NGW) {
                const int l = it / PER_L; int r = it % PER_L;
                if (r < I_IN) { p0_transpose_item(args.in[I_WIN] + (size_t)l * DM * INW, DM, INW, Wt_in + (size_t)l * INW * DM, scr, r, lane); continue; } r -= I_IN;
                if (r < I_OUT) { p0_transpose_item(args.in[I_WOUT] + (size_t)l * DM * DM, DM, DM, Wt_out + (size_t)l * DM * DM, scr, r, lane); continue; } r -= I_OUT;
                p0_transpose_item(args.in[I_PWQ] + (size_t)l * DM * PQW, DM, PQW, Wt_q + (size_t)l * PQW * DM, scr, r, lane);
            }
        }
        {
            const size_t gtid = (size_t)bx * NTHREADS + ptid, gth = (size_t)G * NTHREADS;
            cvt_rows(args.in[I_PKEYS], keysb, (size_t)DEPTH * PHEADS * 2 * 128 * 128, gtid, gth);
            for (int r = gw; r < 2 * DEPTH * PNEXP; r += NGW) { const int tb = r / (DEPTH * PNEXP), rr = r % (DEPTH * PNEXP);
                peer::row_to_fp8(args.in[tb ? I_PV : I_PU] + (size_t)rr * DM, (tb ? V8 : U8) + (size_t)rr * DM, (tb ? Vs : Us) + rr, lane); }
            for (size_t i = gtid; i < (size_t)DEPTH * 4 * 6 * 32 * 64; i += gth) kmean[i] = 0.f;
            if (gtid < DEPTH) { const int l = (int)gtid; float s1 = 0.f, s2 = 0.f;
                for (int i = 0; i < 32; ++i) { s1 += args.in[I_LQ1][l * 32 + i] * args.in[I_LK1][l * 32 + i]; s2 += args.in[I_LQ2][l * 32 + i] * args.in[I_LK2][l * 32 + i]; }
                const float lam_init = 0.8f - 0.6f * expf(-0.3f * (float)l);
                scal[l * 4 + 0] = expf(s1) - expf(s2) + lam_init; scal[l * 4 + 1] = lam_init; }
        }
    }
    SEAM(0);
    if (IN(1)) for (int rep = 0; rep < NREP(1); ++rep) {
        PHASE_BEGIN();
        LAS float* tab = (LAS float*)lds;
        build_table(tab, args.in[I_N1G], modf, 0, 1);
        __syncthreads();
        for (int m = gw; m < TOK; m += NGW) norm_row(args.in[I_X] + (size_t)m * DM, Hb + (size_t)m * DM, tab, m >> 13, lane);
        __syncthreads();
    }
    SEAM(1);

#pragma unroll 1
    for (int l = 0; l < DEPTH; ++l) {
        const int P = 2 + PH_PER_LAYER * l;
        if (IN(P + 0)) for (int rep = 0; rep < NREP(2); ++rep) {
            PHASE_BEGIN();
            pg8::Gemm g{Hb, Wt_in + (size_t)l * INW * DM, TOK, INW, DM}; pg8::StaticOrder S; S.init(TOK, INW, G, bx);
            pg8::EpiProj E{Pj, INW, kmean + (size_t)l * 4 * 6 * 32 * 64, rep == 0 ? OFF_KB : (1 << 28)};
            pg8::gemm_phase<pg8::EpiProj, pg8::StaticOrder, true, true>(lds, g, S, E);
        }
        SEAM(P + 0);
        if (IN(P + 1)) for (int rep = 0; rep < NREP(3); ++rep) {
            for (int u = bx; u < 768; u += G) { PHASE_BEGIN(); att::gate_unit((u % 24) / 6, u % 6, u / 24, Pj, kmean + (size_t)l * 4 * 6 * 32 * 64, RM, lds); }
            for (int u = bx; u < 128; u += G) { PHASE_BEGIN(); att::qknorm_unit(u >> 5, (u >> 3) & 3, u & 7, Pj, ctl + 2048 + ((rep * DEPTH + l) * 16 + (u >> 3)) * 2, ptid); }
        }
        SEAM(P + 1);
        if (IN(P + 2)) for (int rep = 0; rep < NREP(4); ++rep) {
            volatile LAS int* qw = (volatile LAS int*)(lds + LDS_MISC + 32);
#define NEXT_UNIT(mode) int idx; { PHASE_BEGIN(); if (tid == 0) qw[0] = (int)atomicAdd(ctl + 64 * ((rep * DEPTH + l) * 4 + (mode)), 1u); __syncthreads(); idx = qw[0]; }
            if (ATM & 1) for (;;) {
                NEXT_UNIT(0); if (idx >= 512) break;
                PHASE_BEGIN();
                const int qb = 31 - idx / 16, j = idx % 16;
                const unsigned* nw = ctl + 2048 + ((rep * DEPTH + l) * 16 + j) * 2;
                const float qn = sqrtf(__builtin_bit_cast(float, nw[0])), kn = sqrtf(__builtin_bit_cast(float, nw[1]));
                const float need = (40.0f + 0.17677669529663687f * LOG2E * qn * 2.0f * kn) / (alibi_slope(6 + (j & 3)) * LOG2E);
                const int dlim = need < 16384.0f ? (int)need + 1 : 16384;
                att::attn_unit<0>(j >> 2, j & 3, qb, Pj, Ob, nullptr, scal[l * 4 + 0], scal[l * 4 + 1], args.in[I_SUBG] + l * 64, nullptr, dlim, lds);
            }
            __syncthreads();
            if (ATM & 2) for (;;) {
                NEXT_UNIT(1); if (idx >= 768) break;
                PHASE_BEGIN();
                att::moba_unit((idx % 24) / 6, idx % 6, idx / 24, Pj, RM, Pbuf, MLb, lds);
            }
            __syncthreads();
            if (ATM & 4) for (;;) {
                NEXT_UNIT(2); if (idx >= 768) break;
                PHASE_BEGIN();
                const int qb = idx / 24, jj = idx % 24;
                att::attn_unit<2>(jj / 6, jj % 6, qb, Pj, Ob, nullptr, 0.f, 0.f, nullptr, args.in[I_SINK] + l * 6 + jj % 6, 0, lds);
            }
            __syncthreads();
#undef NEXT_UNIT
        }
        SEAM(P + 2);
        if (IN(P + 3)) for (int rep = 0; rep < NREP(5); ++rep) {
            PHASE_BEGIN();
            att::moba_combine(Pbuf, MLb, Ob, (size_t)bx * NTHREADS + ptid, (size_t)G * NTHREADS);
        }
        SEAM(P + 3);
        if (IN(P + 4)) for (int rep = 0; rep < NREP(6); ++rep) {
            PHASE_BEGIN();
            pg8::Gemm g{Ob, Wt_out + (size_t)l * DM * DM, TOK, DM, DM}; pg8::StaticOrder S; S.init(TOK, DM, G, bx);
            pg8::EpiRes E{(l == 0) ? args.in[I_X] : (const float*)args.out, (rep + 1 < NREP(6)) ? (float*)(ws + WS_PROJ) : args.out, DM, modf + (size_t)l * 4 * 6144 + 2 * 1024, 6144};
            pg8::gemm_phase<pg8::EpiRes, pg8::StaticOrder, true, true>(lds, g, S, E);
        }
        SEAM(P + 4);
        if (IN(P + 5)) for (int rep = 0; rep < NREP(7); ++rep) {
            PHASE_BEGIN();
            LAS float* tab = (LAS float*)lds;
            build_table(tab, args.in[I_N2G] + l * DM, modf + (size_t)l * 4 * 6144, 3, 4);
            __syncthreads();
            for (int m = gw; m < TOK; m += NGW) norm_row(args.out + (size_t)m * DM, Hb + (size_t)m * DM, tab, m >> 13, lane);
            __syncthreads();
        }
        SEAM(P + 5);
        if (IN(P + 6)) for (int rep = 0; rep < NREP(8); ++rep) {
            PHASE_BEGIN();
            pg8::Gemm g{Hb, Wt_q + (size_t)l * PQW * DM, TOK, PQW, DM}; pg8::StaticOrder S; S.init(TOK, PQW, G, bx);
            pg8::EpiBf16Plain E{Qp, PQW};
            pg8::gemm_phase<pg8::EpiBf16Plain, pg8::StaticOrder, true, true>(lds, g, S, E);
        }
        SEAM(P + 6);
        if (IN(P + 7)) for (int rep = 0; rep < NREP(9); ++rep) {
            PHASE_BEGIN();
            for (int u = bx; u < (TOK / 256) * PHEADS; u += G) peer::pk_unit(u >> 3, u & 7, Qp, keysb + (size_t)l * PHEADS * 2 * 128 * 128, Eid, Gw, lds);
            __syncthreads();
        }
        SEAM(P + 7);
        if (IN(P + 8)) for (int rep = 0; rep < NREP(10); ++rep) {
            PHASE_BEGIN();
            LAS float* tab2 = (LAS float*)lds; LAS float* tabn = (LAS float*)(lds + 32768);
            const bool last = (l == DEPTH - 1);
            const float* mod_l = modf + (size_t)l * 4 * 6144;
            build_table(tab2, args.in[I_N2G] + l * DM, mod_l, 3, 4);
            if (!last) build_table(tabn, args.in[I_N1G] + (l + 1) * DM, mod_l + 4 * 6144, 0, 1);
            __syncthreads();
            float* dry = (float*)(ws + WS_PROJ);
            for (int m = gw; m < TOK; m += NGW)
                peer::pg_token(m, args.out, (rep + 1 < NREP(10)) ? dry : args.out, tab2, mod_l + 5 * 1024, 6144, Eid, Gw, U8 + (size_t)l * PNEXP * DM, V8 + (size_t)l * PNEXP * DM, Us + l * PNEXP, Vs + l * PNEXP,
                                last, tabn, args.in[I_FG], Hb, (rep + 1 < NREP(10)) ? dry : args.out, lane);
            __syncthreads();
        }
        if (l + 1 < DEPTH) SEAM(P + 8);
    }
#undef IN
#undef SEAM
}

#ifdef DBG
__global__ void dbg_chk16(const bf16_t* p, size_t n, unsigned* flag, unsigned bit) {
    bool bad = false;
    for (size_t i = (size_t)blockIdx.x * blockDim.x + threadIdx.x; i < n; i += (size_t)gridDim.x * blockDim.x) bad |= ((p[i] & 0x7f80u) == 0x7f80u);
    if (bad) atomicOr(flag, bit);
}
__global__ void dbg_chk32(const float* p, size_t n, unsigned* flag, unsigned bit) {
    bool bad = false;
    for (size_t i = (size_t)blockIdx.x * blockDim.x + threadIdx.x; i < n; i += (size_t)gridDim.x * blockDim.x) bad |= ((__builtin_bit_cast(unsigned, p[i]) & 0x7f800000u) == 0x7f800000u);
    if (bad) atomicOr(flag, bit);
}
__global__ void dbg_chk_o(const bf16_t* p, unsigned* flag) {
    unsigned bad = 0;
    for (size_t i = (size_t)blockIdx.x * blockDim.x + threadIdx.x; i < (size_t)TOK * DM; i += (size_t)gridDim.x * blockDim.x) {
        if ((p[i] & 0x7f80u) == 0x7f80u) { const int c = (int)(i & 1023); const int r = (int)((i >> 10) & 8191); bad |= (c < 256) ? 1u : (c < 640 ? 2u : 4u); if (r < 256) bad |= 8u; if ((r & 255) < 32) bad |= 16u; if (p[i] & 0x7fu) bad |= 32u; }
    }
    if (bad) atomicOr(flag, bad);
}
__global__ void dbg_fill(float* out, size_t n, const unsigned* flag) {
    const unsigned f = *flag; if (f == 0u) return;
    const float c = sqrtf((float)f);
    for (size_t i = (size_t)blockIdx.x * blockDim.x + threadIdx.x; i < n; i += (size_t)gridDim.x * blockDim.x) out[i] = c;
}
#endif
extern "C" void kernel_launch(void* const* d_in, const int* in_sizes, int n_in, void* d_out, int out_size, void* d_ws, size_t ws_size, hipStream_t stream) {
    static int grid = 0;
    if (grid == 0) {
        if (n_in != 19 || out_size != TOK * DM || ws_size < WS_END) { fprintf(stderr, "kernel_launch: unexpected shapes (n_in %d out %d ws %zu)\n", n_in, out_size, ws_size); grid = -1; return; }
        int dev = 0, cus = 0, per_cu = 0;
        hipGetDevice(&dev); hipDeviceGetAttribute(&cus, hipDeviceAttributeMultiprocessorCount, dev);
        hipFuncSetAttribute((const void*)hymba_fwd, hipFuncAttributeMaxDynamicSharedMemorySize, LDS_BYTES);
        hipOccupancyMaxActiveBlocksPerMultiprocessor(&per_cu, (const void*)hymba_fwd, NTHREADS, LDS_BYTES);
        (void)hipGetLastError();
        if (per_cu < 1) per_cu = 1;
        if (per_cu > 1) per_cu = 1;
        grid = cus * per_cu;
        if (grid <= 0) grid = 256;
    }
    if (grid < 0) return;
    hipMemsetAsync((char*)d_ws + WS_CTL, 0, CTL_ZERO_BYTES, stream);
    Args a{};
    for (int i = 0; i < 19; ++i) a.in[i] = (const float*)d_in[i];
    a.out = (float*)d_out; a.ws = (unsigned char*)d_ws;
#if MK_N_LAUNCHES == 1
    a.ph_lo = 0; a.ph_hi = N_PHASES;
    void* kargs[] = {&a};
    hipError_t e = hipLaunchCooperativeKernel((const void*)hymba_fwd, dim3(grid), dim3(NTHREADS), kargs, LDS_BYTES, stream);
    if (e != hipSuccess) fprintf(stderr, "cooperative launch failed: %s (grid %d)\n", hipGetErrorString(e), grid);
#else
    for (int p = 0; p < N_PHASES; ++p) { a.ph_lo = p; a.ph_hi = p + 1; hipLaunchKernelGGL(hymba_fwd, dim3(grid), dim3(NTHREADS), LDS_BYTES, stream, a);
#ifdef DBG
        unsigned* flag = (unsigned*)((char*)d_ws + WS_CTL); unsigned char* w = (unsigned char*)d_ws;
        const int base = DBG_BASE;
        if (p == 3) dbg_chk_o<<<1024, 256, 0, stream>>>((const bf16_t*)(w + WS_O), flag);
#endif
    }
#ifdef DBG
    dbg_fill<<<1024, 256, 0, stream>>>((float*)d_out, (size_t)TOK * DM, (const unsigned*)((char*)d_ws + WS_CTL));
#endif
#endif
}
```

```cpp
#include <hip/hip_runtime.h>
#include <hip/hip_cooperative_groups.h>
#include <cstdio>
#include <cstdint>
#include <cmath>
namespace cg = cooperative_groups;

constexpr int DM = 1024, NBATCH = 4, SEQ = 8192, DEPTH = 2, TOK = NBATCH * SEQ;
constexpr int INW = 2560, NMOD = 6;
constexpr int OFF_QA = 0, OFF_KA = 256, OFF_VA = 512, OFF_QB = 768, OFF_KB = 1152, OFF_VB = 1536, OFF_QC = 1920, OFF_KC = 2304, OFF_VC = 2432;
constexpr int PHEADS = 8, PQW = 2048, PNK = 128, PNEXP = 16384, PTOPK = 16;
constexpr float EPS = 1e-6f;
constexpr float LOG2E = 1.4426950408889634f;
constexpr int NWAVES = 8, NTHREADS = 512;

constexpr size_t MiB = 1u << 20;
constexpr size_t WS_CTL = 0, CTL_ZERO_BYTES = 64 * 1024;
constexpr size_t WS_WIN = 1 * MiB;
constexpr size_t WS_WOUT = 11 * MiB;
constexpr size_t WS_WQ = 15 * MiB;
constexpr size_t WS_KEYS = 23 * MiB;
constexpr size_t WS_MOD = 24 * MiB;
constexpr size_t WS_KMEAN = 24 * MiB + 256 * 1024;
constexpr size_t WS_SCAL = 25 * MiB;
constexpr size_t WS_U = 26 * MiB;
constexpr size_t WS_V = 58 * MiB;
constexpr size_t WS_H = 90 * MiB;
constexpr size_t WS_PROJ = 154 * MiB;
constexpr size_t WS_O = 314 * MiB;
constexpr size_t WS_PBUF = 378 * MiB;
constexpr size_t WS_ML = 474 * MiB;
constexpr size_t WS_RM = 480 * MiB;
constexpr size_t WS_END = 482 * MiB;

#define GAS __attribute__((address_space(1)))
#define LAS __attribute__((address_space(3)))
typedef unsigned short bf16_t;
typedef short bf16x8_t __attribute__((ext_vector_type(8)));
typedef short s16x4_t __attribute__((ext_vector_type(4)));
typedef float f32x4_t __attribute__((ext_vector_type(4)));
typedef float f32x16_t __attribute__((ext_vector_type(16)));
typedef unsigned u32x4_t __attribute__((ext_vector_type(4)));
typedef unsigned u32x2_t __attribute__((ext_vector_type(2)));

__device__ __forceinline__ unsigned f2bf(float f) { unsigned u = __builtin_bit_cast(unsigned, f); return (u + 0x7fffu + ((u >> 16) & 1u)) >> 16; }
__device__ __forceinline__ unsigned pk2(float lo, float hi) { return f2bf(lo) | (f2bf(hi) << 16); }
__device__ __forceinline__ float bf_lo(unsigned w) { return __builtin_bit_cast(float, w << 16); }
__device__ __forceinline__ float bf_hi(unsigned w) { return __builtin_bit_cast(float, w & 0xffff0000u); }
__device__ __forceinline__ float wave_sum(float v) {
#pragma unroll
    for (int o = 1; o < 64; o <<= 1) v += __shfl_xor(v, o);
    return v;
}
__device__ __forceinline__ float swap32_partner(float v, int) { return __shfl_xor(v, 32); }
__device__ __forceinline__ float alibi_slope(int i) { return exp2f(-0.5f * (float)(i + 1)); }

typedef GAS unsigned gu32;
#define RLX_AGENT __ATOMIC_RELAXED, __HIP_MEMORY_SCOPE_AGENT
#define XB_TMO      128
#define XB_XCNT(j)  (256  + 64 * (j))
#define XB_XSUB(j)  (1280 + 64 * (j))
#define XB_XGEN(j)  (2304 + 64 * (j))
#define XB_TOP      3328
#define XB_TOPGEN   3392
#define XCD_BAR_WORDS 3456
#define XB_SPIN_CAP (1u << 18)

__device__ __forceinline__ unsigned xb_ld(unsigned* p)              { return __hip_atomic_load(p, __ATOMIC_RELAXED, __HIP_MEMORY_SCOPE_AGENT); }
__device__ __forceinline__ unsigned xb_add(unsigned* p, unsigned v) { return __hip_atomic_fetch_add(p, v, __ATOMIC_RELAXED, __HIP_MEMORY_SCOPE_AGENT); }
__device__ __forceinline__ unsigned xb_xcc_id() { return (unsigned)__builtin_amdgcn_s_getreg((3 << 11) | 20) & 0xFu; }
#define XB_SPIN(cond, bar) do { unsigned _sp = 0; while (cond) { __builtin_amdgcn_s_sleep(1); \
    if ((++_sp & 255u) == 0u) { if (xb_ld(&(bar)[XB_TMO])) break; if (_sp > XB_SPIN_CAP) { atomicAdd(&(bar)[XB_TMO], 1u); break; } } } } while (0)

struct XcdBarrier {
    unsigned* bar; unsigned x;
    volatile LAS unsigned* st;
};

__device__ __forceinline__ XcdBarrier xcd_barrier_post(unsigned* bar, volatile LAS unsigned* st) {
    XcdBarrier b; b.bar = bar; b.x = xb_xcc_id(); b.st = st;
    if (threadIdx.x == 0) (void)xb_add(&bar[XB_XCNT(b.x)], 1u);
    return b;
}
__device__ __forceinline__ void xcd_barrier_complete(unsigned* bar, unsigned x, unsigned& nloc, unsigned& nx) {
    const unsigned G = gridDim.x * gridDim.y * gridDim.z;
    unsigned sum, cnt, mine, sp = 0u;
    for (;;) {
        sum = 0u; cnt = 0u; mine = 0u;
#pragma unroll
        for (unsigned j = 0; j < 16; ++j) { const unsigned c = xb_ld(&bar[XB_XCNT(j)]); sum += c; cnt += (c > 0u) ? 1u : 0u; mine = (j == x) ? c : mine; }
        if (sum == G) break;
        __builtin_amdgcn_s_sleep(1);
        if ((++sp & 255u) == 0u) { if (xb_ld(&bar[XB_TMO])) break; if (sp > XB_SPIN_CAP) { atomicAdd(&bar[XB_TMO], 1u); break; } }
    }
    nloc = mine > 0u ? mine : 1u; nx = cnt > 0u ? cnt : 1u;
}

__device__ __forceinline__ void xcd_barrier(const XcdBarrier& b) {
    asm volatile("s_waitcnt vmcnt(0)" ::: "memory");
    __syncthreads();
    if (threadIdx.x == 0) {
        unsigned* bar = b.bar;
        __builtin_amdgcn_s_waitcnt(0);
        unsigned nloc = b.st[0], nx = b.st[1];
        if (nloc == 0u) { xcd_barrier_complete(bar, b.x, nloc, nx); b.st[0] = nloc; b.st[1] = nx; }
        const unsigned old = xb_add(&bar[XB_XSUB(b.x)], 1u);
        const unsigned gen = old / nloc;
        if (old + 1u == (gen + 1u) * nloc) {
            __builtin_amdgcn_fence(__ATOMIC_RELEASE, "agent");
            asm volatile("s_waitcnt vmcnt(0)" ::: "memory");
            const unsigned og = xb_add(&bar[XB_TOP], 1u);
            const unsigned tg = og / nx;
            if (og + 1u == (tg + 1u) * nx) xb_add(&bar[XB_TOPGEN], 1u);
            else XB_SPIN(xb_ld(&bar[XB_TOPGEN]) == tg, bar);
            __builtin_amdgcn_fence(__ATOMIC_ACQUIRE, "agent");
            xb_add(&bar[XB_XGEN(b.x)], 1u);
            asm volatile("s_waitcnt vmcnt(0)" ::: "memory");
        } else {
            XB_SPIN(xb_ld(&bar[XB_XGEN(b.x)]) == gen, bar);
            __builtin_amdgcn_fence(__ATOMIC_ACQUIRE, "agent");
            asm volatile("s_waitcnt vmcnt(0)" ::: "memory");
        }
    }
    __syncthreads();
}

namespace pg8 {
#define PG8_LAS __attribute__((address_space(3)))
typedef unsigned short bf16_t;
typedef short bf16x8 __attribute__((ext_vector_type(8)));
typedef float f32x4 __attribute__((ext_vector_type(4)));
typedef unsigned u32x4 __attribute__((ext_vector_type(4)));
constexpr int BM = 256, BK = 64, HALF = 128, HTB = HALF * BK * 2  , STAGE_BYTES = 8 * HTB, NXCD = 8, WGM = 8;

__host__ __device__ __forceinline__ int lds_byte(int r, int c) { const int st = (r >> 4) * 2 + (c >> 5), rr = r & 15, cc = c & 31, ob = rr * 64 + cc * 2; return st * 1024 + (ob ^ (((ob >> 9) & 1) << 5)); }
__host__ __device__ __forceinline__ void stage_rc(int b, int& R, int& C) { const int st = b / 1024, sb = b % 1024, swz = sb ^ (((sb >> 9) & 1) << 5); R = (st >> 1) * 16 + swz / 64; C = (st & 1) * 32 + (swz % 64) / 2; }
__host__ __device__ __forceinline__ int perm32(int rho) { const int n = rho >> 4, i = rho & 15; return 8 * (i >> 2) + 4 * n + (i & 3); }

struct Unit { int pm, pn; };
struct Gemm { const bf16_t* A; const bf16_t* Bt; int M, N, K; };

struct StaticOrder {
    int nM, nN, nwg, G, c;
    __host__ __device__ void init(int M, int N, int G_, int c_) { nM = M / BM; nN = N / BM; nwg = nM * nN; G = G_; c = c_; }
    __host__ __device__ bool next(int i, Unit& u) const {
        const long L = (long)i * G + c; if (L >= nwg) return false;
        int wgid = (int)L; { const int q = nwg / NXCD, r = nwg % NXCD, xcd = wgid % NXCD, off = wgid / NXCD; wgid = (xcd < r ? xcd * (q + 1) : r * (q + 1) + (xcd - r) * q) + off; }
        const int nig = WGM * nN, gid = wgid / nig, fm = gid * WGM, gsz = (nM - fm) < WGM ? (nM - fm) : WGM;
        u.pm = fm + ((wgid % nig) % gsz); u.pn = (wgid % nig) / gsz; return true;
    }
    __device__ __forceinline__ void a_ready(const Unit&) const {}
    __device__ __forceinline__ void done(const Unit&) const {}
};

__device__ __forceinline__ unsigned cvt_pk_bf16(float lo, float hi) { unsigned r; asm volatile("v_cvt_pk_bf16_f32 %0, %1, %2" : "=v"(r) : "v"(lo), "v"(hi)); return r; }
struct EpiBf16Plain {
    static constexpr bool PERM = true, AFTER_DRAIN = false;
    bf16_t* O; int ldc;
    __device__ __forceinline__ void operator()(const f32x4 (&acc)[2][2][4][2], const Unit& u, int wr, int wc, int fr, int fq) const {
        const int row0 = u.pm * BM + wr * 64 + fr, col0 = u.pn * BM + wc * 32 + 8 * fq;
#pragma unroll
        for (int ai = 0; ai < 2; ++ai)
#pragma unroll
            for (int m = 0; m < 4; ++m) { bf16_t* rowp = O + (size_t)(row0 + ai * HALF + m * 16) * ldc + col0;
#pragma unroll
                for (int bj = 0; bj < 2; ++bj) { const f32x4 v0 = acc[ai][bj][m][0], v1 = acc[ai][bj][m][1];
                    u32x4 w; w.x = cvt_pk_bf16(v0[0], v0[1]); w.y = cvt_pk_bf16(v0[2], v0[3]); w.z = cvt_pk_bf16(v1[0], v1[1]); w.w = cvt_pk_bf16(v1[2], v1[3]);
                    *(u32x4*)(rowp + bj * HALF) = w; } }
    }
};
struct EpiProj {
    static constexpr bool PERM = true, AFTER_DRAIN = false;
    bf16_t* O; int ldc; float* kmean; int kb_lo;
    __device__ __forceinline__ void operator()(const f32x4 (&acc)[2][2][4][2], const Unit& u, int wr, int wc, int fr, int fq) const {
        const int row0 = u.pm * BM + wr * 64 + fr, col0 = u.pn * BM + wc * 32 + 8 * fq;
#pragma unroll
        for (int ai = 0; ai < 2; ++ai)
#pragma unroll
            for (int m = 0; m < 4; ++m) { bf16_t* rowp = O + (size_t)(row0 + ai * HALF + m * 16) * ldc + col0;
#pragma unroll
                for (int bj = 0; bj < 2; ++bj) { const f32x4 v0 = acc[ai][bj][m][0], v1 = acc[ai][bj][m][1];
                    u32x4 w; w.x = cvt_pk_bf16(v0[0], v0[1]); w.y = cvt_pk_bf16(v0[2], v0[3]); w.z = cvt_pk_bf16(v1[0], v1[1]); w.w = cvt_pk_bf16(v1[2], v1[3]);
                    *(u32x4*)(rowp + bj * HALF) = w; } }
#pragma unroll
        for (int bj = 0; bj < 2; ++bj) {
            const int cb = u.pn * BM + bj * HALF;
            if (cb >= kb_lo && cb < kb_lo + 384) {
                f32x4 s0 = {0.f, 0.f, 0.f, 0.f}, s1 = {0.f, 0.f, 0.f, 0.f};
#pragma unroll
                for (int ai = 0; ai < 2; ++ai)
#pragma unroll
                    for (int m = 0; m < 4; ++m) { s0 += acc[ai][bj][m][0]; s1 += acc[ai][bj][m][1]; }
#pragma unroll
                for (int i = 0; i < 4; ++i) {
#pragma unroll
                    for (int o = 1; o < 16; o <<= 1) { s0[i] += __shfl_xor(s0[i], o); s1[i] += __shfl_xor(s1[i], o); }
                }
                if (fr == 0) {
                    const int c = cb + wc * 32 + 8 * fq - kb_lo, h = c >> 6, d = c & 63, b = u.pm >> 5, nb = u.pm & 31;
                    float* kp = kmean + ((size_t)((b * 6 + h) * 32 + nb)) * 64 + d;
#pragma unroll
                    for (int i = 0; i < 4; ++i) { atomicAdd(kp + i, s0[i]); atomicAdd(kp + 4 + i, s1[i]); }
                }
            }
        }
    }
};
struct EpiRes {
    static constexpr bool PERM = false, AFTER_DRAIN = false;
    const float* base; float* out; int ldc; const float* gate; int gstride;
    __device__ __forceinline__ void operator()(const f32x4 (&acc)[2][2][4][2], const Unit& u, int wr, int wc, int fr, int fq) const {
        const int row0 = u.pm * BM + wr * 64 + fr, col0 = u.pn * BM + wc * 32 + 4 * fq;
        const float* gp = gate + (size_t)(u.pm >> 5) * gstride + col0;
        f32x4 gv[2][2];
#pragma unroll
        for (int bj = 0; bj < 2; ++bj)
#pragma unroll
            for (int n = 0; n < 2; ++n) gv[bj][n] = *(const f32x4*)(gp + bj * HALF + n * 16);
#pragma unroll
        for (int ai = 0; ai < 2; ++ai)
#pragma unroll
            for (int m = 0; m < 4; ++m) { const size_t off = (size_t)(row0 + ai * HALF + m * 16) * ldc + col0;
#pragma unroll
                for (int bj = 0; bj < 2; ++bj)
#pragma unroll
                    for (int n = 0; n < 2; ++n) { const f32x4 bs = *(const f32x4*)(base + off + bj * HALF + n * 16);
                        *(f32x4*)(out + off + bj * HALF + n * 16) = bs + gv[bj][n] * acc[ai][bj][m][n]; } }
    }
};

template <class Epi, class Sched, bool ALIGN_EPI = false, bool SP2 = false>
__device__ __forceinline__ void gemm_phase(PG8_LAS unsigned char* lds, const Gemm g, const Sched& S, const Epi& E) {
    int tid_ = threadIdx.x; asm volatile("" : "+v"(tid_));
    const int tid = tid_, wid = __builtin_amdgcn_readfirstlane(tid >> 6), lane = tid & 63, wr = wid >> 2, wc = wid & 3, fr = lane & 15, fq = lane >> 4;
    const int K = g.K, nt = K / BK;
    unsigned voffA[2], voffB[2];
#pragma unroll
    for (int i = 0; i < 2; ++i) { int R, C; stage_rc(tid * 16 + i * 8192, R, C); const int Rb = Epi::PERM ? ((R & ~31) + perm32(R & 31)) : R;
        voffA[i] = (unsigned)(R * K + C) * 2u; voffB[i] = (unsigned)(Rb * K + C) * 2u; }
    const size_t kstep = (size_t)(BK * 2);
    const size_t hstep = (size_t)HALF * K * 2;
    const size_t tstep = 2 * hstep;
    const unsigned ldsw = (unsigned)wid * 1024u;
    const int aoff = lds_byte(wr * 64 + fr, fq * 8), boff = lds_byte(wc * 32 + fr, fq * 8);
#define PG8_SA(b, h) (((b) * 2 + (h)) * HTB)
#define PG8_SB(b, h) ((4 + (b) * 2 + (h)) * HTB)
#define PG8_STAGE(bufoff, gbase, voff) do { _Pragma("unroll") for (int _i = 0; _i < 2; ++_i) \
        __builtin_amdgcn_global_load_lds((const unsigned*)((const char*)(gbase) + (voff)[_i]), (PG8_LAS unsigned*)(lds + (bufoff) + ldsw + _i * 8192), 16, 0, 0); } while (0)
#define PG8_LDA(dst, b, h) do { _Pragma("unroll") for (int m = 0; m < 4; ++m) _Pragma("unroll") for (int k = 0; k < 2; ++k) dst[m][k] = *(const PG8_LAS bf16x8*)(lds + PG8_SA(b, h) + aoff + m * 2048 + k * 1024); } while (0)
#define PG8_LDB(dst, b, h) do { _Pragma("unroll") for (int n = 0; n < 2; ++n) _Pragma("unroll") for (int k = 0; k < 2; ++k) dst[n][k] = *(const PG8_LAS bf16x8*)(lds + PG8_SB(b, h) + boff + n * 2048 + k * 1024); } while (0)
#define PG8_MMA(ai, bj, At, Bt) do { __builtin_amdgcn_s_setprio(1); _Pragma("unroll") for (int m = 0; m < 4; ++m) _Pragma("unroll") for (int n = 0; n < 2; ++n) _Pragma("unroll") for (int k = 0; k < 2; ++k) \
        acc[ai][bj][m][n] = __builtin_amdgcn_mfma_f32_16x16x32_bf16(Bt[n][k], At[m][k], acc[ai][bj][m][n], 0, 0, 0); __builtin_amdgcn_s_setprio(0); } while (0)
#define PG8_WAIT_V(n) asm volatile("s_waitcnt vmcnt(" #n ")" ::: "memory")
#define PG8_WAIT_L(n) asm volatile("s_waitcnt lgkmcnt(" #n ")" ::: "memory")
#define PG8_BAR __builtin_amdgcn_s_barrier()
#define PG8_SCHED __builtin_amdgcn_sched_barrier(0)
    Unit cur, nxt; int ui = 0;
    if (!S.next(0, cur)) return;
    f32x4 acc[2][2][4][2];
#pragma unroll
    for (int a = 0; a < 2; ++a)
#pragma unroll
        for (int b = 0; b < 2; ++b)
#pragma unroll
            for (int m = 0; m < 4; ++m)
#pragma unroll
                for (int n = 0; n < 2; ++n) acc[a][b][m][n] = (f32x4){0.f, 0.f, 0.f, 0.f};
    bf16x8 At[4][2], B0[2][2], B1[2][2];
    const char* cA = (const char*)g.A + (size_t)cur.pm * tstep; const char* cB = (const char*)g.Bt + (size_t)cur.pn * tstep;
    S.a_ready(cur);
    if constexpr (SP2) {
        PG8_STAGE(PG8_SB(0, 0), cB, voffB); PG8_STAGE(PG8_SB(0, 1), cB + hstep, voffB); PG8_STAGE(PG8_SA(0, 0), cA, voffA); PG8_STAGE(PG8_SA(0, 1), cA + hstep, voffA);
        if (wr == 1) PG8_BAR;
        PG8_WAIT_V(2); PG8_BAR;
        PG8_STAGE(PG8_SB(1, 0), cB + kstep, voffB); PG8_STAGE(PG8_SA(1, 0), cA + kstep, voffA); PG8_STAGE(PG8_SB(1, 1), cB + hstep + kstep, voffB);
        PG8_WAIT_V(6); PG8_BAR;
    } else {
        PG8_STAGE(PG8_SB(0, 0), cB, voffB); PG8_STAGE(PG8_SA(0, 0), cA, voffA); PG8_STAGE(PG8_SB(0, 1), cB + hstep, voffB); PG8_STAGE(PG8_SA(0, 1), cA + hstep, voffA);
        if (wr == 1) PG8_BAR;
        PG8_WAIT_V(4); PG8_BAR;
        PG8_STAGE(PG8_SB(1, 0), cB + kstep, voffB); PG8_STAGE(PG8_SA(1, 0), cA + kstep, voffA); PG8_STAGE(PG8_SB(1, 1), cB + hstep + kstep, voffB);
        PG8_WAIT_V(6); PG8_BAR;
    }
    for (;;) {
        const bool has_next = S.next(ui + 1, nxt);
        const char* nA = has_next ? (const char*)g.A + (size_t)nxt.pm * tstep : cA; const char* nB = has_next ? (const char*)g.Bt + (size_t)nxt.pn * tstep : cB;
        for (int t = 0; t < nt; t += 2) {
            const bool last = (t == nt - 2);
            const char* a1 = cA + (size_t)(t + 1) * kstep;
            const char* a2 = last ? nA : cA + (size_t)(t + 2) * kstep; const char* b2 = last ? nB : cB + (size_t)(t + 2) * kstep;
            const char* a3 = a2 + kstep; const char* b3 = b2 + kstep;
            if (last && has_next) S.a_ready(nxt);
            if constexpr (SP2) {
            PG8_LDB(B0, 0, 0); PG8_LDB(B1, 0, 1); PG8_SCHED; PG8_LDA(At, 0, 0); PG8_STAGE(PG8_SA(1, 1), a1 + hstep, voffA);
            PG8_WAIT_V(8); PG8_WAIT_L(0); PG8_BAR; PG8_MMA(0, 0, At, B0); PG8_MMA(0, 1, At, B1); PG8_BAR; PG8_SCHED;
            PG8_LDA(At, 0, 1); PG8_STAGE(PG8_SB(0, 0), b2, voffB); PG8_STAGE(PG8_SB(0, 1), b2 + hstep, voffB); PG8_STAGE(PG8_SA(0, 0), a2, voffA);
            PG8_WAIT_V(8); PG8_WAIT_L(0); PG8_BAR; PG8_MMA(1, 0, At, B0); PG8_MMA(1, 1, At, B1); PG8_BAR; PG8_SCHED;
            PG8_LDB(B0, 1, 0); PG8_LDB(B1, 1, 1); PG8_SCHED; PG8_LDA(At, 1, 0); PG8_STAGE(PG8_SA(0, 1), a2 + hstep, voffA);
            PG8_WAIT_V(8); PG8_WAIT_L(0); PG8_BAR; PG8_MMA(0, 0, At, B0); PG8_MMA(0, 1, At, B1); PG8_BAR; PG8_SCHED;
            PG8_LDA(At, 1, 1); PG8_STAGE(PG8_SB(1, 0), b3, voffB); PG8_STAGE(PG8_SB(1, 1), b3 + hstep, voffB); PG8_STAGE(PG8_SA(1, 0), a3, voffA);
            PG8_WAIT_V(8); PG8_WAIT_L(0); PG8_BAR; PG8_MMA(1, 0, At, B0); PG8_MMA(1, 1, At, B1); PG8_BAR; PG8_SCHED;
            } else {
            PG8_LDB(B0, 0, 0); PG8_SCHED; PG8_LDA(At, 0, 0); PG8_STAGE(PG8_SA(1, 1), a1 + hstep, voffA);
            PG8_WAIT_L(8); PG8_BAR; PG8_WAIT_L(0); PG8_MMA(0, 0, At, B0); PG8_BAR; PG8_SCHED;
            PG8_LDB(B1, 0, 1); PG8_STAGE(PG8_SB(0, 0), b2, voffB);
            PG8_BAR; PG8_WAIT_L(0); PG8_MMA(0, 1, At, B1); PG8_BAR;
            PG8_LDA(At, 0, 1); PG8_STAGE(PG8_SA(0, 0), a2, voffA);
            PG8_BAR; PG8_WAIT_L(0); PG8_MMA(1, 0, At, B0); PG8_BAR; PG8_SCHED;
            PG8_STAGE(PG8_SB(0, 1), b2 + hstep, voffB);
            PG8_WAIT_V(6); PG8_BAR; PG8_MMA(1, 1, At, B1); PG8_BAR;
            PG8_LDB(B0, 1, 0); PG8_SCHED; PG8_LDA(At, 1, 0); PG8_STAGE(PG8_SA(0, 1), a2 + hstep, voffA);
            PG8_WAIT_L(8); PG8_BAR; PG8_WAIT_L(0); PG8_MMA(0, 0, At, B0); PG8_BAR; PG8_SCHED;
            PG8_LDB(B1, 1, 1); PG8_STAGE(PG8_SB(1, 0), b3, voffB);
            PG8_BAR; PG8_WAIT_L(0); PG8_MMA(0, 1, At, B1); PG8_BAR;
            PG8_LDA(At, 1, 1); PG8_STAGE(PG8_SA(1, 0), a3, voffA);
            PG8_BAR; PG8_WAIT_L(0); PG8_MMA(1, 0, At, B0); PG8_BAR; PG8_SCHED;
            PG8_STAGE(PG8_SB(1, 1), b3 + hstep, voffB);
            PG8_WAIT_V(6); PG8_BAR; PG8_MMA(1, 1, At, B1); PG8_BAR;
            }
        }
        if constexpr (ALIGN_EPI) { if (wr == 0) PG8_BAR; }
        if constexpr (!Epi::AFTER_DRAIN) { E(acc, cur, wr, wc, fr, fq); S.done(cur); }
        if (!has_next) break;
#pragma unroll
        for (int a = 0; a < 2; ++a)
#pragma unroll
            for (int b = 0; b < 2; ++b)
#pragma unroll
                for (int m = 0; m < 4; ++m)
#pragma unroll
                    for (int n = 0; n < 2; ++n) acc[a][b][m][n] = (f32x4){0.f, 0.f, 0.f, 0.f};
        cur = nxt; cA = nA; cB = nB; ++ui;
        if constexpr (ALIGN_EPI) { if (wr == 1) PG8_BAR; }
    }
    PG8_WAIT_V(0);
    if constexpr (!ALIGN_EPI) { if (wr == 0) PG8_BAR; }
    PG8_BAR;
    if constexpr (Epi::AFTER_DRAIN) { E.fused(acc, cur, wr, wc, fr, fq, lds, wid, lane); S.done(cur); }
#undef PG8_SA
#undef PG8_SB
#undef PG8_STAGE
#undef PG8_LDA
#undef PG8_LDB
#undef PG8_MMA
#undef PG8_WAIT_V
#undef PG8_WAIT_L
#undef PG8_BAR
#undef PG8_SCHED
}
}
namespace att {
constexpr int A_K = 0, A_V = 16384, A_WSF = 32768, A_KM = A_WSF + 2048, A_STG = A_KM + 8192;
constexpr int STG_STRIDE = 68, STG_WAVE_BYTES = 32 * STG_STRIDE * 4, A_END = A_STG + NWAVES * STG_WAVE_BYTES;
__device__ __forceinline__ int crow(int r, int hi) { return (r & 3) + 8 * (r >> 2) + 4 * hi; }
__device__ __forceinline__ void dma16(const void* g, LAS unsigned char* l) { __builtin_amdgcn_global_load_lds((const unsigned*)g, (LAS unsigned*)l, 16, 0, 0); }
typedef float f32x2_t __attribute__((ext_vector_type(2))); typedef __bf16 bf16x2_t __attribute__((ext_vector_type(2)));
__device__ __forceinline__ unsigned cvtpk(float lo, float hi) { f32x2_t v = {lo, hi}; bf16x2_t b = __builtin_convertvector(v, bf16x2_t); return __builtin_bit_cast(unsigned, b); }
typedef short v4i16_t __attribute__((ext_vector_type(4)));
__device__ __forceinline__ s16x4_t vtr(LAS const unsigned char* p) { return __builtin_bit_cast(s16x4_t, __builtin_amdgcn_ds_read_tr16_b64_v4i16((LAS v4i16_t*)p)); }
#define LDSW() asm volatile("s_waitcnt lgkmcnt(0)" ::: "memory")

template <int MODE>
__device__ __forceinline__ void attn_unit(int b, int h, int qb, const bf16_t* __restrict__ proj, bf16_t* __restrict__ Obuf, const float* __restrict__ kmean,
                                          float lam, float lam_init, const float* __restrict__ subg, const float* sinkp, int dlim, LAS unsigned char* lds) {
    constexpr int NMAP = (MODE == 0) ? 2 : 1;
    int tid_ = threadIdx.x; asm volatile("" : "+v"(tid_));
    const int tid = tid_, lane = tid & 63, r32 = lane & 31, hi = lane >> 5;
    const int wid = __builtin_amdgcn_readfirstlane(tid >> 6);
    const int q0 = qb * 256;
    int qcol, kcol, vcol, ocol; float slope;
    if (MODE == 0) { qcol = OFF_QA + h * 64; kcol = OFF_KA + h * 64; vcol = OFF_VA + h * 64; ocol = h * 64; slope = alibi_slope(6 + h); }
    else if (MODE == 1) { qcol = OFF_QB + h * 64; kcol = OFF_KB + h * 64; vcol = OFF_VB + h * 64; ocol = 256 + h * 64; slope = alibi_slope(10 + h); }
    else { qcol = OFF_QC + h * 64; kcol = OFF_KC + (h / 3) * 64; vcol = OFF_VC + (h / 3) * 64; ocol = 640 + h * 64; slope = alibi_slope(h); }
    const float slope2 = slope * LOG2E;
    const float cscale = (MODE == 0 ? 0.17677669529663687f : 0.125f) * LOG2E;
    const bf16_t* base = proj + (size_t)b * SEQ * INW;
    const int t_hi = 4 * qb + 4, t_lo = (MODE == 2) ? (qb > 0 ? 4 * qb - 2 : 0) : ((MODE == 0 && q0 > dlim) ? (q0 - dlim) / 64 : 0);
    const bf16_t* ksrc = base + kcol + (size_t)lane * INW + wid * 8;
    const bf16_t* vsrc = base + vcol + (size_t)(16 * (wid & 3) + (lane >> 2)) * INW + (wid >> 2) * 32 + (lane & 3) * 8;
#define DMA_TILE(t, bufi) do { dma16(ksrc + (size_t)(t) * 64 * INW, lds + A_K + (bufi) * 8192 + wid * 1024); dma16(vsrc + (size_t)(t) * 64 * INW, lds + A_V + (bufi) * 8192 + wid * 1024); } while (0)
    DMA_TILE(t_lo, 0);
    const bf16_t* Qw = base + (size_t)(q0 + wid * 32 + r32) * INW + qcol;
    bf16x8_t qr[4];
#pragma unroll
    for (int d0 = 0; d0 < 4; ++d0) qr[d0] = *(const bf16x8_t*)(Qw + d0 * 16 + hi * 8);
    const int qrel = wid * 32 + r32;
    const LAS unsigned char* qlds = lds + A_STG + wid * STG_WAVE_BYTES + lane * 16;
    if (MODE == 0) {
#pragma unroll
        for (int d0 = 0; d0 < 4; ++d0) *(LAS bf16x8_t*)(lds + A_STG + wid * STG_WAVE_BYTES + lane * 16 + d0 * 1024) = qr[d0];
    }
    unsigned rowmask = 0u;
    if (MODE == 1) {
        LAS float* km = (LAS float*)(lds + A_KM);
        const float* kmg = kmean + (size_t)((b * 6 + h) * 32) * 64;
        for (int i = tid; i < 2048; i += NTHREADS) km[i] = kmg[i] * (1.0f / 256.0f);
        __syncthreads();
        if (qb > 0) {
            float qf[32];
#pragma unroll
            for (int d0 = 0; d0 < 4; ++d0)
#pragma unroll
                for (int j = 0; j < 8; ++j) qf[d0 * 8 + j] = __builtin_bit_cast(float, ((unsigned)(unsigned short)qr[d0][j]) << 16);
            float v0 = -INFINITY, v1 = -INFINITY, v2 = -INFINITY; int i0 = 0, i1 = 0, i2 = 0;
            for (int n = 0; n < qb; ++n) {
                const LAS float* kp = km + n * 64 + 8 * hi;
                float part = 0.f;
#pragma unroll
                for (int d0 = 0; d0 < 4; ++d0) {
                    const f32x4_t a = *(const LAS f32x4_t*)(kp + d0 * 16), c = *(const LAS f32x4_t*)(kp + d0 * 16 + 4);
                    part += qf[d0 * 8 + 0] * a[0]; part += qf[d0 * 8 + 1] * a[1]; part += qf[d0 * 8 + 2] * a[2]; part += qf[d0 * 8 + 3] * a[3];
                    part += qf[d0 * 8 + 4] * c[0]; part += qf[d0 * 8 + 5] * c[1]; part += qf[d0 * 8 + 6] * c[2]; part += qf[d0 * 8 + 7] * c[3];
                }
                const float tot = part + swap32_partner(part, hi);
                if (tot > v0) { v2 = v1; i2 = i1; v1 = v0; i1 = i0; v0 = tot; i0 = n; }
                else if (tot > v1) { v2 = v1; i2 = i1; v1 = tot; i1 = n; }
                else if (tot > v2) { v2 = tot; i2 = n; }
            }
            if (v0 > -INFINITY) rowmask |= 1u << i0;
            if (v1 > -INFINITY) rowmask |= 1u << i1;
            if (v2 > -INFINITY) rowmask |= 1u << i2;
        }
    }
    float m_[NMAP], l_[NMAP]; f32x16_t o[NMAP][2];
#pragma unroll
    for (int mi = 0; mi < NMAP; ++mi) { m_[mi] = -INFINITY; l_[mi] = 0.f;
#pragma unroll
        for (int d0 = 0; d0 < 2; ++d0)
#pragma unroll
            for (int r = 0; r < 16; ++r) o[mi][d0][r] = 0.f; }
    LAS float* wsf = (LAS float*)(lds + A_WSF) + wid * 64;
    const int vlane = ((lane >> 4) & 1) * 32 + (lane & 3) * 8 + (4 * hi + ((lane & 15) >> 2)) * 64;

    for (int t = t_lo; t < t_hi; ++t) {
        const int bufi = (t - t_lo) & 1;
        asm volatile("s_waitcnt vmcnt(0)" ::: "memory");
        __syncthreads();
        if (t + 1 < t_hi) DMA_TILE(t + 1, bufi ^ 1);
        const int krel0 = 64 * t - q0;
        bool need = krel0 <= wid * 32 + 31;
        if (MODE == 2) need = need && (krel0 + 63 >= wid * 32 - 127);
        const bool past = (MODE == 1) && ((t >> 2) < qb);
        if (past) need = __any((int)((rowmask >> (t >> 2)) & 1u)) != 0;
        if (!need) continue;
        const bool diag = krel0 + 63 > wid * 32;
        const int kb = krel0 + 4 * hi;
        const LAS unsigned char* Ks = lds + A_K + bufi * 8192 + hi * 1024 + r32 * 16;
        const LAS unsigned char* Vs = lds + A_V + bufi * 8192 + vlane;
#pragma unroll
        for (int mi = 0; mi < NMAP; ++mi) {
            f32x16_t p0, p1;
#pragma unroll
            for (int r = 0; r < 16; ++r) { p0[r] = 0.f; p1[r] = 0.f; }
            constexpr int ND0 = (MODE == 0) ? 2 : 4;
#pragma unroll
            for (int dd = 0; dd < ND0; ++dd) {
                const int d0 = (MODE == 0) ? (2 * mi + dd) : dd;
                const bf16x8_t b0 = *(const LAS bf16x8_t*)(Ks + d0 * 2048);
                const bf16x8_t b1 = *(const LAS bf16x8_t*)(Ks + d0 * 2048 + 512);
                const bf16x8_t qa = (MODE == 0) ? *(const LAS bf16x8_t*)(qlds + d0 * 1024) : qr[d0];
                p0 = __builtin_amdgcn_mfma_f32_32x32x16_bf16(b0, qa, p0, 0, 0, 0);
                p1 = __builtin_amdgcn_mfma_f32_32x32x16_bf16(b1, qa, p1, 0, 0, 0);
            }
            float sl2 = slope2; asm volatile("" : "+v"(sl2));
            const float tb = sl2 * (float)kb;
#pragma unroll
            for (int r = 0; r < 16; ++r) { const int kk = (r & 3) + 8 * (r >> 2); const float bias = tb + sl2 * (float)kk;
                p0[r] = p0[r] * cscale + bias; p1[r] = p1[r] * cscale + (bias + sl2 * 32.0f); }
            if (diag) {
#pragma unroll
                for (int r = 0; r < 16; ++r) { const int kk = kb + (r & 3) + 8 * (r >> 2); if (kk > qrel) p0[r] = -INFINITY; if (kk + 32 > qrel) p1[r] = -INFINITY; }
            }
            if (MODE == 2) {
#pragma unroll
                for (int r = 0; r < 16; ++r) { const int kk = kb + (r & 3) + 8 * (r >> 2); if (qrel - kk >= 128) p0[r] = -INFINITY; if (qrel - (kk + 32) >= 128) p1[r] = -INFINITY; }
            }
            if (past) { if (!((rowmask >> (t >> 2)) & 1u)) {
#pragma unroll
                for (int r = 0; r < 16; ++r) { p0[r] = -INFINITY; p1[r] = -INFINITY; } } }
            float mx = fmaxf(p0[0], p1[0]);
#pragma unroll
            for (int r = 1; r < 16; ++r) mx = fmaxf(mx, fmaxf(p0[r], p1[r]));
            mx = fmaxf(mx, __shfl_xor(mx, 32));
            const float mnew = fmaxf(m_[mi], mx), msafe = (mnew == -INFINITY) ? 0.f : mnew;
            const float f = __builtin_amdgcn_exp2f(m_[mi] - msafe);
            float ps = 0.f;
#pragma unroll
            for (int r = 0; r < 16; ++r) { p0[r] = __builtin_amdgcn_exp2f(p0[r] - msafe); p1[r] = __builtin_amdgcn_exp2f(p1[r] - msafe); ps += p0[r] + p1[r]; }
            l_[mi] = l_[mi] * f + ps; m_[mi] = mnew;
            if (__any(f != 1.0f)) {
                if (hi == 0) wsf[mi * 32 + r32] = f;
                LDSW();
#pragma unroll
                for (int r = 0; r < 16; ++r) { const float fr_ = wsf[mi * 32 + crow(r, hi)]; o[mi][0][r] *= fr_; o[mi][1][r] *= fr_; }
            }
            u32x4_t pw[4];
#pragma unroll
            for (int j = 0; j < 4; ++j) { pw[0][j] = cvtpk(p0[2 * j], p0[2 * j + 1]); pw[1][j] = cvtpk(p0[8 + 2 * j], p0[8 + 2 * j + 1]);
                                          pw[2][j] = cvtpk(p1[2 * j], p1[2 * j + 1]); pw[3][j] = cvtpk(p1[8 + 2 * j], p1[8 + 2 * j + 1]); }
#pragma unroll
            for (int d0 = 0; d0 < 2; ++d0) {
                if (d0) __builtin_amdgcn_sched_barrier(0);
#pragma unroll
                for (int ks = 0; ks < 4; ++ks) {
                    const s16x4_t lo = vtr(Vs + d0 * 4096 + ks * 1024), hh = vtr(Vs + d0 * 4096 + ks * 1024 + 512);
                    const bf16x8_t vf = {lo[0], lo[1], lo[2], lo[3], hh[0], hh[1], hh[2], hh[3]};
                    o[mi][d0] = __builtin_amdgcn_mfma_f32_32x32x16_bf16(__builtin_bit_cast(bf16x8_t, pw[ks]), vf, o[mi][d0], 0, 0, 0);
                }
            }
            if (NMAP > 1) __builtin_amdgcn_sched_barrier(0);
        }
    }
#undef DMA_TILE
    float rl[NMAP][16];
#pragma unroll
    for (int mi = 0; mi < NMAP; ++mi) {
        float lt = l_[mi];
        lt += __shfl_xor(lt, 32);
        if (MODE == 2) lt += __builtin_amdgcn_exp2f(sinkp[0] * LOG2E + slope2 * (float)qrel - m_[mi]);
        if (hi == 0) wsf[mi * 32 + r32] = 1.0f / lt;
    }
    LDSW();
#pragma unroll
    for (int mi = 0; mi < NMAP; ++mi)
#pragma unroll
        for (int r = 0; r < 16; ++r) rl[mi][r] = wsf[mi * 32 + crow(r, hi)];
    LAS float* stg = (LAS float*)(lds + A_STG + wid * STG_WAVE_BYTES);
#pragma unroll
    for (int d0 = 0; d0 < 2; ++d0)
#pragma unroll
        for (int r = 0; r < 16; ++r) {
            float v = o[0][d0][r] * rl[0][r];
            if (MODE == 0) v -= lam * (o[NMAP - 1][d0][r] * rl[NMAP - 1][r]);
            stg[crow(r, hi) * STG_STRIDE + d0 * 32 + r32] = v;
        }
    LDSW();
    {
        const int row = lane >> 1, half = lane & 1;
        float v[32];
#pragma unroll
        for (int i = 0; i < 8; ++i) { const f32x4_t x = *(const LAS f32x4_t*)(stg + row * STG_STRIDE + half * 32 + i * 4); v[4 * i] = x[0]; v[4 * i + 1] = x[1]; v[4 * i + 2] = x[2]; v[4 * i + 3] = x[3]; }
        if (MODE == 0) {
            float ss = 0.f;
#pragma unroll
            for (int i = 0; i < 32; ++i) ss += v[i] * v[i];
            ss += __shfl_xor(ss, 1);
            const float rs = (1.0f / sqrtf(ss * (1.0f / 64.0f) + EPS)) * (1.0f - lam_init);
#pragma unroll
            for (int i = 0; i < 32; ++i) v[i] = v[i] * rs * subg[half * 32 + i];
        }
        bf16_t* op = Obuf + (size_t)(b * SEQ + q0 + wid * 32 + row) * DM + ocol + half * 32;
#pragma unroll
        for (int i = 0; i < 4; ++i) { u32x4_t w; w.x = cvtpk(v[8 * i], v[8 * i + 1]); w.y = cvtpk(v[8 * i + 2], v[8 * i + 3]); w.z = cvtpk(v[8 * i + 4], v[8 * i + 5]); w.w = cvtpk(v[8 * i + 6], v[8 * i + 7]);
            *(u32x4_t*)(op + 8 * i) = w; }
    }
    __syncthreads();
}
#undef LDSW
}

namespace att {
#define LDSW() asm volatile("s_waitcnt lgkmcnt(0)" ::: "memory")
__device__ __forceinline__ void gate_unit(int b, int h, int qb, const bf16_t* __restrict__ proj, const float* __restrict__ kmean, unsigned* __restrict__ RM, LAS unsigned char* lds) {
    int tid_ = threadIdx.x; asm volatile("" : "+v"(tid_));
    const int tid = tid_, lane = tid & 63, r32 = lane & 31, hi = lane >> 5;
    const int wid = __builtin_amdgcn_readfirstlane(tid >> 6);
    const int q0 = qb * 256;
    LAS float* km = (LAS float*)lds;
    const float* kmg = kmean + (size_t)((b * 6 + h) * 32) * 64;
    for (int i = tid; i < 2048; i += NTHREADS) km[i] = kmg[i] * (1.0f / 256.0f);
    __syncthreads();
    const bf16_t* Qw = proj + ((size_t)b * SEQ + q0 + wid * 32 + r32) * INW + OFF_QB + h * 64;
    float qf[32];
#pragma unroll
    for (int d0 = 0; d0 < 4; ++d0) { const bf16x8_t q = *(const bf16x8_t*)(Qw + d0 * 16 + hi * 8);
#pragma unroll
        for (int j = 0; j < 8; ++j) qf[d0 * 8 + j] = __builtin_bit_cast(float, ((unsigned)(unsigned short)q[j]) << 16); }
    float v0 = -INFINITY, v1 = -INFINITY, v2 = -INFINITY; int i0 = 0, i1 = 0, i2 = 0;
    for (int n = 0; n < qb; ++n) {
        const LAS float* kp = km + n * 64 + 8 * hi;
        float part = 0.f;
#pragma unroll
        for (int d0 = 0; d0 < 4; ++d0) {
            const f32x4_t a = *(const LAS f32x4_t*)(kp + d0 * 16), c = *(const LAS f32x4_t*)(kp + d0 * 16 + 4);
            part += qf[d0 * 8 + 0] * a[0]; part += qf[d0 * 8 + 1] * a[1]; part += qf[d0 * 8 + 2] * a[2]; part += qf[d0 * 8 + 3] * a[3];
            part += qf[d0 * 8 + 4] * c[0]; part += qf[d0 * 8 + 5] * c[1]; part += qf[d0 * 8 + 6] * c[2]; part += qf[d0 * 8 + 7] * c[3];
        }
        const float tot = part + __shfl_xor(part, 32);
        if (tot > v0) { v2 = v1; i2 = i1; v1 = v0; i1 = i0; v0 = tot; i0 = n; }
        else if (tot > v1) { v2 = v1; i2 = i1; v1 = tot; i1 = n; }
        else if (tot > v2) { v2 = tot; i2 = n; }
    }
    unsigned rowmask = 0u;
    if (v0 > -INFINITY) rowmask |= 1u << i0;
    if (v1 > -INFINITY) rowmask |= 1u << i1;
    if (v2 > -INFINITY) rowmask |= 1u << i2;
    if (hi == 0) RM[(size_t)(b * 6 + h) * SEQ + q0 + wid * 32 + r32] = rowmask;
    __syncthreads();
}

constexpr int B_K = 0, B_V = 32768, B_LIST = 65536, B_WSF = 81920, B_CNT = 83968, B_STG = 84032, B_STG_ROW = 72  , B_STG_WAVE = 32 * B_STG_ROW * 2;
__device__ __forceinline__ void moba_unit(int b, int h, int n, const bf16_t* __restrict__ proj, const unsigned* __restrict__ RM, bf16_t* __restrict__ Pbuf, float* __restrict__ ML, LAS unsigned char* lds) {
    int tid_ = threadIdx.x; asm volatile("" : "+v"(tid_));
    const int tid = tid_, lane = tid & 63, r32 = lane & 31, hi = lane >> 5;
    const int wid = __builtin_amdgcn_readfirstlane(tid >> 6);
    const float slope2 = alibi_slope(10 + h) * LOG2E, cscale = 0.125f * LOG2E;
    const bf16_t* base = proj + (size_t)b * SEQ * INW;
    {
        const bf16_t* ksrc = base + OFF_KB + h * 64 + (size_t)(256 * n + lane) * INW + wid * 8;
        const bf16_t* vsrc = base + OFF_VB + h * 64 + (size_t)(256 * n + 16 * (wid & 3) + (lane >> 2)) * INW + (wid >> 2) * 32 + (lane & 3) * 8;
#pragma unroll
        for (int tt = 0; tt < 4; ++tt) { dma16(ksrc + (size_t)tt * 64 * INW, lds + B_K + tt * 8192 + wid * 1024); dma16(vsrc + (size_t)tt * 64 * INW, lds + B_V + tt * 8192 + wid * 1024); }
    }
    volatile LAS int* cntp = (volatile LAS int*)(lds + B_CNT);
    LAS unsigned short* list = (LAS unsigned short*)(lds + B_LIST);
    if (tid == 0) cntp[0] = 0;
    __syncthreads();
    const unsigned* rm = RM + (size_t)(b * 6 + h) * SEQ;
    for (int s0 = 256 * (n + 1); s0 < SEQ; s0 += NTHREADS) {
        const int s = s0 + tid;
        const bool sel = (s < SEQ) && ((rm[s < SEQ ? s : 0] >> n) & 1u);
        const unsigned long long bal = __ballot(sel);
        if (bal) {
            const int total = __popcll(bal), prefix = __builtin_amdgcn_mbcnt_hi((unsigned)(bal >> 32), __builtin_amdgcn_mbcnt_lo((unsigned)bal, 0u));
            int wb = 0;
            if (lane == 0) wb = __hip_atomic_fetch_add((LAS int*)(lds + B_CNT), total, __ATOMIC_RELAXED, __HIP_MEMORY_SCOPE_WORKGROUP);
            wb = __builtin_amdgcn_readfirstlane(wb);
            if (sel) list[wb + prefix] = (unsigned short)s;
        }
    }
    asm volatile("s_waitcnt vmcnt(0)" ::: "memory");
    __syncthreads();
    const int C = cntp[0], NG = (C + 31) >> 5;
    LAS float* wsf = (LAS float*)(lds + B_WSF) + wid * 64;
    LAS unsigned short* stg = (LAS unsigned short*)(lds + B_STG + wid * B_STG_WAVE);
    const int vlane = ((lane >> 4) & 1) * 32 + (lane & 3) * 8 + (4 * hi + ((lane & 15) >> 2)) * 64;
    for (int item = wid; item < 8 + NG; item += 8) {
        const bool own = item < 8;
        int li = own ? 0 : 32 * (item - 8) + r32;
        const bool valid = own || (li < C);
        if (li >= C) li = C - 1;
        const int qidx = own ? (256 * n + 32 * item + r32) : (int)list[own ? 0 : li];
        const unsigned qmask = rm[qidx];
        const int slot = own ? 3 : __popc(qmask & ((1u << n) - 1u));
        const bf16_t* Qw = base + (size_t)qidx * INW + OFF_QB + h * 64;
        bf16x8_t qr[4];
#pragma unroll
        for (int d0 = 0; d0 < 4; ++d0) qr[d0] = *(const bf16x8_t*)(Qw + d0 * 16 + hi * 8);
        const int qrel = 32 * item + r32;
        float m_ = -INFINITY, l_ = 0.f; f32x16_t o[2];
#pragma unroll
        for (int d0 = 0; d0 < 2; ++d0)
#pragma unroll
            for (int r = 0; r < 16; ++r) o[d0][r] = 0.f;
        const int ntile = own ? ((32 * item + 31) / 64 + 1) : 4;
        for (int tt = 0; tt < ntile; ++tt) {
            const LAS unsigned char* Ks = lds + B_K + tt * 8192 + hi * 1024 + r32 * 16;
            const LAS unsigned char* Vs = lds + B_V + tt * 8192 + vlane;
            f32x16_t p0, p1;
#pragma unroll
            for (int r = 0; r < 16; ++r) { p0[r] = 0.f; p1[r] = 0.f; }
#pragma unroll
            for (int d0 = 0; d0 < 4; ++d0) {
                const bf16x8_t b0 = *(const LAS bf16x8_t*)(Ks + d0 * 2048);
                const bf16x8_t b1 = *(const LAS bf16x8_t*)(Ks + d0 * 2048 + 512);
                p0 = __builtin_amdgcn_mfma_f32_32x32x16_bf16(b0, qr[d0], p0, 0, 0, 0);
                p1 = __builtin_amdgcn_mfma_f32_32x32x16_bf16(b1, qr[d0], p1, 0, 0, 0);
            }
            float sl2 = slope2; asm volatile("" : "+v"(sl2));
            const int kb = 64 * tt + 4 * hi;
            const float tb = sl2 * (float)kb;
#pragma unroll
            for (int r = 0; r < 16; ++r) { const int kk = (r & 3) + 8 * (r >> 2); const float bias = tb + sl2 * (float)kk;
                p0[r] = p0[r] * cscale + bias; p1[r] = p1[r] * cscale + (bias + sl2 * 32.0f); }
            if (own && (64 * tt + 63 > 32 * item)) {
#pragma unroll
                for (int r = 0; r < 16; ++r) { const int kk = kb + (r & 3) + 8 * (r >> 2); if (kk > qrel) p0[r] = -INFINITY; if (kk + 32 > qrel) p1[r] = -INFINITY; }
            }
            float mx = fmaxf(p0[0], p1[0]);
#pragma unroll
            for (int r = 1; r < 16; ++r) mx = fmaxf(mx, fmaxf(p0[r], p1[r]));
            mx = fmaxf(mx, __shfl_xor(mx, 32));
            const float mnew = fmaxf(m_, mx), msafe = (mnew == -INFINITY) ? 0.f : mnew;
            const float f = __builtin_amdgcn_exp2f(m_ - msafe);
            float ps = 0.f;
#pragma unroll
            for (int r = 0; r < 16; ++r) { p0[r] = __builtin_amdgcn_exp2f(p0[r] - msafe); p1[r] = __builtin_amdgcn_exp2f(p1[r] - msafe); ps += p0[r] + p1[r]; }
            l_ = l_ * f + ps; m_ = mnew;
            if (__any(f != 1.0f)) {
                if (hi == 0) wsf[r32] = f;
                LDSW();
#pragma unroll
                for (int r = 0; r < 16; ++r) { const float fr_ = wsf[crow(r, hi)]; o[0][r] *= fr_; o[1][r] *= fr_; }
            }
            u32x4_t pw[4];
#pragma unroll
            for (int j = 0; j < 4; ++j) { pw[0][j] = cvtpk(p0[2 * j], p0[2 * j + 1]); pw[1][j] = cvtpk(p0[8 + 2 * j], p0[8 + 2 * j + 1]);
                                          pw[2][j] = cvtpk(p1[2 * j], p1[2 * j + 1]); pw[3][j] = cvtpk(p1[8 + 2 * j], p1[8 + 2 * j + 1]); }
#pragma unroll
            for (int d0 = 0; d0 < 2; ++d0)
#pragma unroll
                for (int ks = 0; ks < 4; ++ks) {
                    const s16x4_t lo = vtr(Vs + d0 * 4096 + ks * 1024), hh = vtr(Vs + d0 * 4096 + ks * 1024 + 512);
                    const bf16x8_t vf = {lo[0], lo[1], lo[2], lo[3], hh[0], hh[1], hh[2], hh[3]};
                    o[d0] = __builtin_amdgcn_mfma_f32_32x32x16_bf16(__builtin_bit_cast(bf16x8_t, pw[ks]), vf, o[d0], 0, 0, 0);
                }
        }
        float lt = l_ + __shfl_xor(l_, 32);
        if (hi == 0) wsf[r32] = 1.0f / lt;
        LDSW();
#pragma unroll
        for (int d0 = 0; d0 < 2; ++d0)
#pragma unroll
            for (int r = 0; r < 16; ++r) stg[crow(r, hi) * B_STG_ROW + d0 * 32 + r32] = (unsigned short)f2bf(o[d0][r] * wsf[crow(r, hi)]);
        const size_t pidx = (((size_t)b * SEQ + qidx) * 6 + h) * 4 + slot;
        if (hi == 0 && valid) { float2 mlv; mlv.x = m_ + slope2 * (float)(256 * n - qidx); mlv.y = lt; *(float2*)(ML + pidx * 2) = mlv; }
        LDSW();
        {
            const int row = lane >> 1, half = lane & 1;
            const int pk_own = valid ? (qidx | (slot << 16)) : -1;
            const int pk = __shfl(pk_own, row);
            if (pk >= 0) {
                bf16_t* dst = Pbuf + ((((size_t)b * SEQ + (pk & 0xffff)) * 6 + h) * 4 + (pk >> 16)) * 64 + half * 32;
#pragma unroll
                for (int i = 0; i < 4; ++i) *(u32x4_t*)(dst + 8 * i) = *(const LAS u32x4_t*)((const LAS unsigned char*)stg + row * (B_STG_ROW * 2) + half * 64 + i * 16);
            }
        }
        LDSW();
    }
    __syncthreads();
}

__device__ __forceinline__ void moba_combine(const bf16_t* __restrict__ Pbuf, const float* __restrict__ ML, bf16_t* __restrict__ Obuf, size_t gtid, size_t gth) {
    for (size_t idx = gtid; idx < (size_t)TOK * 48; idx += gth) {
        const int t = (int)(idx / 48), r = (int)(idx % 48), h = r >> 3, c = r & 7;
        const int qb = (t & (SEQ - 1)) >> 8, ns = qb < 3 ? qb : 3;
        const size_t pb = ((size_t)t * 6 + h) * 4;
        float m[4], l[4];
        { const float2 v = *(const float2*)(ML + (pb + 3) * 2); m[3] = v.x; l[3] = v.y; }
        float M = m[3];
#pragma unroll
        for (int i = 0; i < 3; ++i) { if (i < ns) { const float2 v = *(const float2*)(ML + (pb + i) * 2); m[i] = v.x; l[i] = v.y; M = fmaxf(M, m[i]); } else { m[i] = -INFINITY; l[i] = 0.f; } }
        float acc[8]; float wsum = 0.f;
#pragma unroll
        for (int j = 0; j < 8; ++j) acc[j] = 0.f;
#pragma unroll
        for (int i = 0; i < 4; ++i) {
            if (i == 3 || i < ns) {
                const float w = l[i] * __builtin_amdgcn_exp2f(m[i] - M); wsum += w;
                const u32x4_t v = *(const u32x4_t*)(Pbuf + (pb + i) * 64 + c * 8);
#pragma unroll
                for (int j = 0; j < 4; ++j) { acc[2 * j] += w * bf_lo(v[j]); acc[2 * j + 1] += w * bf_hi(v[j]); }
            }
        }
        const float inv = 1.0f / wsum;
        u32x4_t o; o.x = pk2(acc[0] * inv, acc[1] * inv); o.y = pk2(acc[2] * inv, acc[3] * inv); o.z = pk2(acc[4] * inv, acc[5] * inv); o.w = pk2(acc[6] * inv, acc[7] * inv);
        *(u32x4_t*)(Obuf + (size_t)t * DM + 256 + h * 64 + c * 8) = o;
    }
}

__device__ __forceinline__ void qknorm_unit(int b, int h, int chunk, const bf16_t* __restrict__ proj, unsigned* __restrict__ words  , int tid) {
    float mq = 0.f, mk = 0.f;
    for (int rr = tid; rr < 2048; rr += NTHREADS) {
        const int row = chunk * 1024 + (rr >> 1), mp = rr & 1;
        const bf16_t* p = proj + ((size_t)b * SEQ + row) * INW + h * 64 + mp * 32;
        float sq = 0.f, sk = 0.f;
#pragma unroll
        for (int j = 0; j < 4; ++j) { const u32x4_t a = *(const u32x4_t*)(p + OFF_QA + 8 * j), c = *(const u32x4_t*)(p + OFF_KA + 8 * j);
#pragma unroll
            for (int e = 0; e < 4; ++e) { const float a0 = bf_lo(a[e]), a1 = bf_hi(a[e]), c0 = bf_lo(c[e]), c1 = bf_hi(c[e]); sq += a0 * a0 + a1 * a1; sk += c0 * c0 + c1 * c1; } }
        mq = fmaxf(mq, sq); mk = fmaxf(mk, sk);
    }
#pragma unroll
    for (int o = 1; o < 64; o <<= 1) { mq = fmaxf(mq, __shfl_xor(mq, o)); mk = fmaxf(mk, __shfl_xor(mk, o)); }
    if ((tid & 63) == 0) { atomicMax(words + 0, __builtin_bit_cast(unsigned, mq)); atomicMax(words + 1, __builtin_bit_cast(unsigned, mk)); }
}
#undef LDSW
}

namespace peer {
constexpr int K_BYTES = 2 * 32768;
__device__ __forceinline__ int crow(int r, int hi) { return (r & 3) + 8 * (r >> 2) + 4 * hi; }

template <int N>
__device__ __forceinline__ void top16_pair(float (&s)[N], float (&out)[16], bool pair) {
#pragma unroll
    for (int it = 0; it < 16; ++it) {
        float mx = s[0];
#pragma unroll
        for (int i = 1; i < N; ++i) mx = fmaxf(mx, s[i]);
        if (pair) mx = fmaxf(mx, __shfl_xor(mx, 32));
        out[it] = mx;
#pragma unroll
        for (int i = 0; i < N; ++i) s[i] = (s[i] == mx) ? -INFINITY : s[i];
    }
}
__device__ __forceinline__ float pack_idx(float v, unsigned idx, unsigned mask) { return __builtin_bit_cast(float, (__builtin_bit_cast(unsigned, v) & ~mask) | idx); }
__device__ __forceinline__ unsigned byte16(unsigned t0, unsigned t1, unsigned t2, unsigned t3, unsigned i) {
    const unsigned s = i & 7u, a = __builtin_amdgcn_perm(t1, t0, s), b = __builtin_amdgcn_perm(t3, t2, s);
    return ((i & 8u) ? b : a) & 0xffu;
}

__device__ __forceinline__ void pk_unit(int tile, int h, const bf16_t* __restrict__ Q, const bf16_t* __restrict__ keysb, int* __restrict__ Eid, float* __restrict__ Gw, LAS unsigned char* lds) {
    int tid_ = threadIdx.x; asm volatile("" : "+v"(tid_));
    const int tid = tid_, lane = tid & 63, r32 = lane & 31, hi = lane >> 5;
    const int wid = __builtin_amdgcn_readfirstlane(tid >> 6);
    __syncthreads();
    {
        const bf16_t* kg = keysb + (size_t)h * 2 * 128 * 128;
        for (int i = tid; i < 2 * 128 * 16; i += NTHREADS) {
            const int n = i & 127, c = (i >> 7) & 15, p = i >> 11;
            const u32x4_t v = *(const u32x4_t*)(kg + ((size_t)(p * 128 + n)) * 128 + c * 8);
            *(LAS u32x4_t*)(lds + p * 32768 + c * 2048 + n * 16) = v;
        }
    }
    __syncthreads();
    const int tok = tile * 256 + wid * 32 + r32;
    float sv[2][16];
#pragma unroll
    for (int p = 0; p < 2; ++p) {
        const bf16_t* qp = Q + (size_t)tok * PQW + h * 256 + p * 128 + hi * 8;
        bf16x8_t qf[8];
#pragma unroll
        for (int ks = 0; ks < 8; ++ks) qf[ks] = *(const bf16x8_t*)(qp + ks * 16);
        float s[64];
#pragma unroll
        for (int blk = 0; blk < 4; ++blk) {
            f32x16_t acc;
#pragma unroll
            for (int r = 0; r < 16; ++r) acc[r] = 0.f;
#pragma unroll
            for (int ks = 0; ks < 8; ++ks) {
                const bf16x8_t kf = *(const LAS bf16x8_t*)(lds + p * 32768 + (2 * ks + hi) * 2048 + (blk * 32 + r32) * 16);
                acc = __builtin_amdgcn_mfma_f32_32x32x16_bf16(kf, qf[ks], acc, 0, 0, 0);
            }
#pragma unroll
            for (int r = 0; r < 16; ++r) s[blk * 16 + r] = pack_idx(acc[r], (unsigned)(blk * 32 + (r & 3) + 8 * (r >> 2) + 4 * hi), 127u);
        }
        top16_pair<64>(s, sv[p], true);
    }
    float cand[50];
    {
        int c = 0;
#pragma unroll
        for (int i = 0; i < 16; ++i)
#pragma unroll
            for (int j = 0; j < 16; ++j)
                if ((i + 1) * (j + 1) <= 16) { cand[c] = pack_idx(sv[0][i] + sv[1][j], (unsigned)(i * 16 + j), 255u); ++c; }
    }
    float top[16];
    top16_pair<50>(cand, top, false);
    unsigned t1[4], t2[4];
#pragma unroll
    for (int j = 0; j < 4; ++j) { t1[j] = 0u; t2[j] = 0u;
#pragma unroll
        for (int k = 0; k < 4; ++k) { t1[j] |= (__builtin_bit_cast(unsigned, sv[0][4 * j + k]) & 127u) << (8 * k); t2[j] |= (__builtin_bit_cast(unsigned, sv[1][4 * j + k]) & 127u) << (8 * k); } }
    float g[16]; int e[16]; float gs = 0.f;
#pragma unroll
    for (int k = 0; k < 16; ++k) {
        const unsigned code = __builtin_bit_cast(unsigned, top[k]) & 255u;
        e[k] = (int)(byte16(t1[0], t1[1], t1[2], t1[3], code >> 4) * 128u + byte16(t2[0], t2[1], t2[2], t2[3], code & 15u));
        g[k] = __expf(top[k] - top[0]); gs += g[k];
    }
    const float gi = 1.0f / gs;
    if (hi == 0) {
        int* ep = Eid + ((size_t)tok * PHEADS + h) * 16; float* gp = Gw + ((size_t)tok * PHEADS + h) * 16;
#pragma unroll
        for (int k = 0; k < 16; k += 4) {
            *(int4*)(ep + k) = make_int4(e[k], e[k + 1], e[k + 2], e[k + 3]);
            *(float4*)(gp + k) = make_float4(g[k] * gi, g[k + 1] * gi, g[k + 2] * gi, g[k + 3] * gi);
        }
    }
}

__device__ __forceinline__ float reduce16(float (&a)[16], int lane) {
    float b8[8];
    { const bool up = lane & 1;
#pragma unroll
      for (int i = 0; i < 8; ++i) { const float keep = up ? a[8 + i] : a[i], give = up ? a[i] : a[8 + i]; b8[i] = keep + __shfl_xor(give, 1); } }
    float b4[4];
    { const bool up = lane & 2;
#pragma unroll
      for (int i = 0; i < 4; ++i) { const float keep = up ? b8[4 + i] : b8[i], give = up ? b8[i] : b8[4 + i]; b4[i] = keep + __shfl_xor(give, 2); } }
    float b2[2];
    { const bool up = lane & 4;
#pragma unroll
      for (int i = 0; i < 2; ++i) { const float keep = up ? b4[2 + i] : b4[i], give = up ? b4[i] : b4[2 + i]; b2[i] = keep + __shfl_xor(give, 4); } }
    float b1;
    { const bool up = lane & 8; const float keep = up ? b2[1] : b2[0], give = up ? b2[0] : b2[1]; b1 = keep + __shfl_xor(give, 8); }
    b1 += __shfl_xor(b1, 16); b1 += __shfl_xor(b1, 32);
    return b1;
}
__device__ __forceinline__ int red16_index(int lane) { return 8 * (lane & 1) + 4 * ((lane >> 1) & 1) + 2 * ((lane >> 2) & 1) + ((lane >> 3) & 1); }

typedef float f32x2_t __attribute__((ext_vector_type(2)));
__device__ __forceinline__ void pg_token(int tok, const float* xres, float* xdst, const LAS float* tab2  , const float* __restrict__ g2  , int gstride,
                                         const int* __restrict__ Eid, const float* __restrict__ Gw, const unsigned char* __restrict__ U8, const unsigned char* __restrict__ V8,
                                         const float* __restrict__ Us, const float* __restrict__ Vs,
                                         bool last, const LAS float* tabn  , const float* __restrict__ final_g, bf16_t* __restrict__ Hn, float* __restrict__ outp, int lane) {
    const int b = tok >> 13;
    float x[16];
    const float* xp = xres + (size_t)tok * DM + 16 * lane;
    float* xw = xdst + (size_t)tok * DM + 16 * lane;
#pragma unroll
    for (int q = 0; q < 4; ++q) { const f32x4_t a = *(const f32x4_t*)(xp + 4 * q); x[4 * q] = a[0]; x[4 * q + 1] = a[1]; x[4 * q + 2] = a[2]; x[4 * q + 3] = a[3]; }
    float ss = 0.f;
#pragma unroll
    for (int i = 0; i < 16; ++i) ss += x[i] * x[i];
    const float rstd = 1.0f / sqrtf(wave_sum(ss) * (1.0f / DM) + EPS);
    float hh[16];
#pragma unroll
    for (int q = 0; q < 4; ++q) { const f32x4_t g = *(const LAS f32x4_t*)(tab2 + (b * 2 + 0) * 1024 + 16 * lane + 4 * q), s = *(const LAS f32x4_t*)(tab2 + (b * 2 + 1) * 1024 + 16 * lane + 4 * q);
#pragma unroll
        for (int i = 0; i < 4; ++i) hh[4 * q + i] = x[4 * q + i] * rstd * g[i] + s[i]; }
    float out[16];
#pragma unroll
    for (int i = 0; i < 16; ++i) out[i] = 0.f;
    const int ridx = red16_index(lane);
#pragma unroll 1
    for (int hd = 0; hd < PHEADS; ++hd) {
        const size_t eb = ((size_t)tok * PHEADS + hd) * 16;
        const int ev = Eid[eb + (lane & 15)];
        const int er = Eid[eb + ridx];
        const float gv = Gw[eb + ridx];
        const float su = Us[er], sv = Vs[er];
        float a[16];
        {
            u32x2_t w[16];
#pragma unroll
            for (int k = 0; k < 16; ++k) { const int e = __builtin_amdgcn_readlane(ev, k); w[k] = *(const u32x2_t*)(U8 + (size_t)e * (DM / 2) + 8 * lane); }
#pragma unroll
            for (int k = 0; k < 16; ++k) { float acc = 0.f;
#pragma unroll
                for (int q = 0; q < 2; ++q) {
#define FP4_DOT(S) { const f32x2_t f2 = __builtin_amdgcn_cvt_scalef32_pk_f32_fp4(w[k][q], 1.0f, S); acc += hh[8 * q + 2 * S] * f2[0]; acc += hh[8 * q + 2 * S + 1] * f2[1]; }
                    FP4_DOT(0) FP4_DOT(1) FP4_DOT(2) FP4_DOT(3)
#undef FP4_DOT
                }
                a[k] = acc; }
        }
        __builtin_amdgcn_sched_barrier(0);
        const float dot = reduce16(a, lane) * su;
        const float wgt = gv * sv * 0.5f * dot * (1.0f + erff(dot * 0.70710678118654752f));
        {
            u32x2_t w[16];
#pragma unroll
            for (int k = 0; k < 16; ++k) { const int e = __builtin_amdgcn_readlane(ev, k); w[k] = *(const u32x2_t*)(V8 + (size_t)e * (DM / 2) + 8 * lane); }
#pragma unroll
            for (int k = 0; k < 16; ++k) {
                const int src = ((k >> 3) & 1) | (((k >> 2) & 1) << 1) | (((k >> 1) & 1) << 2) | ((k & 1) << 3);
                const float wk = __builtin_bit_cast(float, __builtin_amdgcn_readlane(__builtin_bit_cast(int, wgt), src));
#pragma unroll
                for (int q = 0; q < 2; ++q) {
#define FP4_AXPY(S) { const f32x2_t f2 = __builtin_amdgcn_cvt_scalef32_pk_f32_fp4(w[k][q], 1.0f, S); out[8 * q + 2 * S] += wk * f2[0]; out[8 * q + 2 * S + 1] += wk * f2[1]; }
                    FP4_AXPY(0) FP4_AXPY(1) FP4_AXPY(2) FP4_AXPY(3)
#undef FP4_AXPY
                }
            }
        }
    }
    float y[16]; float s2 = 0.f;
#pragma unroll
    for (int q = 0; q < 4; ++q) { const f32x4_t gg = *(const f32x4_t*)(g2 + (size_t)b * gstride + 16 * lane + 4 * q);
#pragma unroll
        for (int i = 0; i < 4; ++i) { y[4 * q + i] = x[4 * q + i] + gg[i] * out[4 * q + i]; s2 += y[4 * q + i] * y[4 * q + i]; } }
    const float rn = 1.0f / sqrtf(wave_sum(s2) * (1.0f / DM) + EPS);
    if (!last) {
#pragma unroll
        for (int q = 0; q < 4; ++q) *(f32x4_t*)(xw + 4 * q) = (f32x4_t){y[4 * q], y[4 * q + 1], y[4 * q + 2], y[4 * q + 3]};
        float z[16];
#pragma unroll
        for (int q = 0; q < 4; ++q) { const f32x4_t g = *(const LAS f32x4_t*)(tabn + (b * 2 + 0) * 1024 + 16 * lane + 4 * q), s = *(const LAS f32x4_t*)(tabn + (b * 2 + 1) * 1024 + 16 * lane + 4 * q);
#pragma unroll
            for (int i = 0; i < 4; ++i) z[4 * q + i] = y[4 * q + i] * rn * g[i] + s[i]; }
        bf16_t* hp = Hn + (size_t)tok * DM + 16 * lane;
#pragma unroll
        for (int j = 0; j < 2; ++j) { u32x4_t wv; wv.x = pk2(z[8 * j], z[8 * j + 1]); wv.y = pk2(z[8 * j + 2], z[8 * j + 3]); wv.z = pk2(z[8 * j + 4], z[8 * j + 5]); wv.w = pk2(z[8 * j + 6], z[8 * j + 7]); *(u32x4_t*)(hp + 8 * j) = wv; }
    } else {
        float* op = outp + (size_t)tok * DM + 16 * lane;
#pragma unroll
        for (int q = 0; q < 4; ++q) { const f32x4_t fg = *(const f32x4_t*)(final_g + 16 * lane + 4 * q);
            *(f32x4_t*)(op + 4 * q) = (f32x4_t){y[4 * q] * rn * fg[0], y[4 * q + 1] * rn * fg[1], y[4 * q + 2] * rn * fg[2], y[4 * q + 3] * rn * fg[3]}; }
    }
}
__device__ __forceinline__ void row_to_fp4(const float* src, unsigned char* dst, float* scale_out, int lane) {
    float v[16]; float mx = 0.f;
#pragma unroll
    for (int q = 0; q < 4; ++q) { const f32x4_t a = *(const f32x4_t*)(src + 16 * lane + 4 * q); v[4 * q] = a[0]; v[4 * q + 1] = a[1]; v[4 * q + 2] = a[2]; v[4 * q + 3] = a[3]; }
#pragma unroll
    for (int i = 0; i < 16; ++i) mx = fmaxf(mx, fabsf(v[i]));
#pragma unroll
    for (int o = 1; o < 64; o <<= 1) mx = fmaxf(mx, __shfl_xor(mx, o));
    const float sc = mx > 0.f ? 6.0f / mx : 1.0f;
    u32x2_t w;
#pragma unroll
    for (int q = 0; q < 2; ++q) { unsigned t = 0u;
        t = __builtin_amdgcn_cvt_scalef32_pk_fp4_f32(t, v[8 * q + 0] * sc, v[8 * q + 1] * sc, 1.0f, 0);
        t = __builtin_amdgcn_cvt_scalef32_pk_fp4_f32(t, v[8 * q + 2] * sc, v[8 * q + 3] * sc, 1.0f, 1);
        t = __builtin_amdgcn_cvt_scalef32_pk_fp4_f32(t, v[8 * q + 4] * sc, v[8 * q + 5] * sc, 1.0f, 2);
        t = __builtin_amdgcn_cvt_scalef32_pk_fp4_f32(t, v[8 * q + 6] * sc, v[8 * q + 7] * sc, 1.0f, 3);
        w[q] = t; }
    *(u32x2_t*)(dst + 8 * lane) = w;
    if (lane == 0) *scale_out = mx > 0.f ? mx / 6.0f : 1.0f;
}
}

constexpr int LDS_MISC = 131072, LDS_BYTES = 131072 + 64;
constexpr int CW_BAR = 4096;
#ifndef REPMASK
#define REPMASK 0u
#endif
#define NREP(k) ((((REPMASK) >> (k)) & 1u) ? 2 : 1)
#define DBG_BASE 0
#ifndef ATM
#define ATM 7
#endif
#ifndef MK_N_LAUNCHES
#define MK_N_LAUNCHES 1
#endif
constexpr int PH_PER_LAYER = 9, N_PHASES = 2 + PH_PER_LAYER * DEPTH;

struct Args { const float* in[19]; float* out; unsigned char* ws; int ph_lo, ph_hi; };
enum { I_X = 0, I_C, I_N1G, I_N2G, I_WADA, I_BADA, I_WIN, I_WOUT, I_LQ1, I_LK1, I_LQ2, I_LK2, I_SUBG, I_SINK, I_PWQ, I_PKEYS, I_PU, I_PV, I_FG };

__device__ __forceinline__ void p0_transpose_item(const float* W, int K, int N, bf16_t* WT, LAS float* scr, int item, int lane) {
    const int nblk = N / 32, kb = item / nblk, nb = item % nblk, k0 = 64 * kb, n0 = 32 * nb;
#pragma unroll 8
    for (int i = 0; i < 32; ++i) { const int kk = 2 * i + (lane >> 5); scr[kk * 33 + (lane & 31)] = W[(size_t)(k0 + kk) * N + n0 + (lane & 31)]; }
    asm volatile("s_waitcnt lgkmcnt(0)" ::: "memory");
    const int c = lane & 7;
#pragma unroll
    for (int j = 0; j < 4; ++j) { const int n = (lane >> 3) + 8 * j; const LAS float* s = scr + (8 * c) * 33 + n;
        u32x4_t o; o.x = pk2(s[0 * 33], s[1 * 33]); o.y = pk2(s[2 * 33], s[3 * 33]); o.z = pk2(s[4 * 33], s[5 * 33]); o.w = pk2(s[6 * 33], s[7 * 33]);
        *(u32x4_t*)(WT + (size_t)(n0 + n) * K + k0 + 8 * c) = o; }
    asm volatile("s_waitcnt lgkmcnt(0)" ::: "memory");
}
__device__ __forceinline__ void cvt_rows(const float* src, bf16_t* dst, size_t n, size_t gtid, size_t gthreads) {
    for (size_t i = gtid * 8; i < n; i += gthreads * 8) {
        const f32x4_t a = *(const f32x4_t*)(src + i), c = *(const f32x4_t*)(src + i + 4);
        u32x4_t o; o.x = pk2(a[0], a[1]); o.y = pk2(a[2], a[3]); o.z = pk2(c[0], c[1]); o.w = pk2(c[2], c[3]);
        *(u32x4_t*)(dst + i) = o;
    }
}
__device__ __forceinline__ void build_table(LAS float* tab, const float* gvec, const float* mod_l, int sh_idx, int sc_idx) {
    for (int i = threadIdx.x; i < 4096; i += NTHREADS) { const int b = i >> 10, k = i & 1023;
        tab[(b * 2 + 0) * 1024 + k] = gvec[k] * (1.0f + mod_l[b * 6144 + sc_idx * 1024 + k]);
        tab[(b * 2 + 1) * 1024 + k] = mod_l[b * 6144 + sh_idx * 1024 + k]; }
}
__device__ __forceinline__ void norm_row(const float* xrow, bf16_t* orow, const LAS float* tab, int b, int lane) {
    const f32x4_t* xr = (const f32x4_t*)xrow + lane;
    f32x4_t v[4]; float s = 0.f;
#pragma unroll
    for (int j = 0; j < 4; ++j) { v[j] = xr[64 * j]; s += (v[j][0] * v[j][0] + v[j][1] * v[j][1]) + (v[j][2] * v[j][2] + v[j][3] * v[j][3]); }
    const float rstd = 1.0f / sqrtf(wave_sum(s) * (1.0f / DM) + EPS);
    unsigned long long* o8 = (unsigned long long*)orow + lane;
#pragma unroll
    for (int j = 0; j < 4; ++j) { const int k = 4 * lane + 256 * j;
        const f32x4_t g = *(const LAS f32x4_t*)(tab + (b * 2 + 0) * 1024 + k), sh = *(const LAS f32x4_t*)(tab + (b * 2 + 1) * 1024 + k);
        const f32x4_t y = v[j] * rstd * g + sh;
        o8[64 * j] = (unsigned long long)pk2(y[0], y[1]) | ((unsigned long long)pk2(y[2], y[3]) << 32); }
}

__global__ void __launch_bounds__(NTHREADS, 2) hymba_fwd(Args args) {
    extern __shared__ __attribute__((aligned(16))) unsigned char lds_raw[];
    LAS unsigned char* lds = (LAS unsigned char*)lds_raw;
    cg::grid_group grid = cg::this_grid();
    const int tid = threadIdx.x;
    const int wave = __builtin_amdgcn_readfirstlane(tid >> 6);
    const int G = gridDim.x, bx = blockIdx.x;
    const int gw = bx * NWAVES + wave, NGW = G * NWAVES;
    const int lo = args.ph_lo, hi_ = args.ph_hi;
#ifndef PHMASK
#define PHMASK 0xffffu
#endif
#define IN(k) (((PHMASK >> ((k) < 2 ? (k) : 2 + ((k) - 2) % PH_PER_LAYER)) & 1u) && lo <= (k) && (k) < hi_)
    if (tid < 16) ((volatile LAS unsigned*)(lds + LDS_MISC))[tid] = 0u;
    __syncthreads();
    (void)xcd_barrier_post((unsigned*)(args.ws + WS_CTL) + CW_BAR, (volatile LAS unsigned*)(lds + LDS_MISC));
#define SEAM(k) do { if (IN(k) && IN((k) + 1)) { if ((k) == 0) grid.sync(); else { XcdBarrier xb_; { size_t z_ = 0; asm volatile("" : "+s"(z_)); xb_.bar = (unsigned*)(args.ws + z_ + WS_CTL) + CW_BAR; } xb_.x = xb_xcc_id(); xb_.st = (volatile LAS unsigned*)(lds + LDS_MISC); xcd_barrier(xb_); } } } while (0)
#define PHASE_BEGIN() size_t wz_ = 0; asm volatile("" : "+s"(wz_)); unsigned char* ws = args.ws + wz_;     \
    int lane, ptid; { int t_ = threadIdx.x; asm volatile("" : "+v"(t_)); lane = t_ & 63; ptid = t_; } (void)lane; (void)ptid; \
    bf16_t* Wt_in = (bf16_t*)(ws + WS_WIN); bf16_t* Wt_out = (bf16_t*)(ws + WS_WOUT); bf16_t* Wt_q = (bf16_t*)(ws + WS_WQ); bf16_t* keysb = (bf16_t*)(ws + WS_KEYS); \
    float* modf = (float*)(ws + WS_MOD); float* kmean = (float*)(ws + WS_KMEAN); float* scal = (float*)(ws + WS_SCAL); \
    unsigned char* U8 = ws + WS_U; unsigned char* V8 = ws + WS_V; bf16_t* Hb = (bf16_t*)(ws + WS_H); \
    float* Us = (float*)(ws + WS_SCAL + 65536); float* Vs = (float*)(ws + WS_SCAL + 65536 + 262144); \
    bf16_t* Pj = (bf16_t*)(ws + WS_PROJ); bf16_t* Qp = (bf16_t*)(ws + WS_PROJ); bf16_t* Ob = (bf16_t*)(ws + WS_O); \
    int* Eid = (int*)(ws + WS_O); float* Gw = (float*)(ws + WS_O + 16 * MiB); unsigned* ctl = (unsigned*)(ws + WS_CTL); bf16_t* Pbuf = (bf16_t*)(ws + WS_PBUF); float* MLb = (float*)(ws + WS_ML); unsigned* RM = (unsigned*)(ws + WS_RM); (void)Pbuf; (void)MLb; (void)RM; \
    (void)Wt_in; (void)Wt_out; (void)Wt_q; (void)keysb; (void)modf; (void)kmean; (void)scal; (void)U8; (void)V8; (void)Hb; (void)Us; (void)Vs; (void)Pj; (void)Qp; (void)Ob; (void)Eid; (void)Gw; (void)ctl

    if (IN(0)) for (int rep = 0; rep < NREP(0); ++rep) {
        PHASE_BEGIN();
        if (bx < 192) {
            LAS float* cs = (LAS float*)lds;
            LAS float* red = (LAS float*)(lds + 16384);
            for (int i = tid; i < 4096; i += NTHREADS) { const float cv = args.in[I_C][i]; cs[i] = cv / (1.0f + __expf(-cv)); }
            __syncthreads();
            for (int it = bx; it < 192; it += G) {
                const int l = it / 96, n = (it % 96) * 64 + lane;
                const float* wp = args.in[I_WADA] + (size_t)l * DM * 6144 + n;
                float a0 = 0.f, a1 = 0.f, a2 = 0.f, a3 = 0.f;
#pragma unroll 8
                for (int k = wave * 128; k < wave * 128 + 128; ++k) { const float wv = wp[(size_t)k * 6144]; a0 += cs[k] * wv; a1 += cs[1024 + k] * wv; a2 += cs[2048 + k] * wv; a3 += cs[3072 + k] * wv; }
                red[(wave * 4 + 0) * 64 + lane] = a0; red[(wave * 4 + 1) * 64 + lane] = a1; red[(wave * 4 + 2) * 64 + lane] = a2; red[(wave * 4 + 3) * 64 + lane] = a3;
                __syncthreads();
                if (wave < 4) { float s = args.in[I_BADA][l * 6144 + n];
#pragma unroll
                    for (int w = 0; w < 8; ++w) s += red[(w * 4 + wave) * 64 + lane];
                    modf[((size_t)l * 4 + wave) * 6144 + n] = s; }
                __syncthreads();
            }
        }
        __syncthreads();
        {
            LAS float* scr = (LAS float*)(lds + wave * 16384);
            constexpr int I_IN = 16 * (INW / 32), I_OUT = 16 * (DM / 32), I_Q = 16 * (PQW / 32), PER_L = I_IN + I_OUT + I_Q;
            for (int it = gw; it < DEPTH * PER_L; it += NGW) {
                const int l = it / PER_L; int r = it % PER_L;
                if (r < I_IN) { p0_transpose_item(args.in[I_WIN] + (size_t)l * DM * INW, DM, INW, Wt_in + (size_t)l * INW * DM, scr, r, lane); continue; } r -= I_IN;
                if (r < I_OUT) { p0_transpose_item(args.in[I_WOUT] + (size_t)l * DM * DM, DM, DM, Wt_out + (size_t)l * DM * DM, scr, r, lane); continue; } r -= I_OUT;
                p0_transpose_item(args.in[I_PWQ] + (size_t)l * DM * PQW, DM, PQW, Wt_q + (size_t)l * PQW * DM, scr, r, lane);
            }
        }
        {
            const size_t gtid = (size_t)bx * NTHREADS + ptid, gth = (size_t)G * NTHREADS;
            cvt_rows(args.in[I_PKEYS], keysb, (size_t)DEPTH * PHEADS * 2 * 128 * 128, gtid, gth);
            for (int r = gw; r < 2 * DEPTH * PNEXP; r += NGW) { const int tb = r / (DEPTH * PNEXP), rr = r % (DEPTH * PNEXP);
                peer::row_to_fp4(args.in[tb ? I_PV : I_PU] + (size_t)rr * DM, (tb ? V8 : U8) + (size_t)rr * (DM / 2), (tb ? Vs : Us) + rr, lane); }
            for (size_t i = gtid; i < (size_t)DEPTH * 4 * 6 * 32 * 64; i += gth) kmean[i] = 0.f;
            if (gtid < DEPTH) { const int l = (int)gtid; float s1 = 0.f, s2 = 0.f;
                for (int i = 0; i < 32; ++i) { s1 += args.in[I_LQ1][l * 32 + i] * args.in[I_LK1][l * 32 + i]; s2 += args.in[I_LQ2][l * 32 + i] * args.in[I_LK2][l * 32 + i]; }
                const float lam_init = 0.8f - 0.6f * expf(-0.3f * (float)l);
                scal[l * 4 + 0] = expf(s1) - expf(s2) + lam_init; scal[l * 4 + 1] = lam_init; }
        }
    }
    SEAM(0);
    if (IN(1)) for (int rep = 0; rep < NREP(1); ++rep) {
        PHASE_BEGIN();
        LAS float* tab = (LAS float*)lds;
        build_table(tab, args.in[I_N1G], modf, 0, 1);
        __syncthreads();
        for (int m = gw; m < TOK; m += NGW) norm_row(args.in[I_X] + (size_t)m * DM, Hb + (size_t)m * DM, tab, m >> 13, lane);
        __syncthreads();
    }
    SEAM(1);

#pragma unroll 1
    for (int l = 0; l < DEPTH; ++l) {
        const int P = 2 + PH_PER_LAYER * l;
        if (IN(P + 0)) for (int rep = 0; rep < NREP(2); ++rep) {
            PHASE_BEGIN();
            pg8::Gemm g{Hb, Wt_in + (size_t)l * INW * DM, TOK, INW, DM}; pg8::StaticOrder S; S.init(TOK, INW, G, bx);
            pg8::EpiProj E{Pj, INW, kmean + (size_t)l * 4 * 6 * 32 * 64, rep == 0 ? OFF_KB : (1 << 28)};
            pg8::gemm_phase<pg8::EpiProj, pg8::StaticOrder, true, true>(lds, g, S, E);
        }
        SEAM(P + 0);
        if (IN(P + 1)) for (int rep = 0; rep < NREP(3); ++rep) {
            for (int u = bx; u < 768; u += G) { PHASE_BEGIN(); att::gate_unit((u % 24) / 6, u % 6, u / 24, Pj, kmean + (size_t)l * 4 * 6 * 32 * 64, RM, lds); }
            for (int u = bx; u < 128; u += G) { PHASE_BEGIN(); att::qknorm_unit(u >> 5, (u >> 3) & 3, u & 7, Pj, ctl + 2048 + ((rep * DEPTH + l) * 16 + (u >> 3)) * 2, ptid); }
        }
        SEAM(P + 1);
        if (IN(P + 2)) for (int rep = 0; rep < NREP(4); ++rep) {
            volatile LAS int* qw = (volatile LAS int*)(lds + LDS_MISC + 32);
#define NEXT_UNIT(mode) int idx; { PHASE_BEGIN(); if (tid == 0) qw[0] = (int)atomicAdd(ctl + 64 * ((rep * DEPTH + l) * 4 + (mode)), 1u); __syncthreads(); idx = qw[0]; }
            if (ATM & 1) for (;;) {
                NEXT_UNIT(0); if (idx >= 512) break;
                PHASE_BEGIN();
                const int qb = 31 - idx / 16, j = idx % 16;
                const unsigned* nw = ctl + 2048 + ((rep * DEPTH + l) * 16 + j) * 2;
                const float qn = sqrtf(__builtin_bit_cast(float, nw[0])), kn = sqrtf(__builtin_bit_cast(float, nw[1]));
                const float need = (40.0f + 0.17677669529663687f * LOG2E * qn * 2.0f * kn) / (alibi_slope(6 + (j & 3)) * LOG2E);
                const int dlim = need < 16384.0f ? (int)need + 1 : 16384;
                att::attn_unit<0>(j >> 2, j & 3, qb, Pj, Ob, nullptr, scal[l * 4 + 0], scal[l * 4 + 1], args.in[I_SUBG] + l * 64, nullptr, dlim, lds);
            }
            __syncthreads();
            if (ATM & 2) for (;;) {
                NEXT_UNIT(1); if (idx >= 768) break;
                PHASE_BEGIN();
                att::moba_unit((idx % 24) / 6, idx % 6, idx / 24, Pj, RM, Pbuf, MLb, lds);
            }
            __syncthreads();
            if (ATM & 4) for (;;) {
                NEXT_UNIT(2); if (idx >= 768) break;
                PHASE_BEGIN();
                const int qb = idx / 24, jj = idx % 24;
                att::attn_unit<2>(jj / 6, jj % 6, qb, Pj, Ob, nullptr, 0.f, 0.f, nullptr, args.in[I_SINK] + l * 6 + jj % 6, 0, lds);
            }
            __syncthreads();
#undef NEXT_UNIT
        }
        SEAM(P + 2);
        if (IN(P + 3)) for (int rep = 0; rep < NREP(5); ++rep) {
            PHASE_BEGIN();
            att::moba_combine(Pbuf, MLb, Ob, (size_t)bx * NTHREADS + ptid, (size_t)G * NTHREADS);
        }
        SEAM(P + 3);
        if (IN(P + 4)) for (int rep = 0; rep < NREP(6); ++rep) {
            PHASE_BEGIN();
            pg8::Gemm g{Ob, Wt_out + (size_t)l * DM * DM, TOK, DM, DM}; pg8::StaticOrder S; S.init(TOK, DM, G, bx);
            pg8::EpiRes E{(l == 0) ? args.in[I_X] : (const float*)args.out, (rep + 1 < NREP(6)) ? (float*)(ws + WS_PROJ) : args.out, DM, modf + (size_t)l * 4 * 6144 + 2 * 1024, 6144};
            pg8::gemm_phase<pg8::EpiRes, pg8::StaticOrder, true, true>(lds, g, S, E);
        }
        SEAM(P + 4);
        if (IN(P + 5)) for (int rep = 0; rep < NREP(7); ++rep) {
            PHASE_BEGIN();
            LAS float* tab = (LAS float*)lds;
            build_table(tab, args.in[I_N2G] + l * DM, modf + (size_t)l * 4 * 6144, 3, 4);
            __syncthreads();
            for (int m = gw; m < TOK; m += NGW) norm_row(args.out + (size_t)m * DM, Hb + (size_t)m * DM, tab, m >> 13, lane);
            __syncthreads();
        }
        SEAM(P + 5);
        if (IN(P + 6)) for (int rep = 0; rep < NREP(8); ++rep) {
            PHASE_BEGIN();
            pg8::Gemm g{Hb, Wt_q + (size_t)l * PQW * DM, TOK, PQW, DM}; pg8::StaticOrder S; S.init(TOK, PQW, G, bx);
            pg8::EpiBf16Plain E{Qp, PQW};
            pg8::gemm_phase<pg8::EpiBf16Plain, pg8::StaticOrder, true, true>(lds, g, S, E);
        }
        SEAM(P + 6);
        if (IN(P + 7)) for (int rep = 0; rep < NREP(9); ++rep) {
            PHASE_BEGIN();
            for (int u = bx; u < (TOK / 256) * PHEADS; u += G) peer::pk_unit(u >> 3, u & 7, Qp, keysb + (size_t)l * PHEADS * 2 * 128 * 128, Eid, Gw, lds);
            __syncthreads();
        }
        SEAM(P + 7);
        if (IN(P + 8)) for (int rep = 0; rep < NREP(10); ++rep) {
            PHASE_BEGIN();
            LAS float* tab2 = (LAS float*)lds; LAS float* tabn = (LAS float*)(lds + 32768);
            const bool last = (l == DEPTH - 1);
            const float* mod_l = modf + (size_t)l * 4 * 6144;
            build_table(tab2, args.in[I_N2G] + l * DM, mod_l, 3, 4);
            if (!last) build_table(tabn, args.in[I_N1G] + (l + 1) * DM, mod_l + 4 * 6144, 0, 1);
            __syncthreads();
            float* dry = (float*)(ws + WS_PROJ);
            for (int m = gw; m < TOK; m += NGW)
                peer::pg_token(m, args.out, (rep + 1 < NREP(10)) ? dry : args.out, tab2, mod_l + 5 * 1024, 6144, Eid, Gw, U8 + (size_t)l * PNEXP * (DM / 2), V8 + (size_t)l * PNEXP * (DM / 2), Us + l * PNEXP, Vs + l * PNEXP,
                                last, tabn, args.in[I_FG], Hb, (rep + 1 < NREP(10)) ? dry : args.out, lane);
            __syncthreads();
        }
        if (l + 1 < DEPTH) SEAM(P + 8);
    }
#undef IN
#undef SEAM
}

#ifdef DBG
__global__ void dbg_chk16(const bf16_t* p, size_t n, unsigned* flag, unsigned bit) {
    bool bad = false;
    for (size_t i = (size_t)blockIdx.x * blockDim.x + threadIdx.x; i < n; i += (size_t)gridDim.x * blockDim.x) bad |= ((p[i] & 0x7f80u) == 0x7f80u);
    if (bad) atomicOr(flag, bit);
}
__global__ void dbg_chk32(const float* p, size_t n, unsigned* flag, unsigned bit) {
    bool bad = false;
    for (size_t i = (size_t)blockIdx.x * blockDim.x + threadIdx.x; i < n; i += (size_t)gridDim.x * blockDim.x) bad |= ((__builtin_bit_cast(unsigned, p[i]) & 0x7f800000u) == 0x7f800000u);
    if (bad) atomicOr(flag, bit);
}
__global__ void dbg_chk_o(const bf16_t* p, unsigned* flag) {
    unsigned bad = 0;
    for (size_t i = (size_t)blockIdx.x * blockDim.x + threadIdx.x; i < (size_t)TOK * DM; i += (size_t)gridDim.x * blockDim.x) {
        if ((p[i] & 0x7f80u) == 0x7f80u) { const int c = (int)(i & 1023); const int r = (int)((i >> 10) & 8191); bad |= (c < 256) ? 1u : (c < 640 ? 2u : 4u); if (r < 256) bad |= 8u; if ((r & 255) < 32) bad |= 16u; if (p[i] & 0x7fu) bad |= 32u; }
    }
    if (bad) atomicOr(flag, bad);
}
__global__ void dbg_fill(float* out, size_t n, const unsigned* flag) {
    const unsigned f = *flag; if (f == 0u) return;
    const float c = sqrtf((float)f);
    for (size_t i = (size_t)blockIdx.x * blockDim.x + threadIdx.x; i < n; i += (size_t)gridDim.x * blockDim.x) out[i] = c;
}
#endif
extern "C" void kernel_launch(void* const* d_in, const int* in_sizes, int n_in, void* d_out, int out_size, void* d_ws, size_t ws_size, hipStream_t stream) {
    static int grid = 0;
    if (grid == 0) {
        if (n_in != 19 || out_size != TOK * DM || ws_size < WS_END) { fprintf(stderr, "kernel_launch: unexpected shapes (n_in %d out %d ws %zu)\n", n_in, out_size, ws_size); grid = -1; return; }
        int dev = 0, cus = 0, per_cu = 0;
        hipGetDevice(&dev); hipDeviceGetAttribute(&cus, hipDeviceAttributeMultiprocessorCount, dev);
        hipFuncSetAttribute((const void*)hymba_fwd, hipFuncAttributeMaxDynamicSharedMemorySize, LDS_BYTES);
        hipOccupancyMaxActiveBlocksPerMultiprocessor(&per_cu, (const void*)hymba_fwd, NTHREADS, LDS_BYTES);
        (void)hipGetLastError();
        if (per_cu < 1) per_cu = 1;
        if (per_cu > 1) per_cu = 1;
        grid = cus * per_cu;
        if (grid <= 0) grid = 256;
    }
    if (grid < 0) return;
    hipMemsetAsync((char*)d_ws + WS_CTL, 0, CTL_ZERO_BYTES, stream);
    Args a{};
    for (int i = 0; i < 19; ++i) a.in[i] = (const float*)d_in[i];
    a.out = (float*)d_out; a.ws = (unsigned char*)d_ws;
#if MK_N_LAUNCHES == 1
    a.ph_lo = 0; a.ph_hi = N_PHASES;
    void* kargs[] = {&a};
    hipError_t e = hipLaunchCooperativeKernel((const void*)hymba_fwd, dim3(grid), dim3(NTHREADS), kargs, LDS_BYTES, stream);
    if (e != hipSuccess) fprintf(stderr, "cooperative launch failed: %s (grid %d)\n", hipGetErrorString(e), grid);
#else
    for (int p = 0; p < N_PHASES; ++p) { a.ph_lo = p; a.ph_hi = p + 1; hipLaunchKernelGGL(hymba_fwd, dim3(grid), dim3(NTHREADS), LDS_BYTES, stream, a);
#ifdef DBG
        unsigned* flag = (unsigned*)((char*)d_ws + WS_CTL); unsigned char* w = (unsigned char*)d_ws;
        const int base = DBG_BASE;
        if (p == 3) dbg_chk_o<<<1024, 256, 0, stream>>>((const bf16_t*)(w + WS_O), flag);
#endif
    }
#ifdef DBG
    dbg_fill<<<1024, 256, 0, stream>>>((float*)d_out, (size_t)TOK * DM, (const unsigned*)((char*)d_ws + WS_CTL));
#endif
#endif
}
```

```cpp
#include <hip/hip_runtime.h>
#include <hip/hip_cooperative_groups.h>
#include <cstdio>
#include <cstdint>
#include <cmath>
namespace cg = cooperative_groups;

constexpr int DM = 1024, NBATCH = 4, SEQ = 8192, DEPTH = 2, TOK = NBATCH * SEQ;
constexpr int INW = 2560, NMOD = 6;
constexpr int OFF_QA = 0, OFF_KA = 256, OFF_VA = 512, OFF_QB = 768, OFF_KB = 1152, OFF_VB = 1536, OFF_QC = 1920, OFF_KC = 2304, OFF_VC = 2432;
constexpr int PHEADS = 8, PQW = 2048, PNK = 128, PNEXP = 16384, PTOPK = 16;
constexpr float EPS = 1e-6f;
constexpr float LOG2E = 1.4426950408889634f;
constexpr int NWAVES = 8, NTHREADS = 512;

constexpr size_t MiB = 1u << 20;
constexpr size_t WS_CTL = 0, CTL_ZERO_BYTES = 64 * 1024;
constexpr size_t WS_WIN = 1 * MiB;
constexpr size_t WS_WOUT = 11 * MiB;
constexpr size_t WS_WQ = 15 * MiB;
constexpr size_t WS_KEYS = 23 * MiB;
constexpr size_t WS_MOD = 24 * MiB;
constexpr size_t WS_KMEAN = 24 * MiB + 256 * 1024;
constexpr size_t WS_SCAL = 25 * MiB;
constexpr size_t WS_U = 26 * MiB;
constexpr size_t WS_V = 58 * MiB;
constexpr size_t WS_H = 90 * MiB;
constexpr size_t WS_PROJ = 154 * MiB;
constexpr size_t WS_O = 314 * MiB;
constexpr size_t WS_PBUF = 378 * MiB;
constexpr size_t WS_ML = 474 * MiB;
constexpr size_t WS_RM = 480 * MiB;
constexpr size_t WS_END = 482 * MiB;

#define GAS __attribute__((address_space(1)))
#define LAS __attribute__((address_space(3)))
typedef unsigned short bf16_t;
typedef short bf16x8_t __attribute__((ext_vector_type(8)));
typedef short s16x4_t __attribute__((ext_vector_type(4)));
typedef float f32x4_t __attribute__((ext_vector_type(4)));
typedef float f32x16_t __attribute__((ext_vector_type(16)));
typedef unsigned u32x4_t __attribute__((ext_vector_type(4)));
typedef unsigned u32x2_t __attribute__((ext_vector_type(2)));

__device__ __forceinline__ unsigned f2bf(float f) { unsigned u = __builtin_bit_cast(unsigned, f); return (u + 0x7fffu + ((u >> 16) & 1u)) >> 16; }
__device__ __forceinline__ unsigned pk2(float lo, float hi) { return f2bf(lo) | (f2bf(hi) << 16); }
__device__ __forceinline__ float bf_lo(unsigned w) { return __builtin_bit_cast(float, w << 16); }
__device__ __forceinline__ float bf_hi(unsigned w) { return __builtin_bit_cast(float, w & 0xffff0000u); }
__device__ __forceinline__ float wave_sum(float v) {
#pragma unroll
    for (int o = 1; o < 64; o <<= 1) v += __shfl_xor(v, o);
    return v;
}
__device__ __forceinline__ float swap32_partner(float v, int) { return __shfl_xor(v, 32); }
__device__ __forceinline__ float alibi_slope(int i) { return exp2f(-0.5f * (float)(i + 1)); }

typedef GAS unsigned gu32;
#define RLX_AGENT __ATOMIC_RELAXED, __HIP_MEMORY_SCOPE_AGENT
#define XB_TMO      128
#define XB_XCNT(j)  (256  + 64 * (j))
#define XB_XSUB(j)  (1280 + 64 * (j))
#define XB_XGEN(j)  (2304 + 64 * (j))
#define XB_TOP      3328
#define XB_TOPGEN   3392
#define XCD_BAR_WORDS 3456
#define XB_SPIN_CAP (1u << 18)

__device__ __forceinline__ unsigned xb_ld(unsigned* p)              { return __hip_atomic_load(p, __ATOMIC_RELAXED, __HIP_MEMORY_SCOPE_AGENT); }
__device__ __forceinline__ unsigned xb_add(unsigned* p, unsigned v) { return __hip_atomic_fetch_add(p, v, __ATOMIC_RELAXED, __HIP_MEMORY_SCOPE_AGENT); }
__device__ __forceinline__ unsigned xb_xcc_id() { return (unsigned)__builtin_amdgcn_s_getreg((3 << 11) | 20) & 0xFu; }
#define XB_SPIN(cond, bar) do { unsigned _sp = 0; while (cond) { __builtin_amdgcn_s_sleep(1); \
    if ((++_sp & 255u) == 0u) { if (xb_ld(&(bar)[XB_TMO])) break; if (_sp > XB_SPIN_CAP) { atomicAdd(&(bar)[XB_TMO], 1u); break; } } } } while (0)

struct XcdBarrier {
    unsigned* bar; unsigned x;
    volatile LAS unsigned* st;
};

__device__ __forceinline__ XcdBarrier xcd_barrier_post(unsigned* bar, volatile LAS unsigned* st) {
    XcdBarrier b; b.bar = bar; b.x = xb_xcc_id(); b.st = st;
    if (threadIdx.x == 0) (void)xb_add(&bar[XB_XCNT(b.x)], 1u);
    return b;
}
__device__ __forceinline__ void xcd_barrier_complete(unsigned* bar, unsigned x, unsigned& nloc, unsigned& nx) {
    const unsigned G = gridDim.x * gridDim.y * gridDim.z;
    unsigned sum, cnt, mine, sp = 0u;
    for (;;) {
        sum = 0u; cnt = 0u; mine = 0u;
#pragma unroll
        for (unsigned j = 0; j < 16; ++j) { const unsigned c = xb_ld(&bar[XB_XCNT(j)]); sum += c; cnt += (c > 0u) ? 1u : 0u; mine = (j == x) ? c : mine; }
        if (sum == G) break;
        __builtin_amdgcn_s_sleep(1);
        if ((++sp & 255u) == 0u) { if (xb_ld(&bar[XB_TMO])) break; if (sp > XB_SPIN_CAP) { atomicAdd(&bar[XB_TMO], 1u); break; } }
    }
    nloc = mine > 0u ? mine : 1u; nx = cnt > 0u ? cnt : 1u;
}

__device__ __forceinline__ void xcd_barrier(const XcdBarrier& b) {
    asm volatile("s_waitcnt vmcnt(0)" ::: "memory");
    __syncthreads();
    if (threadIdx.x == 0) {
        unsigned* bar = b.bar;
        __builtin_amdgcn_s_waitcnt(0);
        unsigned nloc = b.st[0], nx = b.st[1];
        if (nloc == 0u) { xcd_barrier_complete(bar, b.x, nloc, nx); b.st[0] = nloc; b.st[1] = nx; }
        const unsigned old = xb_add(&bar[XB_XSUB(b.x)], 1u);
        const unsigned gen = old / nloc;
        if (old + 1u == (gen + 1u) * nloc) {
            __builtin_amdgcn_fence(__ATOMIC_RELEASE, "agent");
            asm volatile("s_waitcnt vmcnt(0)" ::: "memory");
            const unsigned og = xb_add(&bar[XB_TOP], 1u);
            const unsigned tg = og / nx;
            if (og + 1u == (tg + 1u) * nx) xb_add(&bar[XB_TOPGEN], 1u);
            else XB_SPIN(xb_ld(&bar[XB_TOPGEN]) == tg, bar);
            __builtin_amdgcn_fence(__ATOMIC_ACQUIRE, "agent");
            xb_add(&bar[XB_XGEN(b.x)], 1u);
            asm volatile("s_waitcnt vmcnt(0)" ::: "memory");
        } else {
            XB_SPIN(xb_ld(&bar[XB_XGEN(b.x)]) == gen, bar);
            __builtin_amdgcn_fence(__ATOMIC_ACQUIRE, "agent");
            asm volatile("s_waitcnt vmcnt(0)" ::: "memory");
        }
    }
    __syncthreads();
}

namespace pg8 {
#define PG8_LAS __attribute__((address_space(3)))
typedef unsigned short bf16_t;
typedef short bf16x8 __attribute__((ext_vector_type(8)));
typedef float f32x4 __attribute__((ext_vector_type(4)));
typedef unsigned u32x4 __attribute__((ext_vector_type(4)));
constexpr int BM = 256, BK = 64, HALF = 128, HTB = HALF * BK * 2  , STAGE_BYTES = 8 * HTB, NXCD = 8, WGM = 8;

__host__ __device__ __forceinline__ int lds_byte(int r, int c) { const int st = (r >> 4) * 2 + (c >> 5), rr = r & 15, cc = c & 31, ob = rr * 64 + cc * 2; return st * 1024 + (ob ^ (((ob >> 9) & 1) << 5)); }
__host__ __device__ __forceinline__ void stage_rc(int b, int& R, int& C) { const int st = b / 1024, sb = b % 1024, swz = sb ^ (((sb >> 9) & 1) << 5); R = (st >> 1) * 16 + swz / 64; C = (st & 1) * 32 + (swz % 64) / 2; }
__host__ __device__ __forceinline__ int perm32(int rho) { const int n = rho >> 4, i = rho & 15; return 8 * (i >> 2) + 4 * n + (i & 3); }

struct Unit { int pm, pn; };
struct Gemm { const bf16_t* A; const bf16_t* Bt; int M, N, K; };

struct StaticOrder {
    int nM, nN, nwg, G, c;
    __host__ __device__ void init(int M, int N, int G_, int c_) { nM = M / BM; nN = N / BM; nwg = nM * nN; G = G_; c = c_; }
    __host__ __device__ bool next(int i, Unit& u) const {
        const long L = (long)i * G + c; if (L >= nwg) return false;
        int wgid = (int)L; { const int q = nwg / NXCD, r = nwg % NXCD, xcd = wgid % NXCD, off = wgid / NXCD; wgid = (xcd < r ? xcd * (q + 1) : r * (q + 1) + (xcd - r) * q) + off; }
        const int nig = WGM * nN, gid = wgid / nig, fm = gid * WGM, gsz = (nM - fm) < WGM ? (nM - fm) : WGM;
        u.pm = fm + ((wgid % nig) % gsz); u.pn = (wgid % nig) / gsz; return true;
    }
    __device__ __forceinline__ void a_ready(const Unit&) const {}
    __device__ __forceinline__ void done(const Unit&) const {}
};

__device__ __forceinline__ unsigned cvt_pk_bf16(float lo, float hi) { unsigned r; asm volatile("v_cvt_pk_bf16_f32 %0, %1, %2" : "=v"(r) : "v"(lo), "v"(hi)); return r; }
struct EpiBf16Plain {
    static constexpr bool PERM = true, AFTER_DRAIN = false;
    bf16_t* O; int ldc;
    __device__ __forceinline__ void operator()(const f32x4 (&acc)[2][2][4][2], const Unit& u, int wr, int wc, int fr, int fq) const {
        const int row0 = u.pm * BM + wr * 64 + fr, col0 = u.pn * BM + wc * 32 + 8 * fq;
#pragma unroll
        for (int ai = 0; ai < 2; ++ai)
#pragma unroll
            for (int m = 0; m < 4; ++m) { bf16_t* rowp = O + (size_t)(row0 + ai * HALF + m * 16) * ldc + col0;
#pragma unroll
                for (int bj = 0; bj < 2; ++bj) { const f32x4 v0 = acc[ai][bj][m][0], v1 = acc[ai][bj][m][1];
                    u32x4 w; w.x = cvt_pk_bf16(v0[0], v0[1]); w.y = cvt_pk_bf16(v0[2], v0[3]); w.z = cvt_pk_bf16(v1[0], v1[1]); w.w = cvt_pk_bf16(v1[2], v1[3]);
                    *(u32x4*)(rowp + bj * HALF) = w; } }
    }
};
struct EpiProj {
    static constexpr bool PERM = true, AFTER_DRAIN = false;
    bf16_t* O; int ldc; float* kmean; int kb_lo;
    __device__ __forceinline__ void operator()(const f32x4 (&acc)[2][2][4][2], const Unit& u, int wr, int wc, int fr, int fq) const {
        const int row0 = u.pm * BM + wr * 64 + fr, col0 = u.pn * BM + wc * 32 + 8 * fq;
#pragma unroll
        for (int ai = 0; ai < 2; ++ai)
#pragma unroll
            for (int m = 0; m < 4; ++m) { bf16_t* rowp = O + (size_t)(row0 + ai * HALF + m * 16) * ldc + col0;
#pragma unroll
                for (int bj = 0; bj < 2; ++bj) { const f32x4 v0 = acc[ai][bj][m][0], v1 = acc[ai][bj][m][1];
                    u32x4 w; w.x = cvt_pk_bf16(v0[0], v0[1]); w.y = cvt_pk_bf16(v0[2], v0[3]); w.z = cvt_pk_bf16(v1[0], v1[1]); w.w = cvt_pk_bf16(v1[2], v1[3]);
                    *(u32x4*)(rowp + bj * HALF) = w; } }
#pragma unroll
        for (int bj = 0; bj < 2; ++bj) {
            const int cb = u.pn * BM + bj * HALF;
            if (cb >= kb_lo && cb < kb_lo + 384) {
                f32x4 s0 = {0.f, 0.f, 0.f, 0.f}, s1 = {0.f, 0.f, 0.f, 0.f};
#pragma unroll
                for (int ai = 0; ai < 2; ++ai)
#pragma unroll
                    for (int m = 0; m < 4; ++m) { s0 += acc[ai][bj][m][0]; s1 += acc[ai][bj][m][1]; }
#pragma unroll
                for (int i = 0; i < 4; ++i) {
#pragma unroll
                    for (int o = 1; o < 16; o <<= 1) { s0[i] += __shfl_xor(s0[i], o); s1[i] += __shfl_xor(s1[i], o); }
                }
                if (fr == 0) {
                    const int c = cb + wc * 32 + 8 * fq - kb_lo, h = c >> 6, d = c & 63, b = u.pm >> 5, nb = u.pm & 31;
                    float* kp = kmean + ((size_t)((b * 6 + h) * 32 + nb)) * 64 + d;
#pragma unroll
                    for (int i = 0; i < 4; ++i) { atomicAdd(kp + i, s0[i]); atomicAdd(kp + 4 + i, s1[i]); }
                }
            }
        }
    }
};
struct EpiRes {
    static constexpr bool PERM = false, AFTER_DRAIN = false;
    const float* base; float* out; int ldc; const float* gate; int gstride;
    __device__ __forceinline__ void operator()(const f32x4 (&acc)[2][2][4][2], const Unit& u, int wr, int wc, int fr, int fq) const {
        const int row0 = u.pm * BM + wr * 64 + fr, col0 = u.pn * BM + wc * 32 + 4 * fq;
        const float* gp = gate + (size_t)(u.pm >> 5) * gstride + col0;
        f32x4 gv[2][2];
#pragma unroll
        for (int bj = 0; bj < 2; ++bj)
#pragma unroll
            for (int n = 0; n < 2; ++n) gv[bj][n] = *(const f32x4*)(gp + bj * HALF + n * 16);
#pragma unroll
        for (int ai = 0; ai < 2; ++ai)
#pragma unroll
            for (int m = 0; m < 4; ++m) { const size_t off = (size_t)(row0 + ai * HALF + m * 16) * ldc + col0;
#pragma unroll
                for (int bj = 0; bj < 2; ++bj)
#pragma unroll
                    for (int n = 0; n < 2; ++n) { const f32x4 bs = *(const f32x4*)(base + off + bj * HALF + n * 16);
                        *(f32x4*)(out + off + bj * HALF + n * 16) = bs + gv[bj][n] * acc[ai][bj][m][n]; } }
    }
};

template <class Epi, class Sched, bool ALIGN_EPI = false, bool SP2 = false>
__device__ __forceinline__ void gemm_phase(PG8_LAS unsigned char* lds, const Gemm g, const Sched& S, const Epi& E) {
    int tid_ = threadIdx.x; asm volatile("" : "+v"(tid_));
    const int tid = tid_, wid = __builtin_amdgcn_readfirstlane(tid >> 6), lane = tid & 63, wr = wid >> 2, wc = wid & 3, fr = lane & 15, fq = lane >> 4;
    const int K = g.K, nt = K / BK;
    unsigned voffA[2], voffB[2];
#pragma unroll
    for (int i = 0; i < 2; ++i) { int R, C; stage_rc(tid * 16 + i * 8192, R, C); const int Rb = Epi::PERM ? ((R & ~31) + perm32(R & 31)) : R;
        voffA[i] = (unsigned)(R * K + C) * 2u; voffB[i] = (unsigned)(Rb * K + C) * 2u; }
    const size_t kstep = (size_t)(BK * 2);
    const size_t hstep = (size_t)HALF * K * 2;
    const size_t tstep = 2 * hstep;
    const unsigned ldsw = (unsigned)wid * 1024u;
    const int aoff = lds_byte(wr * 64 + fr, fq * 8), boff = lds_byte(wc * 32 + fr, fq * 8);
#define PG8_SA(b, h) (((b) * 2 + (h)) * HTB)
#define PG8_SB(b, h) ((4 + (b) * 2 + (h)) * HTB)
#define PG8_STAGE(bufoff, gbase, voff) do { _Pragma("unroll") for (int _i = 0; _i < 2; ++_i) \
        __builtin_amdgcn_global_load_lds((const unsigned*)((const char*)(gbase) + (voff)[_i]), (PG8_LAS unsigned*)(lds + (bufoff) + ldsw + _i * 8192), 16, 0, 0); } while (0)
#define PG8_LDA(dst, b, h) do { _Pragma("unroll") for (int m = 0; m < 4; ++m) _Pragma("unroll") for (int k = 0; k < 2; ++k) dst[m][k] = *(const PG8_LAS bf16x8*)(lds + PG8_SA(b, h) + aoff + m * 2048 + k * 1024); } while (0)
#define PG8_LDB(dst, b, h) do { _Pragma("unroll") for (int n = 0; n < 2; ++n) _Pragma("unroll") for (int k = 0; k < 2; ++k) dst[n][k] = *(const PG8_LAS bf16x8*)(lds + PG8_SB(b, h) + boff + n * 2048 + k * 1024); } while (0)
#define PG8_MMA(ai, bj, At, Bt) do { __builtin_amdgcn_s_setprio(1); _Pragma("unroll") for (int m = 0; m < 4; ++m) _Pragma("unroll") for (int n = 0; n < 2; ++n) _Pragma("unroll") for (int k = 0; k < 2; ++k) \
        acc[ai][bj][m][n] = __builtin_amdgcn_mfma_f32_16x16x32_bf16(Bt[n][k], At[m][k], acc[ai][bj][m][n], 0, 0, 0); __builtin_amdgcn_s_setprio(0); } while (0)
#define PG8_WAIT_V(n) asm volatile("s_waitcnt vmcnt(" #n ")" ::: "memory")
#define PG8_WAIT_L(n) asm volatile("s_waitcnt lgkmcnt(" #n ")" ::: "memory")
#define PG8_BAR __builtin_amdgcn_s_barrier()
#define PG8_SCHED __builtin_amdgcn_sched_barrier(0)
    Unit cur, nxt; int ui = 0;
    if (!S.next(0, cur)) return;
    f32x4 acc[2][2][4][2];
#pragma unroll
    for (int a = 0; a < 2; ++a)
#pragma unroll
        for (int b = 0; b < 2; ++b)
#pragma unroll
            for (int m = 0; m < 4; ++m)
#pragma unroll
                for (int n = 0; n < 2; ++n) acc[a][b][m][n] = (f32x4){0.f, 0.f, 0.f, 0.f};
    bf16x8 At[4][2], B0[2][2], B1[2][2];
    const char* cA = (const char*)g.A + (size_t)cur.pm * tstep; const char* cB = (const char*)g.Bt + (size_t)cur.pn * tstep;
    S.a_ready(cur);
    if constexpr (SP2) {
        PG8_STAGE(PG8_SB(0, 0), cB, voffB); PG8_STAGE(PG8_SB(0, 1), cB + hstep, voffB); PG8_STAGE(PG8_SA(0, 0), cA, voffA); PG8_STAGE(PG8_SA(0, 1), cA + hstep, voffA);
        if (wr == 1) PG8_BAR;
        PG8_WAIT_V(2); PG8_BAR;
        PG8_STAGE(PG8_SB(1, 0), cB + kstep, voffB); PG8_STAGE(PG8_SA(1, 0), cA + kstep, voffA); PG8_STAGE(PG8_SB(1, 1), cB + hstep + kstep, voffB);
        PG8_WAIT_V(6); PG8_BAR;
    } else {
        PG8_STAGE(PG8_SB(0, 0), cB, voffB); PG8_STAGE(PG8_SA(0, 0), cA, voffA); PG8_STAGE(PG8_SB(0, 1), cB + hstep, voffB); PG8_STAGE(PG8_SA(0, 1), cA + hstep, voffA);
        if (wr == 1) PG8_BAR;
        PG8_WAIT_V(4); PG8_BAR;
        PG8_STAGE(PG8_SB(1, 0), cB + kstep, voffB); PG8_STAGE(PG8_SA(1, 0), cA + kstep, voffA); PG8_STAGE(PG8_SB(1, 1), cB + hstep + kstep, voffB);
        PG8_WAIT_V(6); PG8_BAR;
    }
    for (;;) {
        const bool has_next = S.next(ui + 1, nxt);
        const char* nA = has_next ? (const char*)g.A + (size_t)nxt.pm * tstep : cA; const char* nB = has_next ? (const char*)g.Bt + (size_t)nxt.pn * tstep : cB;
        for (int t = 0; t < nt; t += 2) {
            const bool last = (t == nt - 2);
            const char* a1 = cA + (size_t)(t + 1) * kstep;
            const char* a2 = last ? nA : cA + (size_t)(t + 2) * kstep; const char* b2 = last ? nB : cB + (size_t)(t + 2) * kstep;
            const char* a3 = a2 + kstep; const char* b3 = b2 + kstep;
            if (last && has_next) S.a_ready(nxt);
            if constexpr (SP2) {
            PG8_LDB(B0, 0, 0); PG8_LDB(B1, 0, 1); PG8_SCHED; PG8_LDA(At, 0, 0); PG8_STAGE(PG8_SA(1, 1), a1 + hstep, voffA);
            PG8_WAIT_V(8); PG8_WAIT_L(0); PG8_BAR; PG8_MMA(0, 0, At, B0); PG8_MMA(0, 1, At, B1); PG8_BAR; PG8_SCHED;
            PG8_LDA(At, 0, 1); PG8_STAGE(PG8_SB(0, 0), b2, voffB); PG8_STAGE(PG8_SB(0, 1), b2 + hstep, voffB); PG8_STAGE(PG8_SA(0, 0), a2, voffA);
            PG8_WAIT_V(8); PG8_WAIT_L(0); PG8_BAR; PG8_MMA(1, 0, At, B0); PG8_MMA(1, 1, At, B1); PG8_BAR; PG8_SCHED;
            PG8_LDB(B0, 1, 0); PG8_LDB(B1, 1, 1); PG8_SCHED; PG8_LDA(At, 1, 0); PG8_STAGE(PG8_SA(0, 1), a2 + hstep, voffA);
            PG8_WAIT_V(8); PG8_WAIT_L(0); PG8_BAR; PG8_MMA(0, 0, At, B0); PG8_MMA(0, 1, At, B1); PG8_BAR; PG8_SCHED;
            PG8_LDA(At, 1, 1); PG8_STAGE(PG8_SB(1, 0), b3, voffB); PG8_STAGE(PG8_SB(1, 1), b3 + hstep, voffB); PG8_STAGE(PG8_SA(1, 0), a3, voffA);
            PG8_WAIT_V(8); PG8_WAIT_L(0); PG8_BAR; PG8_MMA(1, 0, At, B0); PG8_MMA(1, 1, At, B1); PG8_BAR; PG8_SCHED;
            } else {
            PG8_LDB(B0, 0, 0); PG8_SCHED; PG8_LDA(At, 0, 0); PG8_STAGE(PG8_SA(1, 1), a1 + hstep, voffA);
            PG8_WAIT_L(8); PG8_BAR; PG8_WAIT_L(0); PG8_MMA(0, 0, At, B0); PG8_BAR; PG8_SCHED;
            PG8_LDB(B1, 0, 1); PG8_STAGE(PG8_SB(0, 0), b2, voffB);
            PG8_BAR; PG8_WAIT_L(0); PG8_MMA(0, 1, At, B1); PG8_BAR;
            PG8_LDA(At, 0, 1); PG8_STAGE(PG8_SA(0, 0), a2, voffA);
            PG8_BAR; PG8_WAIT_L(0); PG8_MMA(1, 0, At, B0); PG8_BAR; PG8_SCHED;
            PG8_STAGE(PG8_SB(0, 1), b2 + hstep, voffB);
            PG8_WAIT_V(6); PG8_BAR; PG8_MMA(1, 1, At, B1); PG8_BAR;
            PG8_LDB(B0, 1, 0); PG8_SCHED; PG8_LDA(At, 1, 0); PG8_STAGE(PG8_SA(0, 1), a2 + hstep, voffA);
            PG8_WAIT_L(8); PG8_BAR; PG8_WAIT_L(0); PG8_MMA(0, 0, At, B0); PG8_BAR; PG8_SCHED;
            PG8_LDB(B1, 1, 1); PG8_STAGE(PG8_SB(1, 0), b3, voffB);
            PG8_BAR; PG8_WAIT_L(0); PG8_MMA(0, 1, At, B1); PG8_BAR;
            PG8_LDA(At, 1, 1); PG8_STAGE(PG8_SA(1, 0), a3, voffA);
            PG8_BAR; PG8_WAIT_L(0); PG8_MMA(1, 0, At, B0); PG8_BAR; PG8_SCHED;
            PG8_STAGE(PG8_SB(1, 1), b3 + hstep, voffB);
            PG8_WAIT_V(6); PG8_BAR; PG8_MMA(1, 1, At, B1); PG8_BAR;
            }
        }
        if constexpr (ALIGN_EPI) { if (wr == 0) PG8_BAR; }
        if constexpr (!Epi::AFTER_DRAIN) { E(acc, cur, wr, wc, fr, fq); S.done(cur); }
        if (!has_next) break;
#pragma unroll
        for (int a = 0; a < 2; ++a)
#pragma unroll
            for (int b = 0; b < 2; ++b)
#pragma unroll
                for (int m = 0; m < 4; ++m)
#pragma unroll
                    for (int n = 0; n < 2; ++n) acc[a][b][m][n] = (f32x4){0.f, 0.f, 0.f, 0.f};
        cur = nxt; cA = nA; cB = nB; ++ui;
        if constexpr (ALIGN_EPI) { if (wr == 1) PG8_BAR; }
    }
    PG8_WAIT_V(0);
    if constexpr (!ALIGN_EPI) { if (wr == 0) PG8_BAR; }
    PG8_BAR;
    if constexpr (Epi::AFTER_DRAIN) { E.fused(acc, cur, wr, wc, fr, fq, lds, wid, lane); S.done(cur); }
#undef PG8_SA
#undef PG8_SB
#undef PG8_STAGE
#undef PG8_LDA
#undef PG8_LDB
#undef PG8_MMA
#undef PG8_WAIT_V
#undef PG8_WAIT_L
#undef PG8_BAR
#undef PG8_SCHED
}
}
namespace att {
constexpr int A_K = 0, A_V = 16384, A_WSF = 32768, A_KM = A_WSF + 2048, A_STG = A_KM + 8192;
constexpr int STG_STRIDE = 68, STG_WAVE_BYTES = 32 * STG_STRIDE * 4, A_END = A_STG + NWAVES * STG_WAVE_BYTES;
__device__ __forceinline__ int crow(int r, int hi) { return (r & 3) + 8 * (r >> 2) + 4 * hi; }
__device__ __forceinline__ void dma16(const void* g, LAS unsigned char* l) { __builtin_amdgcn_global_load_lds((const unsigned*)g, (LAS unsigned*)l, 16, 0, 0); }
typedef float f32x2_t __attribute__((ext_vector_type(2))); typedef __bf16 bf16x2_t __attribute__((ext_vector_type(2)));
__device__ __forceinline__ unsigned cvtpk(float lo, float hi) { f32x2_t v = {lo, hi}; bf16x2_t b = __builtin_convertvector(v, bf16x2_t); return __builtin_bit_cast(unsigned, b); }
typedef short v4i16_t __attribute__((ext_vector_type(4)));
__device__ __forceinline__ s16x4_t vtr(LAS const unsigned char* p) { return __builtin_bit_cast(s16x4_t, __builtin_amdgcn_ds_read_tr16_b64_v4i16((LAS v4i16_t*)p)); }
#define LDSW() asm volatile("s_waitcnt lgkmcnt(0)" ::: "memory")

template <int MODE>
__device__ __forceinline__ void attn_unit(int b, int h, int qb, const bf16_t* __restrict__ proj, bf16_t* __restrict__ Obuf, const float* __restrict__ kmean,
                                          float lam, float lam_init, const float* __restrict__ subg, const float* sinkp, int dlim, LAS unsigned char* lds) {
    constexpr int NMAP = (MODE == 0) ? 2 : 1;
    int tid_ = threadIdx.x; asm volatile("" : "+v"(tid_));
    const int tid = tid_, lane = tid & 63, r32 = lane & 31, hi = lane >> 5;
    const int wid = __builtin_amdgcn_readfirstlane(tid >> 6);
    const int q0 = qb * 256;
    int qcol, kcol, vcol, ocol; float slope;
    if (MODE == 0) { qcol = OFF_QA + h * 64; kcol = OFF_KA + h * 64; vcol = OFF_VA + h * 64; ocol = h * 64; slope = alibi_slope(6 + h); }
    else if (MODE == 1) { qcol = OFF_QB + h * 64; kcol = OFF_KB + h * 64; vcol = OFF_VB + h * 64; ocol = 256 + h * 64; slope = alibi_slope(10 + h); }
    else { qcol = OFF_QC + h * 64; kcol = OFF_KC + (h / 3) * 64; vcol = OFF_VC + (h / 3) * 64; ocol = 640 + h * 64; slope = alibi_slope(h); }
    const float slope2 = slope * LOG2E;
    const float cscale = (MODE == 0 ? 0.17677669529663687f : 0.125f) * LOG2E;
    const bf16_t* base = proj + (size_t)b * SEQ * INW;
    const int t_hi = 4 * qb + 4, t_lo = (MODE == 2) ? (qb > 0 ? 4 * qb - 2 : 0) : ((MODE == 0 && q0 > dlim) ? (q0 - dlim) / 64 : 0);
    const bf16_t* ksrc = base + kcol + (size_t)lane * INW + wid * 8;
    const bf16_t* vsrc = base + vcol + (size_t)(16 * (wid & 3) + (lane >> 2)) * INW + (wid >> 2) * 32 + (lane & 3) * 8;
#define DMA_TILE(t, bufi) do { dma16(ksrc + (size_t)(t) * 64 * INW, lds + A_K + (bufi) * 8192 + wid * 1024); dma16(vsrc + (size_t)(t) * 64 * INW, lds + A_V + (bufi) * 8192 + wid * 1024); } while (0)
    DMA_TILE(t_lo, 0);
    const bf16_t* Qw = base + (size_t)(q0 + wid * 32 + r32) * INW + qcol;
    bf16x8_t qr[4];
#pragma unroll
    for (int d0 = 0; d0 < 4; ++d0) qr[d0] = *(const bf16x8_t*)(Qw + d0 * 16 + hi * 8);
    const int qrel = wid * 32 + r32;
    const LAS unsigned char* qlds = lds + A_STG + wid * STG_WAVE_BYTES + lane * 16;
    if (MODE == 0) {
#pragma unroll
        for (int d0 = 0; d0 < 4; ++d0) *(LAS bf16x8_t*)(lds + A_STG + wid * STG_WAVE_BYTES + lane * 16 + d0 * 1024) = qr[d0];
    }
    unsigned rowmask = 0u;
    if (MODE == 1) {
        LAS float* km = (LAS float*)(lds + A_KM);
        const float* kmg = kmean + (size_t)((b * 6 + h) * 32) * 64;
        for (int i = tid; i < 2048; i += NTHREADS) km[i] = kmg[i] * (1.0f / 256.0f);
        __syncthreads();
        if (qb > 0) {
            float qf[32];
#pragma unroll
            for (int d0 = 0; d0 < 4; ++d0)
#pragma unroll
                for (int j = 0; j < 8; ++j) qf[d0 * 8 + j] = __builtin_bit_cast(float, ((unsigned)(unsigned short)qr[d0][j]) << 16);
            float v0 = -INFINITY, v1 = -INFINITY, v2 = -INFINITY; int i0 = 0, i1 = 0, i2 = 0;
            for (int n = 0; n < qb; ++n) {
                const LAS float* kp = km + n * 64 + 8 * hi;
                float part = 0.f;
#pragma unroll
                for (int d0 = 0; d0 < 4; ++d0) {
                    const f32x4_t a = *(const LAS f32x4_t*)(kp + d0 * 16), c = *(const LAS f32x4_t*)(kp + d0 * 16 + 4);
                    part += qf[d0 * 8 + 0] * a[0]; part += qf[d0 * 8 + 1] * a[1]; part += qf[d0 * 8 + 2] * a[2]; part += qf[d0 * 8 + 3] * a[3];
                    part += qf[d0 * 8 + 4] * c[0]; part += qf[d0 * 8 + 5] * c[1]; part += qf[d0 * 8 + 6] * c[2]; part += qf[d0 * 8 + 7] * c[3];
                }
                const float tot = part + swap32_partner(part, hi);
                if (tot > v0) { v2 = v1; i2 = i1; v1 = v0; i1 = i0; v0 = tot; i0 = n; }
                else if (tot > v1) { v2 = v1; i2 = i1; v1 = tot; i1 = n; }
                else if (tot > v2) { v2 = tot; i2 = n; }
            }
            if (v0 > -INFINITY) rowmask |= 1u << i0;
            if (v1 > -INFINITY) rowmask |= 1u << i1;
            if (v2 > -INFINITY) rowmask |= 1u << i2;
        }
    }
    float m_[NMAP], l_[NMAP]; f32x16_t o[NMAP][2];
#pragma unroll
    for (int mi = 0; mi < NMAP; ++mi) { m_[mi] = -INFINITY; l_[mi] = 0.f;
#pragma unroll
        for (int d0 = 0; d0 < 2; ++d0)
#pragma unroll
            for (int r = 0; r < 16; ++r) o[mi][d0][r] = 0.f; }
    LAS float* wsf = (LAS float*)(lds + A_WSF) + wid * 64;
    const int vlane = ((lane >> 4) & 1) * 32 + (lane & 3) * 8 + (4 * hi + ((lane & 15) >> 2)) * 64;

    for (int t = t_lo; t < t_hi; ++t) {
        const int bufi = (t - t_lo) & 1;
        asm volatile("s_waitcnt vmcnt(0)" ::: "memory");
        __syncthreads();
        if (t + 1 < t_hi) DMA_TILE(t + 1, bufi ^ 1);
        const int krel0 = 64 * t - q0;
        bool need = krel0 <= wid * 32 + 31;
        if (MODE == 2) need = need && (krel0 + 63 >= wid * 32 - 127);
        const bool past = (MODE == 1) && ((t >> 2) < qb);
        if (past) need = __any((int)((rowmask >> (t >> 2)) & 1u)) != 0;
        if (!need) continue;
        const bool diag = krel0 + 63 > wid * 32;
        const int kb = krel0 + 4 * hi;
        const LAS unsigned char* Ks = lds + A_K + bufi * 8192 + hi * 1024 + r32 * 16;
        const LAS unsigned char* Vs = lds + A_V + bufi * 8192 + vlane;
#pragma unroll
        for (int mi = 0; mi < NMAP; ++mi) {
            f32x16_t p0, p1;
#pragma unroll
            for (int r = 0; r < 16; ++r) { p0[r] = 0.f; p1[r] = 0.f; }
            constexpr int ND0 = (MODE == 0) ? 2 : 4;
#pragma unroll
            for (int dd = 0; dd < ND0; ++dd) {
                const int d0 = (MODE == 0) ? (2 * mi + dd) : dd;
                const bf16x8_t b0 = *(const LAS bf16x8_t*)(Ks + d0 * 2048);
                const bf16x8_t b1 = *(const LAS bf16x8_t*)(Ks + d0 * 2048 + 512);
                const bf16x8_t qa = (MODE == 0) ? *(const LAS bf16x8_t*)(qlds + d0 * 1024) : qr[d0];
                p0 = __builtin_amdgcn_mfma_f32_32x32x16_bf16(b0, qa, p0, 0, 0, 0);
                p1 = __builtin_amdgcn_mfma_f32_32x32x16_bf16(b1, qa, p1, 0, 0, 0);
            }
            float sl2 = slope2; asm volatile("" : "+v"(sl2));
            const float tb = sl2 * (float)kb;
#pragma unroll
            for (int r = 0; r < 16; ++r) { const int kk = (r & 3) + 8 * (r >> 2); const float bias = tb + sl2 * (float)kk;
                p0[r] = p0[r] * cscale + bias; p1[r] = p1[r] * cscale + (bias + sl2 * 32.0f); }
            if (diag) {
#pragma unroll
                for (int r = 0; r < 16; ++r) { const int kk = kb + (r & 3) + 8 * (r >> 2); if (kk > qrel) p0[r] = -INFINITY; if (kk + 32 > qrel) p1[r] = -INFINITY; }
            }
            if (MODE == 2) {
#pragma unroll
                for (int r = 0; r < 16; ++r) { const int kk = kb + (r & 3) + 8 * (r >> 2); if (qrel - kk >= 128) p0[r] = -INFINITY; if (qrel - (kk + 32) >= 128) p1[r] = -INFINITY; }
            }
            if (past) { if (!((rowmask >> (t >> 2)) & 1u)) {
#pragma unroll
                for (int r = 0; r < 16; ++r) { p0[r] = -INFINITY; p1[r] = -INFINITY; } } }
            float mx = fmaxf(p0[0], p1[0]);
#pragma unroll
            for (int r = 1; r < 16; ++r) mx = fmaxf(mx, fmaxf(p0[r], p1[r]));
            mx = fmaxf(mx, __shfl_xor(mx, 32));
            const float mnew = fmaxf(m_[mi], mx), msafe = (mnew == -INFINITY) ? 0.f : mnew;
            const float f = __builtin_amdgcn_exp2f(m_[mi] - msafe);
            float ps = 0.f;
#pragma unroll
            for (int r = 0; r < 16; ++r) { p0[r] = __builtin_amdgcn_exp2f(p0[r] - msafe); p1[r] = __builtin_amdgcn_exp2f(p1[r] - msafe); ps += p0[r] + p1[r]; }
            l_[mi] = l_[mi] * f + ps; m_[mi] = mnew;
            if (__any(f != 1.0f)) {
                if (hi == 0) wsf[mi * 32 + r32] = f;
                LDSW();
#pragma unroll
                for (int r = 0; r < 16; ++r) { const float fr_ = wsf[mi * 32 + crow(r, hi)]; o[mi][0][r] *= fr_; o[mi][1][r] *= fr_; }
            }
            u32x4_t pw[4];
#pragma unroll
            for (int j = 0; j < 4; ++j) { pw[0][j] = cvtpk(p0[2 * j], p0[2 * j + 1]); pw[1][j] = cvtpk(p0[8 + 2 * j], p0[8 + 2 * j + 1]);
                                          pw[2][j] = cvtpk(p1[2 * j], p1[2 * j + 1]); pw[3][j] = cvtpk(p1[8 + 2 * j], p1[8 + 2 * j + 1]); }
#pragma unroll
            for (int d0 = 0; d0 < 2; ++d0) {
                if (d0) __builtin_amdgcn_sched_barrier(0);
#pragma unroll
                for (int ks = 0; ks < 4; ++ks) {
                    const s16x4_t lo = vtr(Vs + d0 * 4096 + ks * 1024), hh = vtr(Vs + d0 * 4096 + ks * 1024 + 512);
                    const bf16x8_t vf = {lo[0], lo[1], lo[2], lo[3], hh[0], hh[1], hh[2], hh[3]};
                    o[mi][d0] = __builtin_amdgcn_mfma_f32_32x32x16_bf16(__builtin_bit_cast(bf16x8_t, pw[ks]), vf, o[mi][d0], 0, 0, 0);
                }
            }
            if (NMAP > 1) __builtin_amdgcn_sched_barrier(0);
        }
    }
#undef DMA_TILE
    float rl[NMAP][16];
#pragma unroll
    for (int mi = 0; mi < NMAP; ++mi) {
        float lt = l_[mi];
        lt += __shfl_xor(lt, 32);
        if (MODE == 2) { float l2e = LOG2E, s2e = slope2; asm volatile("" : "+v"(l2e), "+v"(s2e));
            lt += __builtin_amdgcn_exp2f(sinkp[0] * l2e + s2e * (float)qrel - m_[mi]); }
        if (hi == 0) wsf[mi * 32 + r32] = 1.0f / lt;
    }
    LDSW();
#pragma unroll
    for (int mi = 0; mi < NMAP; ++mi)
#pragma unroll
        for (int r = 0; r < 16; ++r) rl[mi][r] = wsf[mi * 32 + crow(r, hi)];
    LAS float* stg = (LAS float*)(lds + A_STG + wid * STG_WAVE_BYTES);
#pragma unroll
    for (int d0 = 0; d0 < 2; ++d0)
#pragma unroll
        for (int r = 0; r < 16; ++r) {
            float v = o[0][d0][r] * rl[0][r];
            if (MODE == 0) v -= lam * (o[NMAP - 1][d0][r] * rl[NMAP - 1][r]);
            stg[crow(r, hi) * STG_STRIDE + d0 * 32 + r32] = v;
        }
    LDSW();
    {
        const int row = lane >> 1, half = lane & 1;
        float v[32];
#pragma unroll
        for (int i = 0; i < 8; ++i) { const f32x4_t x = *(const LAS f32x4_t*)(stg + row * STG_STRIDE + half * 32 + i * 4); v[4 * i] = x[0]; v[4 * i + 1] = x[1]; v[4 * i + 2] = x[2]; v[4 * i + 3] = x[3]; }
        if (MODE == 0) {
            float ss = 0.f;
#pragma unroll
            for (int i = 0; i < 32; ++i) ss += v[i] * v[i];
            ss += __shfl_xor(ss, 1);
            const float rs = (1.0f / sqrtf(ss * (1.0f / 64.0f) + EPS)) * (1.0f - lam_init);
#pragma unroll
            for (int i = 0; i < 32; ++i) v[i] = v[i] * rs * subg[half * 32 + i];
        }
        bf16_t* op = Obuf + (size_t)(b * SEQ + q0 + wid * 32 + row) * DM + ocol + half * 32;
#pragma unroll
        for (int i = 0; i < 4; ++i) { u32x4_t w; w.x = cvtpk(v[8 * i], v[8 * i + 1]); w.y = cvtpk(v[8 * i + 2], v[8 * i + 3]); w.z = cvtpk(v[8 * i + 4], v[8 * i + 5]); w.w = cvtpk(v[8 * i + 6], v[8 * i + 7]);
            *(u32x4_t*)(op + 8 * i) = w; }
    }
    __syncthreads();
}
#undef LDSW
}

namespace att {
#define LDSW() asm volatile("s_waitcnt lgkmcnt(0)" ::: "memory")
__device__ __forceinline__ void gate_unit(int b, int h, int qb, const bf16_t* __restrict__ proj, const float* __restrict__ kmean, unsigned* __restrict__ RM, LAS unsigned char* lds) {
    int tid_ = threadIdx.x; asm volatile("" : "+v"(tid_));
    const int tid = tid_, lane = tid & 63, r32 = lane & 31, hi = lane >> 5;
    const int wid = __builtin_amdgcn_readfirstlane(tid >> 6);
    const int q0 = qb * 256;
    LAS float* km = (LAS float*)lds;
    const float* kmg = kmean + (size_t)((b * 6 + h) * 32) * 64;
    for (int i = tid; i < 2048; i += NTHREADS) km[i] = kmg[i] * (1.0f / 256.0f);
    __syncthreads();
    const bf16_t* Qw = proj + ((size_t)b * SEQ + q0 + wid * 32 + r32) * INW + OFF_QB + h * 64;
    float qf[32];
#pragma unroll
    for (int d0 = 0; d0 < 4; ++d0) { const bf16x8_t q = *(const bf16x8_t*)(Qw + d0 * 16 + hi * 8);
#pragma unroll
        for (int j = 0; j < 8; ++j) qf[d0 * 8 + j] = __builtin_bit_cast(float, ((unsigned)(unsigned short)q[j]) << 16); }
    float v0 = -INFINITY, v1 = -INFINITY, v2 = -INFINITY; int i0 = 0, i1 = 0, i2 = 0;
    for (int n = 0; n < qb; ++n) {
        const LAS float* kp = km + n * 64 + 8 * hi;
        float part = 0.f;
#pragma unroll
        for (int d0 = 0; d0 < 4; ++d0) {
            const f32x4_t a = *(const LAS f32x4_t*)(kp + d0 * 16), c = *(const LAS f32x4_t*)(kp + d0 * 16 + 4);
            part += qf[d0 * 8 + 0] * a[0]; part += qf[d0 * 8 + 1] * a[1]; part += qf[d0 * 8 + 2] * a[2]; part += qf[d0 * 8 + 3] * a[3];
            part += qf[d0 * 8 + 4] * c[0]; part += qf[d0 * 8 + 5] * c[1]; part += qf[d0 * 8 + 6] * c[2]; part += qf[d0 * 8 + 7] * c[3];
        }
        const float tot = part + __shfl_xor(part, 32);
        if (tot > v0) { v2 = v1; i2 = i1; v1 = v0; i1 = i0; v0 = tot; i0 = n; }
        else if (tot > v1) { v2 = v1; i2 = i1; v1 = tot; i1 = n; }
        else if (tot > v2) { v2 = tot; i2 = n; }
    }
    unsigned rowmask = 0u;
    if (v0 > -INFINITY) rowmask |= 1u << i0;
    if (v1 > -INFINITY) rowmask |= 1u << i1;
    if (v2 > -INFINITY) rowmask |= 1u << i2;
    if (hi == 0) RM[(size_t)(b * 6 + h) * SEQ + q0 + wid * 32 + r32] = rowmask;
    __syncthreads();
}

constexpr int B_K = 0, B_V = 32768, B_LIST = 65536, B_WSF = 81920, B_CNT = 83968, B_STG = 84032, B_STG_ROW = 72  , B_STG_WAVE = 32 * B_STG_ROW * 2;
__device__ __forceinline__ void moba_unit(int b, int h, int n, const bf16_t* __restrict__ proj, const unsigned* __restrict__ RM, bf16_t* __restrict__ Pbuf, float* __restrict__ ML, LAS unsigned char* lds) {
    int tid_ = threadIdx.x; asm volatile("" : "+v"(tid_));
    const int tid = tid_, lane = tid & 63, r32 = lane & 31, hi = lane >> 5;
    const int wid = __builtin_amdgcn_readfirstlane(tid >> 6);
    const float slope2 = alibi_slope(10 + h) * LOG2E, cscale = 0.125f * LOG2E;
    const bf16_t* base = proj + (size_t)b * SEQ * INW;
    {
        const bf16_t* ksrc = base + OFF_KB + h * 64 + (size_t)(256 * n + lane) * INW + wid * 8;
        const bf16_t* vsrc = base + OFF_VB + h * 64 + (size_t)(256 * n + 16 * (wid & 3) + (lane >> 2)) * INW + (wid >> 2) * 32 + (lane & 3) * 8;
#pragma unroll
        for (int tt = 0; tt < 4; ++tt) { dma16(ksrc + (size_t)tt * 64 * INW, lds + B_K + tt * 8192 + wid * 1024); dma16(vsrc + (size_t)tt * 64 * INW, lds + B_V + tt * 8192 + wid * 1024); }
    }
    volatile LAS int* cntp = (volatile LAS int*)(lds + B_CNT);
    LAS unsigned short* list = (LAS unsigned short*)(lds + B_LIST);
    if (tid == 0) cntp[0] = 0;
    __syncthreads();
    const unsigned* rm = RM + (size_t)(b * 6 + h) * SEQ;
    for (int s0 = 256 * (n + 1); s0 < SEQ; s0 += NTHREADS) {
        const int s = s0 + tid;
        const bool sel = (s < SEQ) && ((rm[s < SEQ ? s : 0] >> n) & 1u);
        const unsigned long long bal = __ballot(sel);
        if (bal) {
            const int total = __popcll(bal), prefix = __builtin_amdgcn_mbcnt_hi((unsigned)(bal >> 32), __builtin_amdgcn_mbcnt_lo((unsigned)bal, 0u));
            int wb = 0;
            if (lane == 0) wb = __hip_atomic_fetch_add((LAS int*)(lds + B_CNT), total, __ATOMIC_RELAXED, __HIP_MEMORY_SCOPE_WORKGROUP);
            wb = __builtin_amdgcn_readfirstlane(wb);
            if (sel) list[wb + prefix] = (unsigned short)s;
        }
    }
    asm volatile("s_waitcnt vmcnt(0)" ::: "memory");
    __syncthreads();
    const int C = cntp[0], NG = (C + 31) >> 5;
    LAS float* wsf = (LAS float*)(lds + B_WSF) + wid * 64;
    LAS unsigned short* stg = (LAS unsigned short*)(lds + B_STG + wid * B_STG_WAVE);
    const int vlane = ((lane >> 4) & 1) * 32 + (lane & 3) * 8 + (4 * hi + ((lane & 15) >> 2)) * 64;
    for (int item = wid; item < 8 + NG; item += 8) {
        const bool own = item < 8;
        int li = own ? 0 : 32 * (item - 8) + r32;
        const bool valid = own || (li < C);
        if (li >= C) li = C - 1;
        const int qidx = own ? (256 * n + 32 * item + r32) : (int)list[own ? 0 : li];
        const unsigned qmask = rm[qidx];
        const int slot = own ? 3 : __popc(qmask & ((1u << n) - 1u));
        const bf16_t* Qw = base + (size_t)qidx * INW + OFF_QB + h * 64;
        bf16x8_t qr[4];
#pragma unroll
        for (int d0 = 0; d0 < 4; ++d0) qr[d0] = *(const bf16x8_t*)(Qw + d0 * 16 + hi * 8);
        const int qrel = 32 * item + r32;
        float m_ = -INFINITY, l_ = 0.f; f32x16_t o[2];
#pragma unroll
        for (int d0 = 0; d0 < 2; ++d0)
#pragma unroll
            for (int r = 0; r < 16; ++r) o[d0][r] = 0.f;
        const int ntile = own ? ((32 * item + 31) / 64 + 1) : 4;
        for (int tt = 0; tt < ntile; ++tt) {
            const LAS unsigned char* Ks = lds + B_K + tt * 8192 + hi * 1024 + r32 * 16;
            const LAS unsigned char* Vs = lds + B_V + tt * 8192 + vlane;
            f32x16_t p0, p1;
#pragma unroll
            for (int r = 0; r < 16; ++r) { p0[r] = 0.f; p1[r] = 0.f; }
#pragma unroll
            for (int d0 = 0; d0 < 4; ++d0) {
                const bf16x8_t b0 = *(const LAS bf16x8_t*)(Ks + d0 * 2048);
                const bf16x8_t b1 = *(const LAS bf16x8_t*)(Ks + d0 * 2048 + 512);
                p0 = __builtin_amdgcn_mfma_f32_32x32x16_bf16(b0, qr[d0], p0, 0, 0, 0);
                p1 = __builtin_amdgcn_mfma_f32_32x32x16_bf16(b1, qr[d0], p1, 0, 0, 0);
            }
            float sl2 = slope2; asm volatile("" : "+v"(sl2));
            const int kb = 64 * tt + 4 * hi;
            const float tb = sl2 * (float)kb;
#pragma unroll
            for (int r = 0; r < 16; ++r) { const int kk = (r & 3) + 8 * (r >> 2); const float bias = tb + sl2 * (float)kk;
                p0[r] = p0[r] * cscale + bias; p1[r] = p1[r] * cscale + (bias + sl2 * 32.0f); }
            if (own && (64 * tt + 63 > 32 * item)) {
#pragma unroll
                for (int r = 0; r < 16; ++r) { const int kk = kb + (r & 3) + 8 * (r >> 2); if (kk > qrel) p0[r] = -INFINITY; if (kk + 32 > qrel) p1[r] = -INFINITY; }
            }
            float mx = fmaxf(p0[0], p1[0]);
#pragma unroll
            for (int r = 1; r < 16; ++r) mx = fmaxf(mx, fmaxf(p0[r], p1[r]));
            mx = fmaxf(mx, __shfl_xor(mx, 32));
            const float mnew = fmaxf(m_, mx), msafe = (mnew == -INFINITY) ? 0.f : mnew;
            const float f = __builtin_amdgcn_exp2f(m_ - msafe);
            float ps = 0.f;
#pragma unroll
            for (int r = 0; r < 16; ++r) { p0[r] = __builtin_amdgcn_exp2f(p0[r] - msafe); p1[r] = __builtin_amdgcn_exp2f(p1[r] - msafe); ps += p0[r] + p1[r]; }
            l_ = l_ * f + ps; m_ = mnew;
            if (__any(f != 1.0f)) {
                if (hi == 0) wsf[r32] = f;
                LDSW();
#pragma unroll
                for (int r = 0; r < 16; ++r) { const float fr_ = wsf[crow(r, hi)]; o[0][r] *= fr_; o[1][r] *= fr_; }
            }
            u32x4_t pw[4];
#pragma unroll
            for (int j = 0; j < 4; ++j) { pw[0][j] = cvtpk(p0[2 * j], p0[2 * j + 1]); pw[1][j] = cvtpk(p0[8 + 2 * j], p0[8 + 2 * j + 1]);
                                          pw[2][j] = cvtpk(p1[2 * j], p1[2 * j + 1]); pw[3][j] = cvtpk(p1[8 + 2 * j], p1[8 + 2 * j + 1]); }
#pragma unroll
            for (int d0 = 0; d0 < 2; ++d0)
#pragma unroll
                for (int ks = 0; ks < 4; ++ks) {
                    const s16x4_t lo = vtr(Vs + d0 * 4096 + ks * 1024), hh = vtr(Vs + d0 * 4096 + ks * 1024 + 512);
                    const bf16x8_t vf = {lo[0], lo[1], lo[2], lo[3], hh[0], hh[1], hh[2], hh[3]};
                    o[d0] = __builtin_amdgcn_mfma_f32_32x32x16_bf16(__builtin_bit_cast(bf16x8_t, pw[ks]), vf, o[d0], 0, 0, 0);
                }
        }
        float lt = l_ + __shfl_xor(l_, 32);
        if (hi == 0) wsf[r32] = 1.0f / lt;
        LDSW();
#pragma unroll
        for (int d0 = 0; d0 < 2; ++d0)
#pragma unroll
            for (int r = 0; r < 16; ++r) stg[crow(r, hi) * B_STG_ROW + d0 * 32 + r32] = (unsigned short)f2bf(o[d0][r] * wsf[crow(r, hi)]);
        const size_t pidx = (((size_t)b * SEQ + qidx) * 6 + h) * 4 + slot;
        if (hi == 0 && valid) { float2 mlv; mlv.x = m_ + slope2 * (float)(256 * n - qidx); mlv.y = lt; *(float2*)(ML + pidx * 2) = mlv; }
        LDSW();
        {
            const int row = lane >> 1, half = lane & 1;
            const int pk_own = valid ? (qidx | (slot << 16)) : -1;
            const int pk = __shfl(pk_own, row);
            if (pk >= 0) {
                bf16_t* dst = Pbuf + ((((size_t)b * SEQ + (pk & 0xffff)) * 6 + h) * 4 + (pk >> 16)) * 64 + half * 32;
#pragma unroll
                for (int i = 0; i < 4; ++i) *(u32x4_t*)(dst + 8 * i) = *(const LAS u32x4_t*)((const LAS unsigned char*)stg + row * (B_STG_ROW * 2) + half * 64 + i * 16);
            }
        }
        LDSW();
    }
    __syncthreads();
}

__device__ __forceinline__ void moba_combine(const bf16_t* __restrict__ Pbuf, const float* __restrict__ ML, bf16_t* __restrict__ Obuf, size_t gtid, size_t gth) {
    for (size_t idx = gtid; idx < (size_t)TOK * 48; idx += gth) {
        const int t = (int)(idx / 48), r = (int)(idx % 48), h = r >> 3, c = r & 7;
        const int qb = (t & (SEQ - 1)) >> 8, ns = qb < 3 ? qb : 3;
        const size_t pb = ((size_t)t * 6 + h) * 4;
        float m[4], l[4];
        { const float2 v = *(const float2*)(ML + (pb + 3) * 2); m[3] = v.x; l[3] = v.y; }
        float M = m[3];
#pragma unroll
        for (int i = 0; i < 3; ++i) { if (i < ns) { const float2 v = *(const float2*)(ML + (pb + i) * 2); m[i] = v.x; l[i] = v.y; M = fmaxf(M, m[i]); } else { m[i] = -INFINITY; l[i] = 0.f; } }
        float acc[8]; float wsum = 0.f;
#pragma unroll
        for (int j = 0; j < 8; ++j) acc[j] = 0.f;
#pragma unroll
        for (int i = 0; i < 4; ++i) {
            if (i == 3 || i < ns) {
                const float w = l[i] * __builtin_amdgcn_exp2f(m[i] - M); wsum += w;
                const u32x4_t v = *(const u32x4_t*)(Pbuf + (pb + i) * 64 + c * 8);
#pragma unroll
                for (int j = 0; j < 4; ++j) { acc[2 * j] += w * bf_lo(v[j]); acc[2 * j + 1] += w * bf_hi(v[j]); }
            }
        }
        const float inv = 1.0f / wsum;
        u32x4_t o; o.x = pk2(acc[0] * inv, acc[1] * inv); o.y = pk2(acc[2] * inv, acc[3] * inv); o.z = pk2(acc[4] * inv, acc[5] * inv); o.w = pk2(acc[6] * inv, acc[7] * inv);
        *(u32x4_t*)(Obuf + (size_t)t * DM + 256 + h * 64 + c * 8) = o;
    }
}

__device__ __forceinline__ void qknorm_unit(int b, int h, int chunk, const bf16_t* __restrict__ proj, unsigned* __restrict__ words  , int tid) {
    float mq = 0.f, mk = 0.f;
    for (int rr = tid; rr < 2048; rr += NTHREADS) {
        const int row = chunk * 1024 + (rr >> 1), mp = rr & 1;
        const bf16_t* p = proj + ((size_t)b * SEQ + row) * INW + h * 64 + mp * 32;
        float sq = 0.f, sk = 0.f;
#pragma unroll
        for (int j = 0; j < 4; ++j) { const u32x4_t a = *(const u32x4_t*)(p + OFF_QA + 8 * j), c = *(const u32x4_t*)(p + OFF_KA + 8 * j);
#pragma unroll
            for (int e = 0; e < 4; ++e) { const float a0 = bf_lo(a[e]), a1 = bf_hi(a[e]), c0 = bf_lo(c[e]), c1 = bf_hi(c[e]); sq += a0 * a0 + a1 * a1; sk += c0 * c0 + c1 * c1; } }
        mq = fmaxf(mq, sq); mk = fmaxf(mk, sk);
    }
#pragma unroll
    for (int o = 1; o < 64; o <<= 1) { mq = fmaxf(mq, __shfl_xor(mq, o)); mk = fmaxf(mk, __shfl_xor(mk, o)); }
    if ((tid & 63) == 0) { atomicMax(words + 0, __builtin_bit_cast(unsigned, mq)); atomicMax(words + 1, __builtin_bit_cast(unsigned, mk)); }
}
#undef LDSW
}

namespace peer {
constexpr int K_BYTES = 2 * 32768;
__device__ __forceinline__ int crow(int r, int hi) { return (r & 3) + 8 * (r >> 2) + 4 * hi; }

__device__ __forceinline__ float vmaxf_(float a, float b) { float r; asm("v_max_f32 %0, %1, %2" : "=v"(r) : "v"(a), "v"(b)); return r; }
__device__ __forceinline__ float vminf_(float a, float b) { float r; asm("v_min_f32 %0, %1, %2" : "=v"(r) : "v"(a), "v"(b)); return r; }
#define CSW_(a, b) { const float hi_ = vmaxf_(a, b), lo_ = vminf_(a, b); a = hi_; b = lo_; }
template <int N> __device__ __forceinline__ void bitonic_merge_desc(float (&v)[N]) {
#pragma unroll
    for (int j = N / 2; j > 0; j >>= 1)
#pragma unroll
        for (int i = 0; i < N; ++i) { const int l = i ^ j; if (l > i) CSW_(v[i], v[l]); }
}
template <int N> __device__ __forceinline__ void sort_desc(float (&v)[N]) {
#pragma unroll
    for (int k = 2; k <= N; k <<= 1)
#pragma unroll
        for (int j = k >> 1; j > 0; j >>= 1)
#pragma unroll
            for (int i = 0; i < N; ++i) { const int l = i ^ j; if (l > i) { if ((i & k) == 0) CSW_(v[i], v[l]) else CSW_(v[l], v[i]) } }
}
__device__ __forceinline__ void merge_top16(float (&a)[16], const float (&b)[16]) {
#pragma unroll
    for (int i = 0; i < 16; ++i) a[i] = vmaxf_(a[i], b[15 - i]);
    bitonic_merge_desc<16>(a);
}
__device__ __forceinline__ void top16_of_pair64(const float (&s)[64], float (&out)[16]) {
    float g0[16], g1[16], g2[16], g3[16];
#pragma unroll
    for (int i = 0; i < 16; ++i) { g0[i] = s[i]; g1[i] = s[16 + i]; g2[i] = s[32 + i]; g3[i] = s[48 + i]; }
    sort_desc<16>(g0); sort_desc<16>(g1); sort_desc<16>(g2); sort_desc<16>(g3);
    merge_top16(g0, g1); merge_top16(g2, g3); merge_top16(g0, g2);
    float pb[16];
#pragma unroll
    for (int i = 0; i < 16; ++i) pb[i] = __shfl_xor(g0[i], 32);
    merge_top16(g0, pb);
#pragma unroll
    for (int i = 0; i < 16; ++i) out[i] = g0[i];
}
template <int N>
__device__ __forceinline__ void top16_pair(float (&s)[N], float (&out)[16], bool pair) {
#pragma unroll
    for (int it = 0; it < 16; ++it) {
        float mx = s[0];
#pragma unroll
        for (int i = 1; i < N; ++i) mx = fmaxf(mx, s[i]);
        if (pair) mx = fmaxf(mx, __shfl_xor(mx, 32));
        out[it] = mx;
#pragma unroll
        for (int i = 0; i < N; ++i) s[i] = (s[i] == mx) ? -INFINITY : s[i];
    }
}
__device__ __forceinline__ float pack_idx(float v, unsigned idx, unsigned mask) { return __builtin_bit_cast(float, (__builtin_bit_cast(unsigned, v) & ~mask) | idx); }
__device__ __forceinline__ unsigned byte16(unsigned t0, unsigned t1, unsigned t2, unsigned t3, unsigned i) {
    const unsigned s = i & 7u, a = __builtin_amdgcn_perm(t1, t0, s), b = __builtin_amdgcn_perm(t3, t2, s);
    return ((i & 8u) ? b : a) & 0xffu;
}

__device__ __forceinline__ void pk_unit(int tile, int h, const bf16_t* __restrict__ Q, const bf16_t* __restrict__ keysb, int* __restrict__ Eid, float* __restrict__ Ga, float* __restrict__ Gb, float* __restrict__ Gc, const float* __restrict__ Us, const float* __restrict__ Urs, const float* __restrict__ Vs, LAS unsigned char* lds) {
    int tid_ = threadIdx.x; asm volatile("" : "+v"(tid_));
    const int tid = tid_, lane = tid & 63, r32 = lane & 31, hi = lane >> 5;
    const int wid = __builtin_amdgcn_readfirstlane(tid >> 6);
    __syncthreads();
    {
        const bf16_t* kg = keysb + (size_t)h * 2 * 128 * 128;
        for (int i = tid; i < 2 * 128 * 16; i += NTHREADS) {
            const int n = i & 127, c = (i >> 7) & 15, p = i >> 11;
            const u32x4_t v = *(const u32x4_t*)(kg + ((size_t)(p * 128 + n)) * 128 + c * 8);
            *(LAS u32x4_t*)(lds + p * 32768 + c * 2048 + n * 16) = v;
        }
    }
    __syncthreads();
    const int tok = tile * 256 + wid * 32 + r32;
    float sv[2][16];
#pragma unroll
    for (int p = 0; p < 2; ++p) {
        const bf16_t* qp = Q + (size_t)tok * PQW + h * 256 + p * 128 + hi * 8;
        bf16x8_t qf[8];
#pragma unroll
        for (int ks = 0; ks < 8; ++ks) qf[ks] = *(const bf16x8_t*)(qp + ks * 16);
        float s[64];
#pragma unroll
        for (int blk = 0; blk < 4; ++blk) {
            f32x16_t acc;
#pragma unroll
            for (int r = 0; r < 16; ++r) acc[r] = 0.f;
#pragma unroll
            for (int ks = 0; ks < 8; ++ks) {
                const bf16x8_t kf = *(const LAS bf16x8_t*)(lds + p * 32768 + (2 * ks + hi) * 2048 + (blk * 32 + r32) * 16);
                acc = __builtin_amdgcn_mfma_f32_32x32x16_bf16(kf, qf[ks], acc, 0, 0, 0);
            }
#pragma unroll
            for (int r = 0; r < 16; ++r) s[blk * 16 + r] = pack_idx(acc[r], (unsigned)(blk * 32 + (r & 3) + 8 * (r >> 2) + 4 * hi), 127u);
        }
        top16_of_pair64(s, sv[p]);
    }
#define CAND(i, j) pack_idx(sv[0][i] + sv[1][j], (unsigned)((i) * 16 + (j)), 255u)
    float top[16], gB[16], gC[16], gD[16];
#pragma unroll
    for (int j = 0; j < 16; ++j) top[j] = CAND(0, j);
#pragma unroll
    for (int j = 0; j < 8; ++j) { gB[j] = CAND(1, j); gB[8 + j] = CAND(15 - j, 0); }
    bitonic_merge_desc<16>(gB);
    gC[0] = CAND(2, 0); gC[1] = CAND(2, 1); gC[2] = CAND(2, 2); gC[3] = CAND(2, 3); gC[4] = CAND(2, 4); gC[5] = CAND(3, 0); gC[6] = CAND(3, 1); gC[7] = CAND(3, 2); gC[8] = CAND(3, 3);
    gC[9] = CAND(4, 0); gC[10] = CAND(4, 1); gC[11] = CAND(4, 2); gC[12] = CAND(5, 0); gC[13] = CAND(5, 1); gC[14] = CAND(6, 0); gC[15] = CAND(6, 1);
    sort_desc<16>(gC);
    gD[0] = CAND(7, 0); gD[1] = CAND(7, 1);
#pragma unroll
    for (int j = 2; j < 16; ++j) gD[j] = -INFINITY;
    merge_top16(top, gB); merge_top16(gC, gD); merge_top16(top, gC);
#undef CAND
    unsigned t1[4], t2[4];
#pragma unroll
    for (int j = 0; j < 4; ++j) { t1[j] = 0u; t2[j] = 0u;
#pragma unroll
        for (int k = 0; k < 4; ++k) { t1[j] |= (__builtin_bit_cast(unsigned, sv[0][4 * j + k]) & 127u) << (8 * k); t2[j] |= (__builtin_bit_cast(unsigned, sv[1][4 * j + k]) & 127u) << (8 * k); } }
    float g[16]; int e[16]; float gs = 0.f;
#pragma unroll
    for (int k = 0; k < 16; ++k) {
        const unsigned code = __builtin_bit_cast(unsigned, top[k]) & 255u;
        e[k] = (int)(byte16(t1[0], t1[1], t1[2], t1[3], code >> 4) * 128u + byte16(t2[0], t2[1], t2[2], t2[3], code & 15u));
        g[k] = __expf(top[k] - top[0]); gs += g[k];
    }
    const float gi = 1.0f / gs;
    if (hi == 0) {
        const size_t ob = ((size_t)tok * PHEADS + h) * 16;
#pragma unroll
        for (int k = 0; k < 16; k += 4) {
            *(int4*)(Eid + ob + k) = make_int4(e[k], e[k + 1], e[k + 2], e[k + 3]);
            const float s0 = Us[e[k]], s1 = Us[e[k + 1]], s2 = Us[e[k + 2]], s3 = Us[e[k + 3]];
            *(float4*)(Ga + ob + k) = make_float4(s0, s1, s2, s3);
            *(float4*)(Gc + ob + k) = make_float4(8.0f * s0 * Urs[e[k]], 8.0f * s1 * Urs[e[k + 1]], 8.0f * s2 * Urs[e[k + 2]], 8.0f * s3 * Urs[e[k + 3]]);
            *(float4*)(Gb + ob + k) = make_float4(g[k] * gi * Vs[e[k]], g[k + 1] * gi * Vs[e[k + 1]], g[k + 2] * gi * Vs[e[k + 2]], g[k + 3] * gi * Vs[e[k + 3]]);
        }
    }
}

__device__ __forceinline__ float reduce16(float (&a)[16], int lane) {
    float b8[8];
    { const bool up = lane & 1;
#pragma unroll
      for (int i = 0; i < 8; ++i) { const float keep = up ? a[8 + i] : a[i], give = up ? a[i] : a[8 + i]; b8[i] = keep + __shfl_xor(give, 1); } }
    float b4[4];
    { const bool up = lane & 2;
#pragma unroll
      for (int i = 0; i < 4; ++i) { const float keep = up ? b8[4 + i] : b8[i], give = up ? b8[i] : b8[4 + i]; b4[i] = keep + __shfl_xor(give, 2); } }
    float b2[2];
    { const bool up = lane & 4;
#pragma unroll
      for (int i = 0; i < 2; ++i) { const float keep = up ? b4[2 + i] : b4[i], give = up ? b4[i] : b4[2 + i]; b2[i] = keep + __shfl_xor(give, 4); } }
    float b1;
    { const bool up = lane & 8; const float keep = up ? b2[1] : b2[0], give = up ? b2[0] : b2[1]; b1 = keep + __shfl_xor(give, 8); }
    b1 += __shfl_xor(b1, 16); b1 += __shfl_xor(b1, 32);
    return b1;
}
__device__ __forceinline__ int red16_index(int lane) { return 8 * (lane & 1) + 4 * ((lane >> 1) & 1) + 2 * ((lane >> 2) & 1) + ((lane >> 3) & 1); }

typedef float f32x2_t __attribute__((ext_vector_type(2)));
typedef short s16x2_t __attribute__((ext_vector_type(2)));
__device__ __forceinline__ void pg_token(int tok, const float* xres, float* xdst, const LAS float* tab2  , const float* __restrict__ g2  , int gstride,
                                         const int* __restrict__ Eid, const float* __restrict__ Ga, const float* __restrict__ Gb, const float* __restrict__ Gc, const unsigned char* __restrict__ U8, const unsigned char* __restrict__ V8,
                                         bool last, const LAS float* tabn  , const float* __restrict__ final_g, bf16_t* __restrict__ Hn, float* __restrict__ outp, int lane) {
    const int b = tok >> 13;
    const float* xp = xres + (size_t)tok * DM + 16 * lane;
    float* xw = xdst + (size_t)tok * DM + 16 * lane;
    unsigned Hpk[2], Lpk[2]; float sx;
    {
        float x[16];
#pragma unroll
        for (int q = 0; q < 4; ++q) { const f32x4_t a = *(const f32x4_t*)(xp + 4 * q); x[4 * q] = a[0]; x[4 * q + 1] = a[1]; x[4 * q + 2] = a[2]; x[4 * q + 3] = a[3]; }
        float ss = 0.f;
#pragma unroll
        for (int i = 0; i < 16; ++i) ss += x[i] * x[i];
        const float rstd = 1.0f / sqrtf(wave_sum(ss) * (1.0f / DM) + EPS);
        float hh[16]; float amax = 0.f;
#pragma unroll
        for (int q = 0; q < 4; ++q) { const f32x4_t g = *(const LAS f32x4_t*)(tab2 + (b * 2 + 0) * 1024 + 16 * lane + 4 * q), s = *(const LAS f32x4_t*)(tab2 + (b * 2 + 1) * 1024 + 16 * lane + 4 * q);
#pragma unroll
            for (int i = 0; i < 4; ++i) { hh[4 * q + i] = x[4 * q + i] * rstd * g[i] + s[i]; amax = fmaxf(amax, fabsf(hh[4 * q + i])); } }
#pragma unroll
        for (int o = 1; o < 64; o <<= 1) amax = fmaxf(amax, __shfl_xor(amax, o));
        const float sxi = amax > 0.f ? 127.0f / amax : 0.f; sx = amax * (1.0f / 127.0f);
#pragma unroll
        for (int qd = 0; qd < 2; ++qd) { unsigned hp = 0u, lp = 0u;
#pragma unroll
            for (int j = 0; j < 8; ++j) { const unsigned xu = (unsigned)((int)rintf(hh[8 * qd + j] * sxi) + 128); hp |= ((xu >> 4) ^ 8u) << (4 * j); lp |= ((xu & 15u) ^ 8u) << (4 * j); }
            Hpk[qd] = hp; Lpk[qd] = lp; }
    }
    float out[16];
#pragma unroll
    for (int i = 0; i < 16; ++i) out[i] = 0.f;
    const int ridx = red16_index(lane);
    const size_t eb0 = (size_t)tok * PHEADS * 16;
    const __amdgpu_buffer_rsrc_t rUV = __builtin_amdgcn_make_buffer_rsrc((void*)U8, 0, PNEXP * DM, 0x00020000);
    const int loff = 16 * lane;
#define LOADROWS(W, EV) { _Pragma("unroll") for (int k = 0; k < 16; ++k) { const int e = __builtin_amdgcn_readlane(EV, k); W[k] = __builtin_amdgcn_raw_buffer_load_b128(rUV, loff, e * DM, 0); } }
#define HEAD_MATH(W, SU, GB, GC) { \
        float a[16]; \
        _Pragma("unroll") for (int k = 0; k < 16; ++k) { \
            int d1 = __builtin_amdgcn_sdot8((int)W[k][0], (int)Hpk[0], 0, false); d1 = __builtin_amdgcn_sdot8((int)W[k][1], (int)Hpk[1], d1, false); \
            int d2 = __builtin_amdgcn_sdot8((int)W[k][0], (int)Lpk[0], 0, false); d2 = __builtin_amdgcn_sdot8((int)W[k][1], (int)Lpk[1], d2, false); \
            a[k] = (float)(16 * d1 + d2); } \
        const float dot = sx * (SU * reduce16(a, lane) + GC);     \
        const float wgt = GB * 0.5f * dot * (1.0f + erff(dot * 0.70710678118654752f)); \
        float wmax = fabsf(wgt);                                  \
        _Pragma("unroll") for (int o = 1; o < 16; o <<= 1) wmax = fmaxf(wmax, __shfl_xor(wmax, o)); \
        const int wq = (int)rintf(wgt * (wmax > 0.f ? 127.0f / wmax : 0.f)); \
        int wsum = wq; \
        _Pragma("unroll") for (int o = 1; o < 16; o <<= 1) wsum += __shfl_xor(wsum, o); \
        const float hs = wmax * (1.0f / 127.0f); \
        s16x2_t acc[2][4]; \
        _Pragma("unroll") for (int qd = 0; qd < 2; ++qd) _Pragma("unroll") for (int j = 0; j < 4; ++j) acc[qd][j] = (s16x2_t){0, 0}; \
        _Pragma("unroll") for (int k = 0; k < 16; ++k) { \
            const int src = ((k >> 3) & 1) | (((k >> 2) & 1) << 1) | (((k >> 1) & 1) << 2) | ((k & 1) << 3);     \
            const int wk = __builtin_amdgcn_readlane(wq, src); \
            const s16x2_t wpk = __builtin_bit_cast(s16x2_t, (wk & 0xffff) | (wk << 16)); \
            _Pragma("unroll") for (int qd = 0; qd < 2; ++qd) { const unsigned d = W[k][2 + qd]; \
                _Pragma("unroll") for (int j = 0; j < 4; ++j) { const s16x2_t t = __builtin_bit_cast(s16x2_t, (d >> (4 * j)) & 0x000F000Fu); acc[qd][j] = t * wpk + acc[qd][j]; } } } \
        const float corr = -8.0f * hs * (float)wsum; \
        _Pragma("unroll") for (int qd = 0; qd < 2; ++qd) _Pragma("unroll") for (int j = 0; j < 4; ++j) { out[8 * qd + j] += hs * (float)acc[qd][j][0] + corr; out[8 * qd + j + 4] += hs * (float)acc[qd][j][1] + corr; } }
#define META(H, EV, SU, GB, GC) { const size_t o_ = eb0 + (size_t)(H) * 16; EV = Eid[o_ + (lane & 15)]; SU = Ga[o_ + ridx]; GB = Gb[o_ + ridx]; GC = Gc[o_ + ridx]; }
    int evA; float suA, gbA, gcA;
    META(0, evA, suA, gbA, gcA);
    u32x4_t wA[16];
#pragma unroll 1
    for (int hd = 0; hd < PHEADS; ++hd) {
        int evN; float suN, gbN, gcN;
        { const int hn = (hd + 1 < PHEADS) ? hd + 1 : PHEADS - 1; META(hn, evN, suN, gbN, gcN); }
        LOADROWS(wA, evA);
        __builtin_amdgcn_sched_barrier(0);
        HEAD_MATH(wA, suA, gbA, gcA);
        __builtin_amdgcn_sched_barrier(0);
        evA = evN; suA = suN; gbA = gbN; gcA = gcN;
    }
#undef LOADROWS
#undef HEAD_MATH
#undef META
    float y[16]; float s2 = 0.f;
#pragma unroll
    for (int q = 0; q < 4; ++q) { const f32x4_t gg = *(const f32x4_t*)(g2 + (size_t)b * gstride + 16 * lane + 4 * q); const f32x4_t xr = *(const volatile f32x4_t*)(xp + 4 * q);
#pragma unroll
        for (int i = 0; i < 4; ++i) { y[4 * q + i] = xr[i] + gg[i] * out[4 * q + i]; s2 += y[4 * q + i] * y[4 * q + i]; } }
    const float rn = 1.0f / sqrtf(wave_sum(s2) * (1.0f / DM) + EPS);
    if (!last) {
#pragma unroll
        for (int q = 0; q < 4; ++q) *(f32x4_t*)(xw + 4 * q) = (f32x4_t){y[4 * q], y[4 * q + 1], y[4 * q + 2], y[4 * q + 3]};
        float z[16];
#pragma unroll
        for (int q = 0; q < 4; ++q) { const f32x4_t g = *(const LAS f32x4_t*)(tabn + (b * 2 + 0) * 1024 + 16 * lane + 4 * q), s = *(const LAS f32x4_t*)(tabn + (b * 2 + 1) * 1024 + 16 * lane + 4 * q);
#pragma unroll
            for (int i = 0; i < 4; ++i) z[4 * q + i] = y[4 * q + i] * rn * g[i] + s[i]; }
        bf16_t* hp = Hn + (size_t)tok * DM + 16 * lane;
#pragma unroll
        for (int j = 0; j < 2; ++j) { u32x4_t wv; wv.x = pk2(z[8 * j], z[8 * j + 1]); wv.y = pk2(z[8 * j + 2], z[8 * j + 3]); wv.z = pk2(z[8 * j + 4], z[8 * j + 5]); wv.w = pk2(z[8 * j + 6], z[8 * j + 7]); *(u32x4_t*)(hp + 8 * j) = wv; }
    } else {
        float* op = outp + (size_t)tok * DM + 16 * lane;
#pragma unroll
        for (int q = 0; q < 4; ++q) { const f32x4_t fg = *(const f32x4_t*)(final_g + 16 * lane + 4 * q);
            *(f32x4_t*)(op + 4 * q) = (f32x4_t){y[4 * q] * rn * fg[0], y[4 * q + 1] * rn * fg[1], y[4 * q + 2] * rn * fg[2], y[4 * q + 3] * rn * fg[3]}; }
    }
}
template <bool OFFS>
__device__ __forceinline__ void row_to_i4(const float* src, unsigned char* dst  , float* scale_out, float* rsum_out, int lane) {
    float v[16]; float mx = 0.f;
#pragma unroll
    for (int q = 0; q < 4; ++q) { const f32x4_t a = *(const f32x4_t*)(src + 16 * lane + 4 * q); v[4 * q] = a[0]; v[4 * q + 1] = a[1]; v[4 * q + 2] = a[2]; v[4 * q + 3] = a[3]; }
#pragma unroll
    for (int i = 0; i < 16; ++i) mx = fmaxf(mx, fabsf(v[i]));
#pragma unroll
    for (int o = 1; o < 64; o <<= 1) mx = fmaxf(mx, __shfl_xor(mx, o));
    const float sc = mx > 0.f ? 7.0f / mx : 0.f;
    u32x2_t w; int rs = 0;
#pragma unroll
    for (int qd = 0; qd < 2; ++qd) { unsigned t = 0u;
#pragma unroll
        for (int j = 0; j < 8; ++j) { int q = (int)rintf(v[8 * qd + j] * sc); q = q > 7 ? 7 : (q < -7 ? -7 : q); rs += q; t |= (OFFS ? (unsigned)(q + 8) : ((unsigned)q & 15u)) << (4 * j); }
        w[qd] = t; }
    *(u32x2_t*)(dst + 16 * lane) = w;
    if (rsum_out) { const float tot = wave_sum((float)rs); if (lane == 0) *rsum_out = tot; }
    if (lane == 0) *scale_out = mx * (1.0f / 7.0f);
}
}

constexpr int LDS_MISC = 131072, LDS_BYTES = 131072 + 64;
constexpr int CW_BAR = 4096;
#ifndef REPMASK
#define REPMASK 0u
#endif
#define NREP(k) ((((REPMASK) >> (k)) & 1u) ? 2 : 1)
#define DBG_BASE 0
#ifndef ATM
#define ATM 7
#endif
#ifndef MK_N_LAUNCHES
#define MK_N_LAUNCHES 1
#endif
constexpr int PH_PER_LAYER = 9, N_PHASES = 2 + PH_PER_LAYER * DEPTH;

struct Args { const float* in[19]; float* out; unsigned char* ws; int ph_lo, ph_hi; };
enum { I_X = 0, I_C, I_N1G, I_N2G, I_WADA, I_BADA, I_WIN, I_WOUT, I_LQ1, I_LK1, I_LQ2, I_LK2, I_SUBG, I_SINK, I_PWQ, I_PKEYS, I_PU, I_PV, I_FG };

__device__ __forceinline__ void p0_transpose_item(const float* W, int K, int N, bf16_t* WT, LAS float* scr, int item, int lane) {
    const int nblk = N / 32, kb = item / nblk, nb = item % nblk, k0 = 64 * kb, n0 = 32 * nb;
#pragma unroll 8
    for (int i = 0; i < 32; ++i) { const int kk = 2 * i + (lane >> 5); scr[kk * 33 + (lane & 31)] = W[(size_t)(k0 + kk) * N + n0 + (lane & 31)]; }
    asm volatile("s_waitcnt lgkmcnt(0)" ::: "memory");
    const int c = lane & 7;
#pragma unroll
    for (int j = 0; j < 4; ++j) { const int n = (lane >> 3) + 8 * j; const LAS float* s = scr + (8 * c) * 33 + n;
        u32x4_t o; o.x = pk2(s[0 * 33], s[1 * 33]); o.y = pk2(s[2 * 33], s[3 * 33]); o.z = pk2(s[4 * 33], s[5 * 33]); o.w = pk2(s[6 * 33], s[7 * 33]);
        *(u32x4_t*)(WT + (size_t)(n0 + n) * K + k0 + 8 * c) = o; }
    asm volatile("s_waitcnt lgkmcnt(0)" ::: "memory");
}
__device__ __forceinline__ void cvt_rows(const float* src, bf16_t* dst, size_t n, size_t gtid, size_t gthreads) {
    for (size_t i = gtid * 8; i < n; i += gthreads * 8) {
        const f32x4_t a = *(const f32x4_t*)(src + i), c = *(const f32x4_t*)(src + i + 4);
        u32x4_t o; o.x = pk2(a[0], a[1]); o.y = pk2(a[2], a[3]); o.z = pk2(c[0], c[1]); o.w = pk2(c[2], c[3]);
        *(u32x4_t*)(dst + i) = o;
    }
}
__device__ __forceinline__ void build_table(LAS float* tab, const float* gvec, const float* mod_l, int sh_idx, int sc_idx) {
    for (int i = threadIdx.x; i < 4096; i += NTHREADS) { const int b = i >> 10, k = i & 1023;
        tab[(b * 2 + 0) * 1024 + k] = gvec[k] * (1.0f + mod_l[b * 6144 + sc_idx * 1024 + k]);
        tab[(b * 2 + 1) * 1024 + k] = mod_l[b * 6144 + sh_idx * 1024 + k]; }
}
__device__ __forceinline__ void norm_row(const float* xrow, bf16_t* orow, const LAS float* tab, int b, int lane) {
    const f32x4_t* xr = (const f32x4_t*)xrow + lane;
    f32x4_t v[4]; float s = 0.f;
#pragma unroll
    for (int j = 0; j < 4; ++j) { v[j] = xr[64 * j]; s += (v[j][0] * v[j][0] + v[j][1] * v[j][1]) + (v[j][2] * v[j][2] + v[j][3] * v[j][3]); }
    const float rstd = 1.0f / sqrtf(wave_sum(s) * (1.0f / DM) + EPS);
    unsigned long long* o8 = (unsigned long long*)orow + lane;
#pragma unroll
    for (int j = 0; j < 4; ++j) { const int k = 4 * lane + 256 * j;
        const f32x4_t g = *(const LAS f32x4_t*)(tab + (b * 2 + 0) * 1024 + k), sh = *(const LAS f32x4_t*)(tab + (b * 2 + 1) * 1024 + k);
        const f32x4_t y = v[j] * rstd * g + sh;
        o8[64 * j] = (unsigned long long)pk2(y[0], y[1]) | ((unsigned long long)pk2(y[2], y[3]) << 32); }
}

__global__ void __launch_bounds__(NTHREADS, 2) hymba_fwd(Args args) {
    extern __shared__ __attribute__((aligned(16))) unsigned char lds_raw[];
    LAS unsigned char* lds = (LAS unsigned char*)lds_raw;
    cg::grid_group grid = cg::this_grid();
    const int tid = threadIdx.x;
    const int wave = __builtin_amdgcn_readfirstlane(tid >> 6);
    const int G = gridDim.x, bx = blockIdx.x;
    const int gw = bx * NWAVES + wave, NGW = G * NWAVES;
    const int lo = args.ph_lo, hi_ = args.ph_hi;
#ifndef PHMASK
#define PHMASK 0xffffu
#endif
#define IN(k) (((PHMASK >> ((k) < 2 ? (k) : 2 + ((k) - 2) % PH_PER_LAYER)) & 1u) && lo <= (k) && (k) < hi_)
    if (tid < 16) ((volatile LAS unsigned*)(lds + LDS_MISC))[tid] = 0u;
    __syncthreads();
    (void)xcd_barrier_post((unsigned*)(args.ws + WS_CTL) + CW_BAR, (volatile LAS unsigned*)(lds + LDS_MISC));
#define SEAM(k) do { if (IN(k) && IN((k) + 1)) { if ((k) == 0) grid.sync(); else { XcdBarrier xb_; { size_t z_ = 0; asm volatile("" : "+s"(z_)); xb_.bar = (unsigned*)(args.ws + z_ + WS_CTL) + CW_BAR; } xb_.x = xb_xcc_id(); xb_.st = (volatile LAS unsigned*)(lds + LDS_MISC); xcd_barrier(xb_); } } } while (0)
#define PHASE_BEGIN() size_t wz_ = 0; asm volatile("" : "+s"(wz_)); unsigned char* ws = args.ws + wz_;     \
    int lane, ptid; { int t_ = threadIdx.x; asm volatile("" : "+v"(t_)); lane = t_ & 63; ptid = t_; } (void)lane; (void)ptid; \
    bf16_t* Wt_in = (bf16_t*)(ws + WS_WIN); bf16_t* Wt_out = (bf16_t*)(ws + WS_WOUT); bf16_t* Wt_q = (bf16_t*)(ws + WS_WQ); bf16_t* keysb = (bf16_t*)(ws + WS_KEYS); \
    float* modf = (float*)(ws + WS_MOD); float* kmean = (float*)(ws + WS_KMEAN); float* scal = (float*)(ws + WS_SCAL); \
    unsigned char* U8 = ws + WS_U; unsigned char* V8 = ws + WS_V; bf16_t* Hb = (bf16_t*)(ws + WS_H); \
    float* Us = (float*)(ws + WS_SCAL + 65536); float* Vs = (float*)(ws + WS_SCAL + 65536 + 262144); \
    bf16_t* Pj = (bf16_t*)(ws + WS_PROJ); bf16_t* Qp = (bf16_t*)(ws + WS_PROJ); bf16_t* Ob = (bf16_t*)(ws + WS_O); \
    int* Eid = (int*)(ws + WS_O); float* Gw = (float*)(ws + WS_O + 16 * MiB); float* Gv = (float*)(ws + WS_O + 32 * MiB); float* Gc = (float*)(ws + WS_O + 48 * MiB); float* Urs = (float*)(ws + WS_SCAL + 65536 + 131072); (void)Gv; (void)Gc; (void)Urs; unsigned* ctl = (unsigned*)(ws + WS_CTL); bf16_t* Pbuf = (bf16_t*)(ws + WS_PBUF); float* MLb = (float*)(ws + WS_ML); unsigned* RM = (unsigned*)(ws + WS_RM); (void)Pbuf; (void)MLb; (void)RM; \
    (void)Wt_in; (void)Wt_out; (void)Wt_q; (void)keysb; (void)modf; (void)kmean; (void)scal; (void)U8; (void)V8; (void)Hb; (void)Us; (void)Vs; (void)Pj; (void)Qp; (void)Ob; (void)Eid; (void)Gw; (void)ctl

    if (IN(0)) for (int rep = 0; rep < NREP(0); ++rep) {
        PHASE_BEGIN();
        if (bx < 192) {
            LAS float* cs = (LAS float*)lds;
            LAS float* red = (LAS float*)(lds + 16384);
            for (int i = tid; i < 4096; i += NTHREADS) { const float cv = args.in[I_C][i]; cs[i] = cv / (1.0f + __expf(-cv)); }
            __syncthreads();
            for (int it = bx; it < 192; it += G) {
                const int l = it / 96, n = (it % 96) * 64 + lane;
                const float* wp = args.in[I_WADA] + (size_t)l * DM * 6144 + n;
                float a0 = 0.f, a1 = 0.f, a2 = 0.f, a3 = 0.f;
#pragma unroll 8
                for (int k = wave * 128; k < wave * 128 + 128; ++k) { const float wv = wp[(size_t)k * 6144]; a0 += cs[k] * wv; a1 += cs[1024 + k] * wv; a2 += cs[2048 + k] * wv; a3 += cs[3072 + k] * wv; }
                red[(wave * 4 + 0) * 64 + lane] = a0; red[(wave * 4 + 1) * 64 + lane] = a1; red[(wave * 4 + 2) * 64 + lane] = a2; red[(wave * 4 + 3) * 64 + lane] = a3;
                __syncthreads();
                if (wave < 4) { float s = args.in[I_BADA][l * 6144 + n];
#pragma unroll
                    for (int w = 0; w < 8; ++w) s += red[(w * 4 + wave) * 64 + lane];
                    modf[((size_t)l * 4 + wave) * 6144 + n] = s; }
                __syncthreads();
            }
        }
        __syncthreads();
        {
            LAS float* scr = (LAS float*)(lds + wave * 16384);
            constexpr int I_IN = 16 * (INW / 32), I_OUT = 16 * (DM / 32), I_Q = 16 * (PQW / 32), PER_L = I_IN + I_OUT + I_Q;
            for (int it = gw; it < DEPTH * PER_L; it += NGW) {
                const int l = it / PER_L; int r = it % PER_L;
                if (r < I_IN) { p0_transpose_item(args.in[I_WIN] + (size_t)l * DM * INW, DM, INW, Wt_in + (size_t)l * INW * DM, scr, r, lane); continue; } r -= I_IN;
                if (r < I_OUT) { p0_transpose_item(args.in[I_WOUT] + (size_t)l * DM * DM, DM, DM, Wt_out + (size_t)l * DM * DM, scr, r, lane); continue; } r -= I_OUT;
                p0_transpose_item(args.in[I_PWQ] + (size_t)l * DM * PQW, DM, PQW, Wt_q + (size_t)l * PQW * DM, scr, r, lane);
            }
        }
        {
            const size_t gtid = (size_t)bx * NTHREADS + ptid, gth = (size_t)G * NTHREADS;
            cvt_rows(args.in[I_PKEYS], keysb, (size_t)DEPTH * PHEADS * 2 * 128 * 128, gtid, gth);
            for (int r = gw; r < 2 * DEPTH * PNEXP; r += NGW) { const int tb = r / (DEPTH * PNEXP), rr = r % (DEPTH * PNEXP);
                if (tb) peer::row_to_i4<true>(args.in[I_PV] + (size_t)rr * DM, U8 + (size_t)rr * DM + 8, Vs + rr, nullptr, lane);
                else peer::row_to_i4<false>(args.in[I_PU] + (size_t)rr * DM, U8 + (size_t)rr * DM, Us + rr, Urs + rr, lane); }
            for (size_t i = gtid; i < (size_t)DEPTH * 4 * 6 * 32 * 64; i += gth) kmean[i] = 0.f;
            if (gtid < DEPTH) { const int l = (int)gtid; float s1 = 0.f, s2 = 0.f;
                for (int i = 0; i < 32; ++i) { s1 += args.in[I_LQ1][l * 32 + i] * args.in[I_LK1][l * 32 + i]; s2 += args.in[I_LQ2][l * 32 + i] * args.in[I_LK2][l * 32 + i]; }
                const float lam_init = 0.8f - 0.6f * expf(-0.3f * (float)l);
                scal[l * 4 + 0] = expf(s1) - expf(s2) + lam_init; scal[l * 4 + 1] = lam_init; }
        }
    }
    SEAM(0);
    if (IN(1)) for (int rep = 0; rep < NREP(1); ++rep) {
        PHASE_BEGIN();
        LAS float* tab = (LAS float*)lds;
        build_table(tab, args.in[I_N1G], modf, 0, 1);
        __syncthreads();
        for (int m = gw; m < TOK; m += NGW) norm_row(args.in[I_X] + (size_t)m * DM, Hb + (size_t)m * DM, tab, m >> 13, lane);
        __syncthreads();
#if defined(MB_KIND)
        {
            unsigned w0 = (unsigned)ptid * 2654435761u; float acc0 = 0.f, acc1 = 0.f, acc2 = 0.f, acc3 = 0.f;
#pragma unroll 1
            for (int it = 0; it < MB_ITERS; ++it) {
#if MB_KIND == 1
                typedef float f2_t __attribute__((ext_vector_type(2)));
                const f2_t a = __builtin_amdgcn_cvt_scalef32_pk_f32_fp4(w0, 1.0f, 0), b = __builtin_amdgcn_cvt_scalef32_pk_f32_fp4(w0, 1.0f, 1), c = __builtin_amdgcn_cvt_scalef32_pk_f32_fp4(w0, 1.0f, 2), d = __builtin_amdgcn_cvt_scalef32_pk_f32_fp4(w0, 1.0f, 3);
                const f2_t e = __builtin_amdgcn_cvt_scalef32_pk_f32_fp4(~w0, 1.0f, 0), f_ = __builtin_amdgcn_cvt_scalef32_pk_f32_fp4(~w0, 1.0f, 1), g = __builtin_amdgcn_cvt_scalef32_pk_f32_fp4(~w0, 1.0f, 2), h = __builtin_amdgcn_cvt_scalef32_pk_f32_fp4(~w0, 1.0f, 3);
                acc0 += a[0] + e[1]; acc1 += b[0] + f_[1]; acc2 += c[0] + g[1]; acc3 += d[0] + h[1];
#elif MB_KIND == 2
                typedef float f2_t __attribute__((ext_vector_type(2)));
                const f2_t a = __builtin_amdgcn_cvt_pk_f32_fp8((int)w0, false), b = __builtin_amdgcn_cvt_pk_f32_fp8((int)w0, true), c = __builtin_amdgcn_cvt_pk_f32_fp8((int)(w0 * 3u), false), d = __builtin_amdgcn_cvt_pk_f32_fp8((int)(w0 * 3u), true);
                const f2_t e = __builtin_amdgcn_cvt_pk_f32_fp8((int)~w0, false), f_ = __builtin_amdgcn_cvt_pk_f32_fp8((int)~w0, true), g = __builtin_amdgcn_cvt_pk_f32_fp8((int)(w0 * 5u), false), h = __builtin_amdgcn_cvt_pk_f32_fp8((int)(w0 * 5u), true);
                acc0 += a[0] + e[1]; acc1 += b[0] + f_[1]; acc2 += c[0] + g[1]; acc3 += d[0] + h[1];
#elif MB_KIND == 4
                int i0 = __builtin_amdgcn_sdot8((int)w0, (int)~w0, it, false), i1 = __builtin_amdgcn_sdot8((int)w0, (int)(w0 * 3u), it, false), i2 = __builtin_amdgcn_sdot8((int)w0, (int)(w0 * 5u), it, false), i3 = __builtin_amdgcn_sdot8((int)w0, (int)(w0 * 7u), it, false);
                i0 = __builtin_amdgcn_sdot8((int)(w0 * 9u), (int)~w0, i0, false); i1 = __builtin_amdgcn_sdot8((int)(w0 * 9u), (int)(w0 * 3u), i1, false); i2 = __builtin_amdgcn_sdot8((int)(w0 * 9u), (int)(w0 * 5u), i2, false); i3 = __builtin_amdgcn_sdot8((int)(w0 * 9u), (int)(w0 * 7u), i3, false);
                acc0 += (float)i0; acc1 += (float)i1; acc2 += (float)i2; acc3 += (float)i3;
#elif MB_KIND == 5
                typedef short s2_t __attribute__((ext_vector_type(2)));
                s2_t q0 = __builtin_bit_cast(s2_t, w0), q1 = __builtin_bit_cast(s2_t, ~w0), wv = __builtin_bit_cast(s2_t, w0 * 3u);
                s2_t r0 = __builtin_bit_cast(s2_t, __builtin_bit_cast(unsigned, acc0)), r1 = __builtin_bit_cast(s2_t, __builtin_bit_cast(unsigned, acc1)), r2 = __builtin_bit_cast(s2_t, __builtin_bit_cast(unsigned, acc2)), r3 = __builtin_bit_cast(s2_t, __builtin_bit_cast(unsigned, acc3));
                r0 = q0 * wv + r0; r1 = q1 * wv + r1; r2 = q0 * wv + r2; r3 = q1 * wv + r3; r0 = q1 * wv + r0; r1 = q0 * wv + r1; r2 = q1 * wv + r2; r3 = q0 * wv + r3;
                acc0 = __builtin_bit_cast(float, __builtin_bit_cast(unsigned, r0) & 0x3fffffffu); acc1 = __builtin_bit_cast(float, __builtin_bit_cast(unsigned, r1) & 0x3fffffffu); acc2 = __builtin_bit_cast(float, __builtin_bit_cast(unsigned, r2) & 0x3fffffffu); acc3 = __builtin_bit_cast(float, __builtin_bit_cast(unsigned, r3) & 0x3fffffffu);
#else
                acc0 = acc0 * 1.0001f + 1.f; acc1 = acc1 * 1.0001f + 1.f; acc2 = acc2 * 1.0001f + 1.f; acc3 = acc3 * 1.0001f + 1.f;
                acc0 = acc0 * 1.0001f + 2.f; acc1 = acc1 * 1.0001f + 2.f; acc2 = acc2 * 1.0001f + 2.f; acc3 = acc3 * 1.0001f + 2.f;
                acc0 += 1.f; acc1 += 1.f; acc2 += 1.f; acc3 += 1.f; acc0 += 2.f; acc1 += 2.f; acc2 += 2.f; acc3 += 2.f;
#endif
                w0 = w0 * 1664525u + 1013904223u;
            }
            if (acc0 + acc1 + acc2 + acc3 == 1.2345f) ((float*)(ws + WS_PBUF))[ptid] = acc0;
        }
#endif
    }
    SEAM(1);

#pragma unroll 1
    for (int l = 0; l < DEPTH; ++l) {
        const int P = 2 + PH_PER_LAYER * l;
        if (IN(P + 0)) for (int rep = 0; rep < NREP(2); ++rep) {
            PHASE_BEGIN();
            pg8::Gemm g{Hb, Wt_in + (size_t)l * INW * DM, TOK, INW, DM}; pg8::StaticOrder S; S.init(TOK, INW, G, bx);
            pg8::EpiProj E{Pj, INW, kmean + (size_t)l * 4 * 6 * 32 * 64, rep == 0 ? OFF_KB : (1 << 28)};
            pg8::gemm_phase<pg8::EpiProj, pg8::StaticOrder, true, true>(lds, g, S, E);
        }
        SEAM(P + 0);
        if (IN(P + 1)) for (int rep = 0; rep < NREP(3); ++rep) {
            for (int u = bx; u < 768; u += G) { PHASE_BEGIN(); att::gate_unit((u % 24) / 6, u % 6, u / 24, Pj, kmean + (size_t)l * 4 * 6 * 32 * 64, RM, lds); }
            for (int u = bx; u < 128; u += G) { PHASE_BEGIN(); att::qknorm_unit(u >> 5, (u >> 3) & 3, u & 7, Pj, ctl + 2048 + ((rep * DEPTH + l) * 16 + (u >> 3)) * 2, ptid); }
        }
        SEAM(P + 1);
        if (IN(P + 2)) for (int rep = 0; rep < NREP(4); ++rep) {
            volatile LAS int* qw = (volatile LAS int*)(lds + LDS_MISC + 32);
#define NEXT_UNIT(mode) int idx; { PHASE_BEGIN(); if (tid == 0) qw[0] = (int)atomicAdd(ctl + 64 * ((rep * DEPTH + l) * 4 + (mode)), 1u); __syncthreads(); idx = qw[0]; }
            if (ATM & 1) for (;;) {
                NEXT_UNIT(0); if (idx >= 512) break;
                PHASE_BEGIN();
                const int qb = 31 - idx / 16, j = idx % 16;
                const unsigned* nw = ctl + 2048 + ((rep * DEPTH + l) * 16 + j) * 2;
                const float qn = sqrtf(__builtin_bit_cast(float, nw[0])), kn = sqrtf(__builtin_bit_cast(float, nw[1]));
                const float need = (40.0f + 0.17677669529663687f * LOG2E * qn * 2.0f * kn) / (alibi_slope(6 + (j & 3)) * LOG2E);
                const int dlim = need < 16384.0f ? (int)need + 1 : 16384;
                att::attn_unit<0>(j >> 2, j & 3, qb, Pj, Ob, nullptr, scal[l * 4 + 0], scal[l * 4 + 1], args.in[I_SUBG] + l * 64, nullptr, dlim, lds);
            }
            __syncthreads();
            if (ATM & 2) for (;;) {
                NEXT_UNIT(1); if (idx >= 768) break;
                PHASE_BEGIN();
                att::moba_unit((idx % 24) / 6, idx % 6, idx / 24, Pj, RM, Pbuf, MLb, lds);
            }
            __syncthreads();
            if (ATM & 4) for (;;) {
                NEXT_UNIT(2); if (idx >= 768) break;
                PHASE_BEGIN();
                const int qb = idx / 24, jj = idx % 24;
                att::attn_unit<2>(jj / 6, jj % 6, qb, Pj, Ob, nullptr, 0.f, 0.f, nullptr, args.in[I_SINK] + l * 6 + jj % 6, 0, lds);
            }
            __syncthreads();
#undef NEXT_UNIT
        }
        SEAM(P + 2);
        if (IN(P + 3)) for (int rep = 0; rep < NREP(5); ++rep) {
            PHASE_BEGIN();
            att::moba_combine(Pbuf, MLb, Ob, (size_t)bx * NTHREADS + ptid, (size_t)G * NTHREADS);
        }
        SEAM(P + 3);
        if (IN(P + 4)) for (int rep = 0; rep < NREP(6); ++rep) {
            PHASE_BEGIN();
            pg8::Gemm g{Ob, Wt_out + (size_t)l * DM * DM, TOK, DM, DM}; pg8::StaticOrder S; S.init(TOK, DM, G, bx);
            pg8::EpiRes E{(l == 0) ? args.in[I_X] : (const float*)args.out, (rep + 1 < NREP(6)) ? (float*)(ws + WS_PROJ) : args.out, DM, modf + (size_t)l * 4 * 6144 + 2 * 1024, 6144};
            pg8::gemm_phase<pg8::EpiRes, pg8::StaticOrder, true, true>(lds, g, S, E);
        }
        SEAM(P + 4);
        if (IN(P + 5)) for (int rep = 0; rep < NREP(7); ++rep) {
            PHASE_BEGIN();
            LAS float* tab = (LAS float*)lds;
            build_table(tab, args.in[I_N2G] + l * DM, modf + (size_t)l * 4 * 6144, 3, 4);
            __syncthreads();
            for (int m = gw; m < TOK; m += NGW) norm_row(args.out + (size_t)m * DM, Hb + (size_t)m * DM, tab, m >> 13, lane);
            __syncthreads();
        }
        SEAM(P + 5);
        if (IN(P + 6)) for (int rep = 0; rep < NREP(8); ++rep) {
            PHASE_BEGIN();
            pg8::Gemm g{Hb, Wt_q + (size_t)l * PQW * DM, TOK, PQW, DM}; pg8::StaticOrder S; S.init(TOK, PQW, G, bx);
            pg8::EpiBf16Plain E{Qp, PQW};
            pg8::gemm_phase<pg8::EpiBf16Plain, pg8::StaticOrder, true, true>(lds, g, S, E);
        }
        SEAM(P + 6);
        if (IN(P + 7)) for (int rep = 0; rep < NREP(9); ++rep) {
            PHASE_BEGIN();
            for (int u = bx; u < (TOK / 256) * PHEADS; u += G) peer::pk_unit(u >> 3, u & 7, Qp, keysb + (size_t)l * PHEADS * 2 * 128 * 128, Eid, Gw, Gv, Gc, Us + l * PNEXP, Urs + l * PNEXP, Vs + l * PNEXP, lds);
            __syncthreads();
        }
        SEAM(P + 7);
        if (IN(P + 8)) for (int rep = 0; rep < NREP(10); ++rep) {
            PHASE_BEGIN();
            LAS float* tab2 = (LAS float*)lds; LAS float* tabn = (LAS float*)(lds + 32768);
            const bool last = (l == DEPTH - 1);
            const float* mod_l = modf + (size_t)l * 4 * 6144;
            build_table(tab2, args.in[I_N2G] + l * DM, mod_l, 3, 4);
            if (!last) build_table(tabn, args.in[I_N1G] + (l + 1) * DM, mod_l + 4 * 6144, 0, 1);
            __syncthreads();
            float* dry = (float*)(ws + WS_PROJ);
            for (int m = gw; m < TOK; m += NGW)
                peer::pg_token(m, args.out, (rep + 1 < NREP(10)) ? dry : args.out, tab2, mod_l + 5 * 1024, 6144, Eid, Gw, Gv, Gc, U8 + (size_t)l * PNEXP * DM, V8,
                                last, tabn, args.in[I_FG], Hb, (rep + 1 < NREP(10)) ? dry : args.out, lane);
            __syncthreads();
        }
        if (l + 1 < DEPTH) SEAM(P + 8);
    }
#undef IN
#undef SEAM
}

#ifdef DBG
__global__ void dbg_chk16(const bf16_t* p, size_t n, unsigned* flag, unsigned bit) {
    bool bad = false;
    for (size_t i = (size_t)blockIdx.x * blockDim.x + threadIdx.x; i < n; i += (size_t)gridDim.x * blockDim.x) bad |= ((p[i] & 0x7f80u) == 0x7f80u);
    if (bad) atomicOr(flag, bit);
}
__global__ void dbg_chk32(const float* p, size_t n, unsigned* flag, unsigned bit) {
    bool bad = false;
    for (size_t i = (size_t)blockIdx.x * blockDim.x + threadIdx.x; i < n; i += (size_t)gridDim.x * blockDim.x) bad |= ((__builtin_bit_cast(unsigned, p[i]) & 0x7f800000u) == 0x7f800000u);
    if (bad) atomicOr(flag, bit);
}
__global__ void dbg_chk_o(const bf16_t* p, unsigned* flag) {
    unsigned bad = 0;
    for (size_t i = (size_t)blockIdx.x * blockDim.x + threadIdx.x; i < (size_t)TOK * DM; i += (size_t)gridDim.x * blockDim.x) {
        if ((p[i] & 0x7f80u) == 0x7f80u) { const int c = (int)(i & 1023); const int r = (int)((i >> 10) & 8191); bad |= (c < 256) ? 1u : (c < 640 ? 2u : 4u); if (r < 256) bad |= 8u; if ((r & 255) < 32) bad |= 16u; if (p[i] & 0x7fu) bad |= 32u; }
    }
    if (bad) atomicOr(flag, bad);
}
__global__ void dbg_fill(float* out, size_t n, const unsigned* flag) {
    const unsigned f = *flag; if (f == 0u) return;
    const float c = sqrtf((float)f);
    for (size_t i = (size_t)blockIdx.x * blockDim.x + threadIdx.x; i < n; i += (size_t)gridDim.x * blockDim.x) out[i] = c;
}
#endif
extern "C" void kernel_launch(void* const* d_in, const int* in_sizes, int n_in, void* d_out, int out_size, void* d_ws, size_t ws_size, hipStream_t stream) {
    static int grid = 0;
    if (grid == 0) {
        if (n_in != 19 || out_size != TOK * DM || ws_size < WS_END) { fprintf(stderr, "kernel_launch: unexpected shapes (n_in %d out %d ws %zu)\n", n_in, out_size, ws_size); grid = -1; return; }
        int dev = 0, cus = 0, per_cu = 0;
        hipGetDevice(&dev); hipDeviceGetAttribute(&cus, hipDeviceAttributeMultiprocessorCount, dev);
        hipFuncSetAttribute((const void*)hymba_fwd, hipFuncAttributeMaxDynamicSharedMemorySize, LDS_BYTES);
        hipOccupancyMaxActiveBlocksPerMultiprocessor(&per_cu, (const void*)hymba_fwd, NTHREADS, LDS_BYTES);
        (void)hipGetLastError();
        if (per_cu < 1) per_cu = 1;
        if (per_cu > 1) per_cu = 1;
        grid = cus * per_cu;
        if (grid <= 0) grid = 256;
    }
    if (grid < 0) return;
    hipMemsetAsync((char*)d_ws + WS_CTL, 0, CTL_ZERO_BYTES, stream);
    Args a{};
    for (int i = 0; i < 19; ++i) a.in[i] = (const float*)d_in[i];
    a.out = (float*)d_out; a.ws = (unsigned char*)d_ws;
#if MK_N_LAUNCHES == 1
    a.ph_lo = 0; a.ph_hi = N_PHASES;
    void* kargs[] = {&a};
    hipError_t e = hipLaunchCooperativeKernel((const void*)hymba_fwd, dim3(grid), dim3(NTHREADS), kargs, LDS_BYTES, stream);
    if (e != hipSuccess) fprintf(stderr, "cooperative launch failed: %s (grid %d)\n", hipGetErrorString(e), grid);
#else
    for (int p = 0; p < N_PHASES; ++p) { a.ph_lo = p; a.ph_hi = p + 1; hipLaunchKernelGGL(hymba_fwd, dim3(grid), dim3(NTHREADS), LDS_BYTES, stream, a);
#ifdef DBG
        unsigned* flag = (unsigned*)((char*)d_ws + WS_CTL); unsigned char* w = (unsigned char*)d_ws;
        const int base = DBG_BASE;
        if (p == 3) dbg_chk_o<<<1024, 256, 0, stream>>>((const bf16_t*)(w + WS_O), flag);
#endif
    }
#ifdef DBG
    dbg_fill<<<1024, 256, 0, stream>>>((float*)d_out, (size_t)TOK * DM, (const unsigned*)((char*)d_ws + WS_CTL));
#endif
#endif
}
```
